# Optimizing an MI355X kernel written in HIP

```python
import math
import jax
import jax.numpy as jnp
from jax import lax
import numpy as np

D_MODEL = 1024
BATCH = 2
SEQ = 8192
DEPTH = 4
DEC_BATCH = 32
DEC_SEQ = 8
PAST_LEN = 8192
PAGE_SIZE = 128

N_A_LAYERS = DEPTH // 2
N_B_LAYERS = DEPTH - N_A_LAYERS
RET_HEADS = 4
RET_DK = D_MODEL // RET_HEADS
RET_DV = 2 * D_MODEL // RET_HEADS
RET_CHUNK = 128
N_HEADS = 16
N_KV = 4
HEAD_DIM = 64
GROUP = N_HEADS // N_KV
CMP_LEN = 32
CMP_STRIDE = 16
CMP_HID = 128
SEL_BLOCK = 64
SEL_TOPK = 16
WINDOW = 512
Q_BLOCK = 128
D_FF = 2816
CONV_W = 3
ROPE_THETA = 10000.0
EPS = 1e-6
NEG_INF = -1e30
TINY = 1e-30
SEL_FORCE = 1e6
SEL_NEG = -1e6

kernel_name = 'yoco_retnet_nsa_convffn_step'


def rmsnorm(x, g):
    xf = x.astype(jnp.float32)
    y = xf * lax.rsqrt(jnp.mean(xf * xf, axis=-1, keepdims=True) + EPS)
    return (y * g.astype(jnp.float32)).astype(x.dtype)


def head_rms(x):
    xf = x.astype(jnp.float32)
    return (xf * lax.rsqrt(jnp.mean(xf * xf, axis=-1, keepdims=True) + EPS)).astype(x.dtype)


def rope(x, pos):
    half = x.shape[-1] // 2
    inv = jnp.exp(-math.log(ROPE_THETA) * jnp.arange(half, dtype=jnp.float32) / half)
    ang = pos.astype(jnp.float32)[:, None] * inv[None, :]
    cos = jnp.cos(ang)[:, None, :]
    sin = jnp.sin(ang)[:, None, :]
    xf = x.astype(jnp.float32)
    x1, x2 = xf[..., :half], xf[..., half:]
    return jnp.concatenate([x1 * cos - x2 * sin, x2 * cos + x1 * sin], axis=-1).astype(x.dtype)


def masked_softmax(s, mask):
    s = jnp.where(mask, s, NEG_INF)
    m = jnp.max(s, axis=-1, keepdims=True)
    e = jnp.where(mask, jnp.exp(s - m), 0.0)
    return e / jnp.maximum(jnp.sum(e, axis=-1, keepdims=True), TINY)


def retention_chunk(S, q, k, v, log_gamma):
    L = q.shape[1]
    idx = jnp.arange(L, dtype=jnp.float32)
    diff = idx[:, None] - idx[None, :]
    decay = jnp.where(diff >= 0, jnp.exp(jnp.maximum(diff, 0.0)[None] * log_gamma[:, None, None]), 0.0)
    qf, kf, vf = q.astype(jnp.float32), k.astype(jnp.float32), v.astype(jnp.float32)
    scores = jnp.einsum('blhd,bmhd->bhlm', qf, kf) * decay[None]
    o = jnp.einsum('bhlm,bmhe->blhe', scores, vf)
    q_dec = jnp.exp((idx + 1.0)[:, None] * log_gamma[None, :])
    o = o + jnp.einsum('blhd,bhde->blhe', qf, S) * q_dec[None, :, :, None]
    k_dec = jnp.exp((L - 1.0 - idx)[:, None] * log_gamma[None, :])
    S = S * jnp.exp(L * log_gamma)[None, :, None, None] + jnp.einsum('blhd,blhe->bhde', kf * k_dec[None, :, :, None], vf)
    return S, o


def retention_mixer(h, S0, pos, w_in, w_out):
    B, T, _ = h.shape
    proj = h @ w_in
    q = proj[..., :D_MODEL].reshape(B, T, RET_HEADS, RET_DK)
    k = proj[..., D_MODEL:2 * D_MODEL].reshape(B, T, RET_HEADS, RET_DK)
    v = proj[..., 2 * D_MODEL:4 * D_MODEL].reshape(B, T, RET_HEADS, RET_DV)
    g = proj[..., 4 * D_MODEL:]
    q = rope(q, pos)
    k = rope(k, pos) * (RET_DK ** -0.5)
    log_gamma = jnp.log1p(-jnp.exp2(-5.0 - jnp.arange(RET_HEADS, dtype=jnp.float32)))
    chunk = RET_CHUNK if T % RET_CHUNK == 0 else T
    n = T // chunk

    def to_chunks(a):
        return a.reshape(B, n, chunk, RET_HEADS, a.shape[-1]).swapaxes(0, 1)

    def step(S, inp):
        return retention_chunk(S, inp[0], inp[1], inp[2], log_gamma)

    S, o = lax.scan(step, S0.astype(jnp.float32), (to_chunks(q), to_chunks(k), to_chunks(v)))
    o = o.swapaxes(0, 1).reshape(B, T, RET_HEADS, RET_DV)
    o = head_rms(o).reshape(B, T, RET_HEADS * RET_DV).astype(h.dtype)
    return (o * jax.nn.silu(g)) @ w_out, S


def conv_ffn(h, buf, w_in, conv_w, conv_b, w_out):
    T = h.shape[1]
    proj = h @ w_in
    u, gate = proj[..., :D_FF], proj[..., D_FF:]
    up = jnp.concatenate([buf.astype(u.dtype), u], axis=1)
    c = conv_b + conv_w[0] * up[:, 0:T]
    for j in range(1, CONV_W):
        c = c + conv_w[j] * up[:, j:j + T]
    out = (jax.nn.gelu(c) * gate) @ w_out
    return out, up[:, up.shape[1] - (CONV_W - 1):]


def compress(rows, cmp_pos, cmp_w1, cmp_w2, k_gain):
    B, L = rows.shape[0], rows.shape[1]
    R = CMP_LEN // CMP_STRIDE
    n_sub = L // CMP_STRIDE
    n_cmp = n_sub - R + 1
    sub = rows[:, :n_sub * CMP_STRIDE].reshape(B, n_sub, CMP_STRIDE, 2, N_KV, HEAD_DIM)
    w1 = cmp_w1.reshape(2, R, CMP_STRIDE, HEAD_DIM, CMP_HID)
    part = jnp.einsum('bnsckd,crsdh->rbnckh', sub, w1)
    hid = part[0][:, 0:n_cmp]
    for r in range(1, R):
        hid = hid + part[r][:, r:r + n_cmp]
    pos_bias = jnp.einsum('cld,cldh->ch', cmp_pos, cmp_w1.reshape(2, CMP_LEN, HEAD_DIM, CMP_HID))
    hid = jax.nn.gelu(hid + pos_bias[:, None, :].astype(hid.dtype))
    out = jnp.einsum('bnckh,chd->bnckd', hid, cmp_w2)
    return head_rms(out[:, :, 0]) * k_gain, out[:, :, 1]


def build_shared(x, pos, past_len, past_cmp, past_sel, past_win,
                 kv_norm, kv_w, kv_knorm, cmp_pos, cmp_w1, cmp_w2):
    B, T, _ = x.shape
    kv = (rmsnorm(x, kv_norm) @ kv_w).reshape(B, T, 6, N_KV, HEAD_DIM)
    new_cmp = kv[:, :, 0:2]
    new_sel = jnp.stack([rope(head_rms(kv[:, :, 2]) * kv_knorm[1], pos), kv[:, :, 3]], axis=2)
    new_win = jnp.stack([rope(head_rms(kv[:, :, 4]) * kv_knorm[2], pos), kv[:, :, 5]], axis=2)
    all_cmp = jnp.concatenate([past_cmp.astype(new_cmp.dtype), new_cmp], axis=1)
    cmp_k, cmp_v = compress(all_cmp, cmp_pos, cmp_w1, cmp_w2, kv_knorm[0])
    all_sel = jnp.concatenate([past_sel.astype(new_sel.dtype), new_sel], axis=1)
    L = all_sel.shape[1]
    pad = (-L) % SEL_BLOCK
    all_sel = jnp.pad(all_sel, ((0, 0), (0, pad), (0, 0), (0, 0), (0, 0)))
    blocks = all_sel.reshape(B, (L + pad) // SEL_BLOCK, SEL_BLOCK, 2, N_KV, HEAD_DIM).transpose(3, 0, 4, 1, 2, 5)
    all_win = jnp.concatenate([past_win.astype(new_win.dtype), new_win], axis=1)
    win_state = all_win[:, all_win.shape[1] - min(WINDOW, past_len + T):]
    win_keys = jnp.pad(all_win, ((0, 0), (WINDOW - past_win.shape[1], 0), (0, 0), (0, 0), (0, 0)))
    shared = (cmp_k, cmp_v, blocks[0], blocks[1], win_keys[:, :, 0], win_keys[:, :, 1])
    return shared, new_cmp, new_sel, win_state


def nsa_attend(q, gates, qpos, cmp_k, cmp_v, sel_k, sel_v, win_k, win_v, win_pos):
    B, Q = q.shape[0], q.shape[1]
    scale = HEAD_DIM ** -0.5
    q_c = q.reshape(B, Q, N_KV, GROUP, HEAD_DIM)
    q_r = rope(q, qpos).reshape(B, Q, N_KV, GROUP, HEAD_DIM)
    n_cmp = cmp_k.shape[1]
    c_start = jnp.arange(n_cmp) * CMP_STRIDE
    m_c = (c_start + CMP_LEN - 1)[None, :] <= qpos[:, None]
    s_c = jnp.einsum('bqkgd,bnkd->bkgqn', q_c, cmp_k).astype(jnp.float32) * scale
    p_c = masked_softmax(s_c, m_c)
    o_c = jnp.einsum('bkgqn,bnkd->bqkgd', p_c.astype(cmp_v.dtype), cmp_v)
    n_sel = sel_k.shape[2]
    s_start = jnp.arange(n_sel) * SEL_BLOCK
    overlap = (jnp.minimum(c_start[:, None] + CMP_LEN, s_start[None, :] + SEL_BLOCK)
               - jnp.maximum(c_start[:, None], s_start[None, :]))
    w_map = jnp.maximum(overlap, 0).astype(jnp.float32) / CMP_LEN
    imp = jnp.einsum('bkgqn,ns->bkqs', p_c, w_map)
    blk = jnp.arange(n_sel)[None, :]
    cur = (qpos // SEL_BLOCK)[:, None]
    forced = (blk == 0) | (blk == cur) | (blk == cur - 1)
    imp = jnp.where(forced, SEL_FORCE, jnp.where(s_start[None, :] <= qpos[:, None], imp, SEL_NEG))
    top_v, top_i = lax.top_k(imp, min(SEL_TOPK, n_sel))
    n_top = top_i.shape[-1]
    bi = jnp.arange(B)[:, None, None, None]
    ki = jnp.arange(N_KV)[None, :, None, None]
    g_k = sel_k[bi, ki, top_i]
    g_v = sel_v[bi, ki, top_i]
    tok = top_i[..., None] * SEL_BLOCK + jnp.arange(SEL_BLOCK)
    m_s = (top_v > 0.5 * SEL_NEG)[..., None] & (tok <= qpos[None, None, :, None, None])
    s_s = jnp.einsum('bqkgd,bkqtsd->bkgqts', q_r, g_k).astype(jnp.float32) * scale
    p_s = masked_softmax(s_s.reshape(B, N_KV, GROUP, Q, n_top * SEL_BLOCK),
                         m_s.reshape(B, N_KV, 1, Q, n_top * SEL_BLOCK))
    o_s = jnp.einsum('bkgqts,bkqtsd->bqkgd', p_s.reshape(s_s.shape).astype(sel_v.dtype), g_v)
    m_w = ((win_pos[None, :] <= qpos[:, None]) & (win_pos[None, :] > qpos[:, None] - WINDOW)
           & (win_pos[None, :] >= 0))
    s_w = jnp.einsum('bqkgd,bwkd->bkgqw', q_r, win_k).astype(jnp.float32) * scale
    p_w = masked_softmax(s_w, m_w)
    o_w = jnp.einsum('bkgqw,bwkd->bqkgd', p_w.astype(win_v.dtype), win_v)
    g = gates.reshape(B, Q, N_KV, GROUP, 3).astype(o_c.dtype)
    o = g[..., 0:1] * o_c + g[..., 1:2] * o_s + g[..., 2:3] * o_w
    return o.reshape(B, Q, N_HEADS * HEAD_DIM)


def nsa_mixer(h, past_len, shared, w_qg, q_gain, w_o):
    cmp_k, cmp_v, sel_k, sel_v, win_k, win_v = shared
    B, T, _ = h.shape
    proj = h @ w_qg
    q = head_rms(proj[..., :N_HEADS * HEAD_DIM].reshape(B, T, N_HEADS, HEAD_DIM)) * q_gain
    gates = jax.nn.sigmoid(proj[..., N_HEADS * HEAD_DIM:].astype(jnp.float32)).reshape(B, T, N_HEADS, 3)
    qb = Q_BLOCK if T % Q_BLOCK == 0 else T
    n_qb = T // qb
    q_blk = q.reshape(B, n_qb, qb, N_HEADS, HEAD_DIM).swapaxes(0, 1)
    g_blk = gates.reshape(B, n_qb, qb, N_HEADS, 3).swapaxes(0, 1)

    def one_block(args):
        i, qi, gi = args
        qs = i * qb
        qpos = past_len + qs + jnp.arange(qb)
        wk = lax.dynamic_slice_in_dim(win_k, qs, WINDOW + qb, axis=1)
        wv = lax.dynamic_slice_in_dim(win_v, qs, WINDOW + qb, axis=1)
        wpos = past_len - WINDOW + qs + jnp.arange(WINDOW + qb)
        return nsa_attend(qi, gi, qpos, cmp_k, cmp_v, sel_k, sel_v, wk, wv, wpos)

    o = lax.map(one_block, (jnp.arange(n_qb), q_blk, g_blk))
    o = o.swapaxes(0, 1).reshape(B, T, N_HEADS * HEAD_DIM)
    return o.astype(h.dtype) @ w_o


def run_trunk(x, past_len, ret_s0, conv0, past_cmp, past_sel, past_win, params):
    (norm_mix, norm_ffn, ret_w_in, ret_w_out, ffn_w_in, ffn_conv_w, ffn_conv_b, ffn_w_out,
     kv_norm, kv_w, kv_knorm, cmp_pos, cmp_w1, cmp_w2, nsa_w_qg, nsa_qnorm, nsa_w_o) = params
    T = x.shape[1]
    pos = past_len + jnp.arange(T)
    ret_states = []
    conv_states = []
    for layer in range(DEPTH):
        if layer == N_A_LAYERS:
            shared, new_cmp, new_sel, new_win = build_shared(
                x, pos, past_len, past_cmp, past_sel, past_win,
                kv_norm, kv_w, kv_knorm, cmp_pos, cmp_w1, cmp_w2)
        h = rmsnorm(x, norm_mix[layer])
        if layer < N_A_LAYERS:
            mix, s_new = retention_mixer(h, ret_s0[layer], pos, ret_w_in[layer], ret_w_out[layer])
            ret_states.append(s_new)
        else:
            j = layer - N_A_LAYERS
            mix = nsa_mixer(h, past_len, shared, nsa_w_qg[j], nsa_qnorm[j], nsa_w_o[j])
        x = x + mix
        f, buf = conv_ffn(rmsnorm(x, norm_ffn[layer]), conv0[layer], ffn_w_in[layer],
                          ffn_conv_w[layer], ffn_conv_b[layer], ffn_w_out[layer])
        conv_states.append(buf)
        x = x + f
    return x, jnp.stack(ret_states), jnp.stack(conv_states), new_cmp, new_sel, new_win


def setup_inputs(seed: int = 0) -> dict:
    key = jax.random.key(seed)
    ks = jax.random.split(key, 26)
    f32 = jnp.float32

    def nrm(k, shape, scale=1.0):
        return jax.random.normal(k, shape, f32) * scale

    n_pages = PAST_LEN // PAGE_SIZE
    n_used = DEC_BATCH * n_pages
    n_pool = n_used + max(n_used // 4, 1)
    win_buf = min(WINDOW, PAST_LEN)
    page_table = jax.random.permutation(ks[0], n_pool)[:n_used].reshape(DEC_BATCH, n_pages).astype(jnp.int32)
    qg_width = N_HEADS * HEAD_DIM + 3 * N_HEADS
    return {
        'x_prompt': nrm(ks[1], (BATCH, SEQ, D_MODEL)),
        'x_sample': nrm(ks[2], (DEC_BATCH, DEC_SEQ, D_MODEL)),
        'cache_cmp_kv': nrm(ks[3], (n_pool, PAGE_SIZE, 2, N_KV, HEAD_DIM)),
        'cache_sel_kv': nrm(ks[4], (n_pool, PAGE_SIZE, 2, N_KV, HEAD_DIM)),
        'cache_win_kv': nrm(ks[5], (DEC_BATCH, win_buf, 2, N_KV, HEAD_DIM)),
        'state_ret': nrm(ks[6], (N_A_LAYERS, DEC_BATCH, RET_HEADS, RET_DK, RET_DV), 0.5),
        'state_conv': nrm(ks[7], (DEPTH, DEC_BATCH, CONV_W - 1, D_FF)),
        'page_table': page_table,
        'norm_mix': 1.0 + nrm(ks[8], (DEPTH, D_MODEL), 0.01),
        'norm_ffn': 1.0 + nrm(ks[9], (DEPTH, D_MODEL), 0.01),
        'ret_w_in': nrm(ks[10], (N_A_LAYERS, D_MODEL, 6 * D_MODEL), D_MODEL ** -0.5),
        'ret_w_out': nrm(ks[11], (N_A_LAYERS, 2 * D_MODEL, D_MODEL), (2 * D_MODEL) ** -0.5),
        'ffn_w_in': nrm(ks[12], (DEPTH, D_MODEL, 2 * D_FF), D_MODEL ** -0.5),
        'ffn_conv_w': nrm(ks[13], (DEPTH, CONV_W, D_FF), CONV_W ** -0.5),
        'ffn_conv_b': nrm(ks[14], (DEPTH, D_FF), 0.01),
        'ffn_w_out': nrm(ks[15], (DEPTH, D_FF, D_MODEL), D_FF ** -0.5),
        'kv_norm': 1.0 + nrm(ks[16], (D_MODEL,), 0.01),
        'kv_w': nrm(ks[17], (D_MODEL, 6 * N_KV * HEAD_DIM), D_MODEL ** -0.5),
        'kv_knorm': 1.0 + nrm(ks[18], (3, HEAD_DIM), 0.01),
        'cmp_pos': nrm(ks[19], (2, CMP_LEN, HEAD_DIM), 0.5),
        'cmp_w1': nrm(ks[20], (2, CMP_LEN * HEAD_DIM, CMP_HID), (CMP_LEN * HEAD_DIM) ** -0.5),
        'cmp_w2': nrm(ks[21], (2, CMP_HID, HEAD_DIM), CMP_HID ** -0.5),
        'nsa_w_qg': nrm(ks[22], (N_B_LAYERS, D_MODEL, qg_width), D_MODEL ** -0.5),
        'nsa_qnorm': 1.0 + nrm(ks[23], (N_B_LAYERS, HEAD_DIM), 0.01),
        'nsa_w_o': nrm(ks[24], (N_B_LAYERS, N_HEADS * HEAD_DIM, D_MODEL), (N_HEADS * HEAD_DIM) ** -0.5),
    }


def reference(x_prompt, x_sample, cache_cmp_kv, cache_sel_kv, cache_win_kv, state_ret, state_conv,
              page_table, norm_mix, norm_ffn, ret_w_in, ret_w_out, ffn_w_in, ffn_conv_w, ffn_conv_b,
              ffn_w_out, kv_norm, kv_w, kv_knorm, cmp_pos, cmp_w1, cmp_w2, nsa_w_qg, nsa_qnorm, nsa_w_o):
    params = (norm_mix, norm_ffn, ret_w_in, ret_w_out, ffn_w_in, ffn_conv_w, ffn_conv_b, ffn_w_out,
              kv_norm, kv_w, kv_knorm, cmp_pos, cmp_w1, cmp_w2, nsa_w_qg, nsa_qnorm, nsa_w_o)
    B = x_prompt.shape[0]
    dt = x_prompt.dtype
    zero_ret = jnp.zeros((N_A_LAYERS, B, RET_HEADS, RET_DK, RET_DV), jnp.float32)
    zero_conv = jnp.zeros((DEPTH, B, CONV_W - 1, D_FF), dt)
    empty = jnp.zeros((B, 0, 2, N_KV, HEAD_DIM), dt)
    y_p, ret_p, conv_p, cmp_p, sel_p, win_p = run_trunk(
        x_prompt, 0, zero_ret, zero_conv, empty, empty, empty, params)
    db = x_sample.shape[0]
    past_len = page_table.shape[1] * PAGE_SIZE
    past_cmp = cache_cmp_kv[page_table].reshape(db, past_len, 2, N_KV, HEAD_DIM)
    past_sel = cache_sel_kv[page_table].reshape(db, past_len, 2, N_KV, HEAD_DIM)
    y_s, ret_s, conv_s, cmp_s, sel_s, win_s = run_trunk(
        x_sample, past_len, state_ret, state_conv, past_cmp, past_sel, cache_win_kv, params)
    return (y_p, y_s, ret_p, ret_s, conv_p, conv_s, cmp_p, cmp_s, sel_p, sel_s, win_p, win_s)
```

```cpp
#define OPT_ATTN
#include <hip/hip_runtime.h>
#include <cstdio>
#include <cstring>
#include <cmath>
#ifdef SMALL_CFG
constexpr int D_MODEL = 64, BATCH = 2, SEQ = 2048, DEC_BATCH = 3, DEC_SEQ = 8, PAST_LEN = 2048, N_HEADS = 8, N_KV = 2, HEAD_DIM = 32, CMP_HID = 16, D_FF = 96;
#else
constexpr int D_MODEL = 1024, BATCH = 2, SEQ = 8192, DEC_BATCH = 32, DEC_SEQ = 8, PAST_LEN = 8192, N_HEADS = 16, N_KV = 4, HEAD_DIM = 64, CMP_HID = 128, D_FF = 2816;
#endif
constexpr int DEPTH = 4, PAGE_SIZE = 128, N_A = 2, N_B = 2, RET_HEADS = 4, RET_DK = D_MODEL / RET_HEADS, RET_DV = 2 * D_MODEL / RET_HEADS, RET_CHUNK = 128;
constexpr int GROUP = N_HEADS / N_KV, CMP_LEN = 32, CMP_STRIDE = 16, SEL_BLOCK = 64, SEL_TOPK = 16, WINDOW = 512;
constexpr int D_Q = N_HEADS * HEAD_DIM, D_QG = D_Q + 3 * N_HEADS, D_KV = 6 * N_KV * HEAD_DIM, KVROW = 2 * N_KV * HEAD_DIM, KVH = N_KV * HEAD_DIM;
constexpr int NP = BATCH * SEQ, NS = DEC_BATCH * DEC_SEQ, NT = NP + NS, NSEQ = BATCH + DEC_BATCH;
constexpr int NCHP = SEQ / RET_CHUNK, NCH = BATCH * NCHP + DEC_BATCH;
constexpr int N_PAGES = PAST_LEN / PAGE_SIZE, WIN_BUF = (WINDOW < PAST_LEN ? WINDOW : PAST_LEN);
constexpr int NCMP = SEQ / CMP_STRIDE - 1;
static_assert((PAST_LEN + DEC_SEQ) / CMP_STRIDE - 1 == NCMP && PAST_LEN == SEQ, "both groups have the same compressed-block count");
constexpr int NSEL_P = SEQ / SEL_BLOCK, NSEL_S = (PAST_LEN + DEC_SEQ + SEL_BLOCK - 1) / SEL_BLOCK, NSEL_MAX = NSEL_S;
constexpr int WIN_P = (WINDOW < SEQ ? WINDOW : SEQ), WIN_S = (WINDOW < PAST_LEN + DEC_SEQ ? WINDOW : PAST_LEN + DEC_SEQ);
constexpr float EPS = 1e-6f, NEG_INF = -1e30f, TINY = 1e-30f, SEL_FORCE = 1e6f, SEL_NEG = -1e6f;
constexpr long O_YP = 0, O_YS = O_YP + (long)NP * D_MODEL, O_RETP = O_YS + (long)NS * D_MODEL, O_RETS = O_RETP + (long)N_A * BATCH * RET_HEADS * RET_DK * RET_DV,
    O_CONVP = O_RETS + (long)N_A * DEC_BATCH * RET_HEADS * RET_DK * RET_DV, O_CONVS = O_CONVP + (long)DEPTH * BATCH * 2 * D_FF, O_CMPP = O_CONVS + (long)DEPTH * DEC_BATCH * 2 * D_FF,
    O_CMPS = O_CMPP + (long)NP * KVROW, O_SELP = O_CMPS + (long)NS * KVROW, O_SELS = O_SELP + (long)NP * KVROW, O_WINP = O_SELS + (long)NS * KVROW,
    O_WINS = O_WINP + (long)BATCH * WIN_P * KVROW, O_END = O_WINS + (long)DEC_BATCH * WIN_S * KVROW;

struct NvP {
    const float *x_prompt, *x_sample, *cache_cmp, *cache_sel, *cache_win, *state_ret, *state_conv; const int* page_table;
    const float *norm_mix, *norm_ffn, *ret_w_in, *ret_w_out, *ffn_w_in, *ffn_conv_w, *ffn_conv_b, *ffn_w_out, *kv_norm, *kv_w, *kv_knorm, *cmp_pos, *cmp_w1, *cmp_w2, *nsa_w_qg, *nsa_qnorm, *nsa_w_o;
    float* out;
    float *x, *rstd, *h, *proj, *SB, *SC, *RO, *G, *act, *kv, *winbuf, *posb, *hid, *cmpk, *cmpv, *qc, *qr, *gates, *oc, *mc, *lc, *imp, *os, *ao; int* topi;
};
constexpr long cmax(long a, long b) { return a > b ? a : b; }
constexpr long NW_RSTD = 0, NW_H = NW_RSTD + NT, NW_PROJ = NW_H + (long)NT * D_MODEL, NW_ACT = NW_PROJ + (long)NT * cmax(6 * D_MODEL, 2 * D_FF), NW_UNION = NW_ACT + (long)NT * D_FF,
    NW_SB = NW_UNION, NW_SC = NW_SB + (long)NCH * RET_HEADS * RET_DK * RET_DV, NW_RO = NW_SC + (long)NCH * RET_HEADS * RET_CHUNK * RET_CHUNK, NW_G = NW_RO + (long)NT * 2 * D_MODEL, NW_A_END = NW_G + (long)NT * 2 * D_MODEL,
    NW_KV = NW_UNION, NW_WIN = NW_KV + (long)NT * D_KV, NW_POSB = NW_WIN + (long)NT * KVROW,
    NW_HID = NW_POSB + 2 * CMP_HID, NW_CMPK = NW_HID + (long)NSEQ * NCMP * 2 * N_KV * CMP_HID, NW_CMPV = NW_CMPK + (long)NSEQ * NCMP * KVH, NW_QC = NW_CMPV + (long)NSEQ * NCMP * KVH,
    NW_QR = NW_QC + (long)NT * D_Q, NW_GATES = NW_QR + (long)NT * D_Q, NW_OC = NW_GATES + (long)NT * 3 * N_HEADS, NW_MC = NW_OC + (long)NT * D_Q, NW_LC = NW_MC + (long)NT * N_HEADS,
    NW_IMP = NW_LC + (long)NT * N_HEADS, NW_OS = NW_IMP + (long)NT * N_KV * NSEL_MAX, NW_AO = NW_OS + (long)NT * D_Q, NW_TOPI = NW_AO + (long)NT * D_Q, NW_B_END = NW_TOPI + (long)NT * N_KV * SEL_TOPK,
    NW_END = ((cmax(NW_A_END, NW_B_END) + 1023) / 1024) * 1024;

struct Tok { int s, t, T, past, pos; };
__device__ __forceinline__ Tok tok_of(int r) {
    Tok k; if (r < NP) { k.s = r / SEQ; k.t = r % SEQ; k.T = SEQ; k.past = 0; k.pos = k.t; }
    else { int q = r - NP; k.s = BATCH + q / DEC_SEQ; k.t = q % DEC_SEQ; k.T = DEC_SEQ; k.past = PAST_LEN; k.pos = PAST_LEN + k.t; } return k; }
__device__ __forceinline__ int seq_row0(int s) { return s < BATCH ? s * SEQ : NP + (s - BATCH) * DEC_SEQ; }
__device__ __forceinline__ float nv_gelu(float x) { return 0.5f * x * (1.f + tanhf(0.7978845608028654f * (x + 0.044715f * x * x * x))); }
__device__ __forceinline__ float nv_silu(float x) { return x / (1.f + expf(-x)); }
__device__ __forceinline__ float nv_loggamma(int h) { return log1pf(-exp2f(-5.f - (float)h)); }
__device__ __forceinline__ float nv_ropefreq(int i, int half) { return expf(-9.210340371976184f * (float)i / (float)half); }
__device__ __forceinline__ void chunk_of(int c, int& s, int& row0, int& L) { if (c < BATCH * NCHP) { s = c / NCHP; row0 = s * SEQ + (c % NCHP) * RET_CHUNK; L = RET_CHUNK; } else { s = BATCH + (c - BATCH * NCHP); row0 = NP + (s - BATCH) * DEC_SEQ; L = DEC_SEQ; } }
__device__ __forceinline__ int chunk_of_row(int r) { return r < NP ? (r / SEQ) * NCHP + (r % SEQ) / RET_CHUNK : BATCH * NCHP + (r - NP) / DEC_SEQ; }
__device__ __forceinline__ const float* paged_row(const float* cache, const int* pt, int b, int p) { const int page = pt[b * N_PAGES + p / PAGE_SIZE]; return cache + ((long)page * PAGE_SIZE + p % PAGE_SIZE) * KVROW; }
__device__ __forceinline__ const float* cmp_row(const NvP& p, int s, int tok) { if (s < BATCH) return p.out + O_CMPP + ((long)s * SEQ + tok) * KVROW; const int b = s - BATCH; if (tok < PAST_LEN) return paged_row(p.cache_cmp, p.page_table, b, tok); return p.out + O_CMPS + ((long)b * DEC_SEQ + tok - PAST_LEN) * KVROW; }
__device__ __forceinline__ const float* sel_row(const NvP& p, int s, int tok) { if (s < BATCH) return p.out + O_SELP + ((long)s * SEQ + tok) * KVROW; const int b = s - BATCH; if (tok < PAST_LEN) return paged_row(p.cache_sel, p.page_table, b, tok); return p.out + O_SELS + ((long)b * DEC_SEQ + tok - PAST_LEN) * KVROW; }
__device__ __forceinline__ const float* win_row(const NvP& p, int s, int tok) { if (s < BATCH) return p.winbuf + ((long)s * SEQ + tok) * KVROW; const int b = s - BATCH; if (tok < PAST_LEN) return p.cache_win + ((long)b * WIN_BUF + (tok - (PAST_LEN - WIN_BUF))) * KVROW; return p.winbuf + ((long)NP + (long)b * DEC_SEQ + tok - PAST_LEN) * KVROW; }

#define GSL(i, n) for (long i = gtid; i < (long)(n); i += gsz)

__device__ void nv_init_x(const NvP& p, long gtid, long gsz) { GSL(i, (long)NT * D_MODEL) p.x[i] = i < (long)NP * D_MODEL ? p.x_prompt[i] : p.x_sample[i - (long)NP * D_MODEL]; }
__device__ void nv_rowstat(const NvP& p, long gtid, long gsz) { GSL(r, NT) { float ss = 0.f; for (int c = 0; c < D_MODEL; ++c) { float v = p.x[r * D_MODEL + c]; ss += v * v; } p.rstd[r] = 1.f / sqrtf(ss / D_MODEL + EPS); } }
__device__ void nv_norm(const NvP& p, const float* g, long gtid, long gsz) { GSL(i, (long)NT * D_MODEL) { long r = i / D_MODEL; int c = (int)(i % D_MODEL); p.h[i] = p.x[i] * p.rstd[r] * g[c]; } }
__device__ void nv_gemm(const float* A, const float* W, float* C, int M, int N, int K, bool accum, long gtid, long gsz) {
    const int nt = N / 8, mt = (M + 7) / 8;
    GSL(ti, (long)nt * mt) { const int m0 = (int)(ti / nt) * 8, n0 = (int)(ti % nt) * 8;
        float acc[8][8];
#pragma unroll
        for (int i = 0; i < 8; ++i)
#pragma unroll
            for (int j = 0; j < 8; ++j) acc[i][j] = 0.f;
        for (int k = 0; k < K; ++k) { float w[8];
#pragma unroll
            for (int j = 0; j < 8; ++j) w[j] = W[(long)k * N + n0 + j];
#pragma unroll
            for (int i = 0; i < 8; ++i) { const int m = m0 + i < M ? m0 + i : M - 1; const float a = A[(long)m * K + k];
#pragma unroll
                for (int j = 0; j < 8; ++j) acc[i][j] += a * w[j]; } }
#pragma unroll
        for (int i = 0; i < 8; ++i) if (m0 + i < M)
#pragma unroll
            for (int j = 0; j < 8; ++j) { float* c = C + (long)(m0 + i) * N + n0 + j; *c = accum ? *c + acc[i][j] : acc[i][j]; } }
}
__device__ void nv_ret_rope(const NvP& p, long gtid, long gsz) { constexpr int half = RET_DK / 2;
    GSL(i, (long)NT * 2 * RET_HEADS * half) { int ii = (int)(i % half); long q = i / half; int hh = (int)(q % RET_HEADS); q /= RET_HEADS; int which = (int)(q % 2); int r = (int)(q / 2);
        Tok tk = tok_of(r); float ang = (float)tk.pos * nv_ropefreq(ii, half), cs = cosf(ang), sn = sinf(ang);
        float* b = p.proj + (long)r * 6 * D_MODEL + which * D_MODEL + hh * RET_DK; float x1 = b[ii], x2 = b[ii + half]; float sc = which ? 1.f / sqrtf((float)RET_DK) : 1.f;
        b[ii] = (x1 * cs - x2 * sn) * sc; b[ii + half] = (x2 * cs + x1 * sn) * sc; } }
__device__ void nv_ret_kv(const NvP& p, long gtid, long gsz) {
    GSL(i, (long)NCH * RET_HEADS * RET_DK * RET_DV) { int e = (int)(i % RET_DV); long q = i / RET_DV; int d = (int)(q % RET_DK); q /= RET_DK; int hh = (int)(q % RET_HEADS); int c = (int)(q / RET_HEADS);
        int s, row0, L; chunk_of(c, s, row0, L); const float lg = nv_loggamma(hh); float acc = 0.f;
        for (int m = 0; m < L; ++m) { const float* pr = p.proj + (long)(row0 + m) * 6 * D_MODEL; acc += pr[D_MODEL + hh * RET_DK + d] * expf((float)(L - 1 - m) * lg) * pr[2 * D_MODEL + hh * RET_DV + e]; }
        p.SB[i] = acc; } }
__device__ void nv_ret_scan(const NvP& p, int layer, long gtid, long gsz) { constexpr long HS = (long)RET_HEADS * RET_DK * RET_DV;
    GSL(i, (long)NSEQ * HS) { int s = (int)(i / HS); long j = i % HS; int hh = (int)(j / ((long)RET_DK * RET_DV)); const float lg = nv_loggamma(hh);
        float S = s < BATCH ? 0.f : p.state_ret[((long)layer * DEC_BATCH + (s - BATCH)) * HS + j];
        int c0 = s < BATCH ? s * NCHP : BATCH * NCHP + (s - BATCH), nc = s < BATCH ? NCHP : 1, L = s < BATCH ? RET_CHUNK : DEC_SEQ; const float dec = expf((float)L * lg);
        for (int c = 0; c < nc; ++c) { float* sb = p.SB + (long)(c0 + c) * HS + j; float kvv = *sb; *sb = S; S = S * dec + kvv; }
        if (s < BATCH) p.out[O_RETP + ((long)layer * BATCH + s) * HS + j] = S; else p.out[O_RETS + ((long)layer * DEC_BATCH + (s - BATCH)) * HS + j] = S; } }
__device__ void nv_ret_scores(const NvP& p, long gtid, long gsz) {
    GSL(i, (long)NCH * RET_HEADS * RET_CHUNK * RET_CHUNK) { int m = (int)(i % RET_CHUNK); long q = i / RET_CHUNK; int l = (int)(q % RET_CHUNK); q /= RET_CHUNK; int hh = (int)(q % RET_HEADS); int c = (int)(q / RET_HEADS);
        int s, row0, L; chunk_of(c, s, row0, L); float v = 0.f;
        if (l < L && m <= l) { const float* ql = p.proj + (long)(row0 + l) * 6 * D_MODEL + hh * RET_DK; const float* km = p.proj + (long)(row0 + m) * 6 * D_MODEL + D_MODEL + hh * RET_DK;
            float acc = 0.f; for (int d = 0; d < RET_DK; ++d) acc += ql[d] * km[d]; v = acc * expf((float)(l - m) * nv_loggamma(hh)); }
        p.SC[i] = v; } }
__device__ void nv_ret_out(const NvP& p, long gtid, long gsz) {
    GSL(i, (long)NT * RET_HEADS * RET_DV) { int e = (int)(i % RET_DV); long q = i / RET_DV; int hh = (int)(q % RET_HEADS); int r = (int)(q / RET_HEADS);
        int c = chunk_of_row(r), s, row0, L; chunk_of(c, s, row0, L); int l = r - row0; const float lg = nv_loggamma(hh);
        const float* sc = p.SC + (((long)c * RET_HEADS + hh) * RET_CHUNK + l) * RET_CHUNK; float acc = 0.f;
        for (int m = 0; m <= l; ++m) acc += sc[m] * p.proj[(long)(row0 + m) * 6 * D_MODEL + 2 * D_MODEL + hh * RET_DV + e];
        const float* ql = p.proj + (long)r * 6 * D_MODEL + hh * RET_DK; const float* sb = p.SB + ((long)c * RET_HEADS + hh) * RET_DK * RET_DV + e; float a2 = 0.f;
        for (int d = 0; d < RET_DK; ++d) a2 += ql[d] * sb[(long)d * RET_DV];
        p.RO[i] = acc + a2 * expf((float)(l + 1) * lg); } }
__device__ void nv_ret_gate(const NvP& p, long gtid, long gsz) {
    GSL(i, (long)NT * RET_HEADS) { int hh = (int)(i % RET_HEADS); long r = i / RET_HEADS; const float* ro = p.RO + i * RET_DV; float ss = 0.f; for (int e = 0; e < RET_DV; ++e) ss += ro[e] * ro[e];
        const float rs = 1.f / sqrtf(ss / RET_DV + EPS); const float* g = p.proj + r * 6 * D_MODEL + 4 * D_MODEL + hh * RET_DV;
        for (int e = 0; e < RET_DV; ++e) p.G[i * RET_DV + e] = ro[e] * rs * nv_silu(g[e]); } }
__device__ void nv_conv(const NvP& p, int layer, long gtid, long gsz) {
    const float* cw = p.ffn_conv_w + (long)layer * 3 * D_FF; const float* cb = p.ffn_conv_b + (long)layer * D_FF;
    GSL(i, (long)NT * D_FF) { int f = (int)(i % D_FF); int r = (int)(i / D_FF); Tok tk = tok_of(r);
        const float* pr = p.proj + (long)r * 2 * D_FF; float u0 = pr[f];
        float um1, um2;
        const float* buf = tk.s < BATCH ? nullptr : p.state_conv + (((long)layer * DEC_BATCH + (tk.s - BATCH)) * 2) * D_FF;
        um1 = tk.t >= 1 ? pr[f - 2 * D_FF] : (buf ? buf[D_FF + f] : 0.f);
        um2 = tk.t >= 2 ? pr[f - 4 * D_FF] : (buf ? buf[(long)tk.t * D_FF + f] : 0.f);
        float c = cb[f] + cw[f] * um2 + cw[D_FF + f] * um1 + cw[2 * D_FF + f] * u0;
        p.act[i] = nv_gelu(c) * pr[D_FF + f];
        if (tk.t >= tk.T - 2) { int j = tk.t - (tk.T - 2); if (tk.s < BATCH) p.out[O_CONVP + (((long)layer * BATCH + tk.s) * 2 + j) * D_FF + f] = u0; else p.out[O_CONVS + (((long)layer * DEC_BATCH + (tk.s - BATCH)) * 2 + j) * D_FF + f] = u0; } } }
__device__ void nv_kv_post(const NvP& p, long gtid, long gsz) { constexpr int half = HEAD_DIM / 2;
    GSL(i, (long)NT * 3 * N_KV) { int kh = (int)(i % N_KV); long q = i / N_KV; int br = (int)(q % 3); int r = (int)(q / 3); Tok tk = tok_of(r);
        const float* kk = p.kv + (long)r * D_KV + (2 * br) * KVH + kh * HEAD_DIM; const float* vv = kk + KVH;
        float* dst; float* dst2 = nullptr;
        if (br == 0) dst = p.out + (r < NP ? O_CMPP + (long)r * KVROW : O_CMPS + (long)(r - NP) * KVROW);
        else if (br == 1) dst = p.out + (r < NP ? O_SELP + (long)r * KVROW : O_SELS + (long)(r - NP) * KVROW);
        else { dst = p.winbuf + (long)r * KVROW;
            if (tk.s < BATCH) { if (tk.t >= SEQ - WIN_P) dst2 = p.out + O_WINP + ((long)tk.s * WIN_P + (tk.t - (SEQ - WIN_P))) * KVROW; }
            else dst2 = p.out + O_WINS + ((long)(tk.s - BATCH) * WIN_S + (WIN_S - DEC_SEQ + tk.t)) * KVROW; }
        float rs = 1.f; if (br != 0) { float ss = 0.f; _Pragma("unroll") for (int d = 0; d < HEAD_DIM; ++d) ss += kk[d] * kk[d]; rs = 1.f / sqrtf(ss / HEAD_DIM + EPS); }
        const float* gn = p.kv_knorm + br * HEAD_DIM;
        for (int d = 0; d < half; ++d) { float k1, k2;
            if (br == 0) { k1 = kk[d]; k2 = kk[d + half]; }
            else { float x1 = kk[d] * rs * gn[d], x2 = kk[d + half] * rs * gn[d + half]; float ang = (float)tk.pos * nv_ropefreq(d, half), cs = cosf(ang), sn = sinf(ang); k1 = x1 * cs - x2 * sn; k2 = x2 * cs + x1 * sn; }
            dst[kh * HEAD_DIM + d] = k1; dst[kh * HEAD_DIM + d + half] = k2; dst[KVH + kh * HEAD_DIM + d] = vv[d]; dst[KVH + kh * HEAD_DIM + d + half] = vv[d + half];
            if (dst2) { dst2[kh * HEAD_DIM + d] = k1; dst2[kh * HEAD_DIM + d + half] = k2; dst2[KVH + kh * HEAD_DIM + d] = vv[d]; dst2[KVH + kh * HEAD_DIM + d + half] = vv[d + half]; } } } }
__device__ void nv_win_copy(const NvP& p, long gtid, long gsz) { constexpr int keep = WIN_S - DEC_SEQ;
    GSL(i, (long)DEC_BATCH * keep * KVROW) { int c = (int)(i % KVROW); long q = i / KVROW; int j = (int)(q % keep); int b = (int)(q / keep);
        p.out[O_WINS + ((long)b * WIN_S + j) * KVROW + c] = p.cache_win[((long)b * WIN_BUF + (WIN_BUF - keep + j)) * KVROW + c]; } }
__device__ void nv_cmp_posb(const NvP& p, long gtid, long gsz) { GSL(i, 2 * CMP_HID) { int hh = (int)(i % CMP_HID), c = (int)(i / CMP_HID); float acc = 0.f;
        for (int ld = 0; ld < CMP_LEN * HEAD_DIM; ++ld) acc += p.cmp_pos[(long)c * CMP_LEN * HEAD_DIM + ld] * p.cmp_w1[((long)c * CMP_LEN * HEAD_DIM + ld) * CMP_HID + hh]; p.posb[i] = acc; } }
__device__ void nv_cmp_hid(const NvP& p, long gtid, long gsz) {
    GSL(i, (long)NSEQ * NCMP * 2 * N_KV * CMP_HID) { int hh = (int)(i % CMP_HID); long q = i / CMP_HID; int kh = (int)(q % N_KV); q /= N_KV; int c = (int)(q % 2); q /= 2; int n = (int)(q % NCMP); int s = (int)(q / NCMP);
        float acc = p.posb[c * CMP_HID + hh];
        for (int l = 0; l < CMP_LEN; ++l) { const float* row = cmp_row(p, s, n * CMP_STRIDE + l) + c * KVH + kh * HEAD_DIM; const float* w = p.cmp_w1 + ((long)c * CMP_LEN * HEAD_DIM + (long)l * HEAD_DIM) * CMP_HID + hh;
            _Pragma("unroll") for (int d = 0; d < HEAD_DIM; ++d) acc += row[d] * w[(long)d * CMP_HID]; }
        p.hid[i] = nv_gelu(acc); } }
__device__ void nv_cmp_out(const NvP& p, long gtid, long gsz) {
    GSL(i, (long)NSEQ * NCMP * 2 * N_KV) { int kh = (int)(i % N_KV); long q = i / N_KV; int c = (int)(q % 2); long sn = q / 2; const float* hd = p.hid + i * CMP_HID; float o[HEAD_DIM];
        _Pragma("unroll") for (int d = 0; d < HEAD_DIM; ++d) o[d] = 0.f;
        for (int hh = 0; hh < CMP_HID; ++hh) { const float hv = hd[hh]; const float* w = p.cmp_w2 + ((long)c * CMP_HID + hh) * HEAD_DIM; _Pragma("unroll") for (int d = 0; d < HEAD_DIM; ++d) o[d] += hv * w[d]; }
        if (c == 0) { float ss = 0.f; _Pragma("unroll") for (int d = 0; d < HEAD_DIM; ++d) ss += o[d] * o[d]; const float rs = 1.f / sqrtf(ss / HEAD_DIM + EPS); _Pragma("unroll") for (int d = 0; d < HEAD_DIM; ++d) p.cmpk[(sn * N_KV + kh) * HEAD_DIM + d] = o[d] * rs * p.kv_knorm[d]; }
        else _Pragma("unroll") for (int d = 0; d < HEAD_DIM; ++d) p.cmpv[(sn * N_KV + kh) * HEAD_DIM + d] = o[d]; } }
__device__ void nv_q_post(const NvP& p, int j, long gtid, long gsz) { constexpr int half = HEAD_DIM / 2; const float* gn = p.nsa_qnorm + (long)j * HEAD_DIM;
    GSL(i, (long)NT * N_HEADS) { int hd = (int)(i % N_HEADS); int r = (int)(i / N_HEADS); Tok tk = tok_of(r); const float* qq = p.proj + (long)r * D_QG + hd * HEAD_DIM;
        float ss = 0.f; _Pragma("unroll") for (int d = 0; d < HEAD_DIM; ++d) ss += qq[d] * qq[d]; const float rs = 1.f / sqrtf(ss / HEAD_DIM + EPS);
        for (int d = 0; d < half; ++d) { float x1 = qq[d] * rs * gn[d], x2 = qq[d + half] * rs * gn[d + half]; float ang = (float)tk.pos * nv_ropefreq(d, half), cs = cosf(ang), sn = sinf(ang);
            p.qc[i * HEAD_DIM + d] = x1; p.qc[i * HEAD_DIM + d + half] = x2; p.qr[i * HEAD_DIM + d] = x1 * cs - x2 * sn; p.qr[i * HEAD_DIM + d + half] = x2 * cs + x1 * sn; }
        for (int g = 0; g < 3; ++g) p.gates[i * 3 + g] = 1.f / (1.f + expf(-p.proj[(long)r * D_QG + D_Q + hd * 3 + g])); } }
__device__ __forceinline__ int n_cmp_valid(int pos) { int n = pos - (CMP_LEN - 1); if (n < 0) return 0; n = n / CMP_STRIDE + 1; return n < NCMP ? n : NCMP; }
__device__ void nv_nsa_cmp(const NvP& p, long gtid, long gsz) { const float scale = 1.f / sqrtf((float)HEAD_DIM);
    GSL(i, (long)NT * N_HEADS) { int hd = (int)(i % N_HEADS); int r = (int)(i / N_HEADS); Tok tk = tok_of(r); const int kh = hd / GROUP, nc = n_cmp_valid(tk.pos);
        const float* q = p.qc + i * HEAD_DIM; const float* K = p.cmpk + ((long)tk.s * NCMP * N_KV + kh) * HEAD_DIM; const float* V = p.cmpv + ((long)tk.s * NCMP * N_KV + kh) * HEAD_DIM;
        float m = NEG_INF; for (int n = 0; n < nc; ++n) { float a = 0.f; _Pragma("unroll") for (int d = 0; d < HEAD_DIM; ++d) a += q[d] * K[(long)n * KVH + d]; a *= scale; m = a > m ? a : m; }
        float l = 0.f, o[HEAD_DIM]; _Pragma("unroll") for (int d = 0; d < HEAD_DIM; ++d) o[d] = 0.f;
        for (int n = 0; n < nc; ++n) { float a = 0.f; _Pragma("unroll") for (int d = 0; d < HEAD_DIM; ++d) a += q[d] * K[(long)n * KVH + d]; const float e = expf(a * scale - m); l += e; _Pragma("unroll") for (int d = 0; d < HEAD_DIM; ++d) o[d] += e * V[(long)n * KVH + d]; }
        const float inv = 1.f / (l > TINY ? l : TINY); _Pragma("unroll") for (int d = 0; d < HEAD_DIM; ++d) p.oc[i * HEAD_DIM + d] = o[d] * inv; p.mc[i] = m; p.lc[i] = l; } }
__device__ void nv_nsa_imp(const NvP& p, long gtid, long gsz) { const float scale = 1.f / sqrtf((float)HEAD_DIM);
    GSL(i, (long)NT * N_KV * NSEL_MAX) { int sb = (int)(i % NSEL_MAX); long q = i / NSEL_MAX; int kh = (int)(q % N_KV); int r = (int)(q / N_KV); Tok tk = tok_of(r); const int nc = n_cmp_valid(tk.pos);
        const int nsel = tk.s < BATCH ? NSEL_P : NSEL_S; float v;
        if (sb >= nsel) v = -3e6f;
        else { const int cur = tk.pos / SEL_BLOCK;
            if (sb == 0 || sb == cur || sb == cur - 1) v = SEL_FORCE; else if (sb * SEL_BLOCK > tk.pos) v = SEL_NEG;
            else { float acc = 0.f; const float* K = p.cmpk + ((long)tk.s * NCMP * N_KV + kh) * HEAD_DIM;
                for (int n = 4 * sb - 1; n <= 4 * sb + 3; ++n) { if (n < 0 || n >= nc) continue;
                    int lo = n * CMP_STRIDE > sb * SEL_BLOCK ? n * CMP_STRIDE : sb * SEL_BLOCK, hi = n * CMP_STRIDE + CMP_LEN < (sb + 1) * SEL_BLOCK ? n * CMP_STRIDE + CMP_LEN : (sb + 1) * SEL_BLOCK; if (hi <= lo) continue; const float w = (float)(hi - lo) / CMP_LEN;
                    for (int g = 0; g < GROUP; ++g) { const int hd = kh * GROUP + g; const float* qq = p.qc + ((long)r * N_HEADS + hd) * HEAD_DIM; float a = 0.f; _Pragma("unroll") for (int d = 0; d < HEAD_DIM; ++d) a += qq[d] * K[(long)n * KVH + d];
                        const float l = p.lc[(long)r * N_HEADS + hd]; acc += w * expf(a * scale - p.mc[(long)r * N_HEADS + hd]) / (l > TINY ? l : TINY); } }
                v = acc; } }
        p.imp[i] = v; } }
__device__ void nv_nsa_topk(const NvP& p, long gtid, long gsz) {
    GSL(i, (long)NT * N_KV) { int r = (int)(i / N_KV); Tok tk = tok_of(r); const int nsel = tk.s < BATCH ? NSEL_P : NSEL_S; const float* im = p.imp + i * NSEL_MAX; unsigned long long t0 = 0, t1 = 0, t2 = 0;
        for (int k = 0; k < SEL_TOPK; ++k) { float best = -4e6f; int bi = -1;
            for (int sb = 0; sb < nsel; ++sb) { const bool taken = sb < 64 ? (t0 >> sb) & 1 : sb < 128 ? (t1 >> (sb - 64)) & 1 : (t2 >> (sb - 128)) & 1; if (!taken && im[sb] > best) { best = im[sb]; bi = sb; } }
            if (bi >= 0) { if (bi < 64) t0 |= 1ull << bi; else if (bi < 128) t1 |= 1ull << (bi - 64); else t2 |= 1ull << (bi - 128); }
            p.topi[i * SEL_TOPK + k] = (bi >= 0 && best > 0.5f * SEL_NEG) ? bi : -1; } } }
__device__ void nv_nsa_sel(const NvP& p, long gtid, long gsz) { const float scale = 1.f / sqrtf((float)HEAD_DIM);
    GSL(i, (long)NT * N_HEADS) { int hd = (int)(i % N_HEADS); int r = (int)(i / N_HEADS); Tok tk = tok_of(r); const int kh = hd / GROUP; const float* q = p.qr + i * HEAD_DIM; const int* ti = p.topi + ((long)r * N_KV + kh) * SEL_TOPK;
        float m = NEG_INF;
        for (int k = 0; k < SEL_TOPK; ++k) { const int sb = ti[k]; if (sb < 0) continue; for (int j = 0; j < SEL_BLOCK; ++j) { const int tok = sb * SEL_BLOCK + j; if (tok > tk.pos) break; const float* kr = sel_row(p, tk.s, tok) + kh * HEAD_DIM; float a = 0.f; _Pragma("unroll") for (int d = 0; d < HEAD_DIM; ++d) a += q[d] * kr[d]; a *= scale; m = a > m ? a : m; } }
        float l = 0.f, o[HEAD_DIM]; _Pragma("unroll") for (int d = 0; d < HEAD_DIM; ++d) o[d] = 0.f;
        for (int k = 0; k < SEL_TOPK; ++k) { const int sb = ti[k]; if (sb < 0) continue; for (int j = 0; j < SEL_BLOCK; ++j) { const int tok = sb * SEL_BLOCK + j; if (tok > tk.pos) break; const float* kr = sel_row(p, tk.s, tok) + kh * HEAD_DIM; float a = 0.f; _Pragma("unroll") for (int d = 0; d < HEAD_DIM; ++d) a += q[d] * kr[d];
                const float e = expf(a * scale - m); l += e; const float* vr = kr + KVH; _Pragma("unroll") for (int d = 0; d < HEAD_DIM; ++d) o[d] += e * vr[d]; } }
        const float inv = 1.f / (l > TINY ? l : TINY); _Pragma("unroll") for (int d = 0; d < HEAD_DIM; ++d) p.os[i * HEAD_DIM + d] = o[d] * inv; } }
__device__ void nv_nsa_win(const NvP& p, long gtid, long gsz) { const float scale = 1.f / sqrtf((float)HEAD_DIM);
    GSL(i, (long)NT * N_HEADS) { int hd = (int)(i % N_HEADS); int r = (int)(i / N_HEADS); Tok tk = tok_of(r); const int kh = hd / GROUP; const float* q = p.qr + i * HEAD_DIM;
        int lo = tk.pos - WINDOW + 1; if (lo < 0) lo = 0; if (lo < tk.past - WIN_BUF) lo = tk.past - WIN_BUF;
        float m = NEG_INF; for (int tok = lo; tok <= tk.pos; ++tok) { const float* kr = win_row(p, tk.s, tok) + kh * HEAD_DIM; float a = 0.f; _Pragma("unroll") for (int d = 0; d < HEAD_DIM; ++d) a += q[d] * kr[d]; a *= scale; m = a > m ? a : m; }
        float l = 0.f, o[HEAD_DIM]; _Pragma("unroll") for (int d = 0; d < HEAD_DIM; ++d) o[d] = 0.f;
        for (int tok = lo; tok <= tk.pos; ++tok) { const float* kr = win_row(p, tk.s, tok) + kh * HEAD_DIM; float a = 0.f; _Pragma("unroll") for (int d = 0; d < HEAD_DIM; ++d) a += q[d] * kr[d]; const float e = expf(a * scale - m); l += e; const float* vr = kr + KVH; _Pragma("unroll") for (int d = 0; d < HEAD_DIM; ++d) o[d] += e * vr[d]; }
        const float inv = 1.f / (l > TINY ? l : TINY); const float* g = p.gates + i * 3;
        _Pragma("unroll") for (int d = 0; d < HEAD_DIM; ++d) p.ao[i * HEAD_DIM + d] = g[0] * p.oc[i * HEAD_DIM + d] + g[1] * p.os[i * HEAD_DIM + d] + g[2] * o[d] * inv; } }
enum NvPhase { NV_INIT, NV_ROWSTAT, NV_NORM_MIX, NV_NORM_FFN, NV_NORM_KV, NV_G_RETIN, NV_RET_ROPE, NV_RET_KV, NV_RET_SCAN, NV_RET_SCORES, NV_RET_OUT, NV_RET_GATE, NV_G_RETOUT, NV_G_FFNIN, NV_CONV, NV_G_FFNOUT,
    NV_G_KV, NV_KV_POST, NV_WIN_COPY, NV_CMP_POSB, NV_CMP_HID, NV_CMP_OUT, NV_G_QG, NV_Q_POST, NV_NSA_CMP, NV_NSA_IMP, NV_NSA_TOPK, NV_NSA_SEL, NV_NSA_WIN, NV_G_WO, NV_NPH };
__device__ void nv_dispatch(const NvP& p, int ph, int a, long gtid, long gsz) {
    switch (ph) {
    case NV_INIT: nv_init_x(p, gtid, gsz); break;
    case NV_ROWSTAT: nv_rowstat(p, gtid, gsz); break;
    case NV_NORM_MIX: nv_norm(p, p.norm_mix + (long)a * D_MODEL, gtid, gsz); break;
    case NV_NORM_FFN: nv_norm(p, p.norm_ffn + (long)a * D_MODEL, gtid, gsz); break;
    case NV_NORM_KV: nv_norm(p, p.kv_norm, gtid, gsz); break;
    case NV_G_RETIN: nv_gemm(p.h, p.ret_w_in + (long)a * D_MODEL * 6 * D_MODEL, p.proj, NT, 6 * D_MODEL, D_MODEL, false, gtid, gsz); break;
    case NV_RET_ROPE: nv_ret_rope(p, gtid, gsz); break;
    case NV_RET_KV: nv_ret_kv(p, gtid, gsz); break;
    case NV_RET_SCAN: nv_ret_scan(p, a, gtid, gsz); break;
    case NV_RET_SCORES: nv_ret_scores(p, gtid, gsz); break;
    case NV_RET_OUT: nv_ret_out(p, gtid, gsz); break;
    case NV_RET_GATE: nv_ret_gate(p, gtid, gsz); break;
    case NV_G_RETOUT: nv_gemm(p.G, p.ret_w_out + (long)a * 2 * D_MODEL * D_MODEL, p.x, NT, D_MODEL, 2 * D_MODEL, true, gtid, gsz); break;
    case NV_G_FFNIN: nv_gemm(p.h, p.ffn_w_in + (long)a * D_MODEL * 2 * D_FF, p.proj, NT, 2 * D_FF, D_MODEL, false, gtid, gsz); break;
    case NV_CONV: nv_conv(p, a, gtid, gsz); break;
    case NV_G_FFNOUT: nv_gemm(p.act, p.ffn_w_out + (long)a * D_FF * D_MODEL, p.x, NT, D_MODEL, D_FF, true, gtid, gsz); break;
    case NV_G_KV: nv_gemm(p.h, p.kv_w, p.kv, NT, D_KV, D_MODEL, false, gtid, gsz); break;
    case NV_KV_POST: nv_kv_post(p, gtid, gsz); break;
    case NV_WIN_COPY: nv_win_copy(p, gtid, gsz); break;
    case NV_CMP_POSB: nv_cmp_posb(p, gtid, gsz); break;
    case NV_CMP_HID: nv_cmp_hid(p, gtid, gsz); break;
    case NV_CMP_OUT: nv_cmp_out(p, gtid, gsz); break;
    case NV_G_QG: nv_gemm(p.h, p.nsa_w_qg + (long)a * D_MODEL * D_QG, p.proj, NT, D_QG, D_MODEL, false, gtid, gsz); break;
    case NV_Q_POST: nv_q_post(p, a, gtid, gsz); break;
    case NV_NSA_CMP: nv_nsa_cmp(p, gtid, gsz); break;
    case NV_NSA_IMP: nv_nsa_imp(p, gtid, gsz); break;
    case NV_NSA_TOPK: nv_nsa_topk(p, gtid, gsz); break;
    case NV_NSA_SEL: nv_nsa_sel(p, gtid, gsz); break;
    case NV_NSA_WIN: nv_nsa_win(p, gtid, gsz); break;
    case NV_G_WO: nv_gemm(p.ao, p.nsa_w_o + (long)a * D_Q * D_MODEL, p.x, NT, D_MODEL, D_Q, true, gtid, gsz); break;
    default: break; }
}
struct NvStep { int ph, a; };
template <class PT> __host__ __device__ inline int nv_program(PT st) { int n = 0;
#define S_(ph_, a_) do { st[n].ph = (ph_); st[n].a = (a_); ++n; } while (0)
    S_(NV_INIT, 0);
    for (int l = 0; l < DEPTH; ++l) {
        if (l == N_A) { S_(NV_ROWSTAT, 0); S_(NV_NORM_KV, 0); S_(NV_G_KV, 0); S_(NV_KV_POST, 0); S_(NV_WIN_COPY, 0); S_(NV_CMP_POSB, 0); S_(NV_CMP_HID, 0); S_(NV_CMP_OUT, 0); }
        S_(NV_ROWSTAT, 0); S_(NV_NORM_MIX, l);
        if (l < N_A) { S_(NV_G_RETIN, l); S_(NV_RET_ROPE, 0); S_(NV_RET_KV, 0); S_(NV_RET_SCAN, l); S_(NV_RET_SCORES, 0); S_(NV_RET_OUT, 0); S_(NV_RET_GATE, 0); S_(NV_G_RETOUT, l); }
        else { const int j = l - N_A; S_(NV_G_QG, j); S_(NV_Q_POST, j); S_(NV_NSA_CMP, 0); S_(NV_NSA_IMP, 0); S_(NV_NSA_TOPK, 0); S_(NV_NSA_SEL, 0); S_(NV_NSA_WIN, 0); S_(NV_G_WO, j); }
        S_(NV_ROWSTAT, 0); S_(NV_NORM_FFN, l); S_(NV_G_FFNIN, l); S_(NV_CONV, l); S_(NV_G_FFNOUT, l);
    }
#undef S_
    return n; }
static void nv_fill_params(NvP& p, void* const* d_in, float* out, float* ws) {
    p.x_prompt = (const float*)d_in[0]; p.x_sample = (const float*)d_in[1]; p.cache_cmp = (const float*)d_in[2]; p.cache_sel = (const float*)d_in[3]; p.cache_win = (const float*)d_in[4];
    p.state_ret = (const float*)d_in[5]; p.state_conv = (const float*)d_in[6]; p.page_table = (const int*)d_in[7]; p.norm_mix = (const float*)d_in[8]; p.norm_ffn = (const float*)d_in[9];
    p.ret_w_in = (const float*)d_in[10]; p.ret_w_out = (const float*)d_in[11]; p.ffn_w_in = (const float*)d_in[12]; p.ffn_conv_w = (const float*)d_in[13]; p.ffn_conv_b = (const float*)d_in[14];
    p.ffn_w_out = (const float*)d_in[15]; p.kv_norm = (const float*)d_in[16]; p.kv_w = (const float*)d_in[17]; p.kv_knorm = (const float*)d_in[18]; p.cmp_pos = (const float*)d_in[19];
    p.cmp_w1 = (const float*)d_in[20]; p.cmp_w2 = (const float*)d_in[21]; p.nsa_w_qg = (const float*)d_in[22]; p.nsa_qnorm = (const float*)d_in[23]; p.nsa_w_o = (const float*)d_in[24];
    p.out = out; p.x = out + O_YP;
    p.rstd = ws + NW_RSTD; p.h = ws + NW_H; p.proj = ws + NW_PROJ; p.SB = ws + NW_SB; p.SC = ws + NW_SC; p.RO = ws + NW_RO; p.G = ws + NW_G; p.act = ws + NW_ACT; p.kv = ws + NW_KV; p.winbuf = ws + NW_WIN;
    p.posb = ws + NW_POSB; p.hid = ws + NW_HID; p.cmpk = ws + NW_CMPK; p.cmpv = ws + NW_CMPV; p.qc = ws + NW_QC; p.qr = ws + NW_QR; p.gates = ws + NW_GATES; p.oc = ws + NW_OC; p.mc = ws + NW_MC; p.lc = ws + NW_LC;
    p.imp = ws + NW_IMP; p.os = ws + NW_OS; p.ao = ws + NW_AO; p.topi = (int*)(ws + NW_TOPI);
}
#define XB_TMO      128
#define XB_XCNT(j)  (256  + 64 * (j))
#define XB_XSUB(j)  (1280 + 64 * (j))
#define XB_XGEN(j)  (2304 + 64 * (j))
#define XB_TOP      3328
#define XB_TOPGEN   3392
#define XCD_BAR_WORDS 3456
#define XB_SPIN_CAP (1u << 18)
#define LAS __attribute__((address_space(3)))

__device__ __forceinline__ unsigned xb_ld(unsigned* p)              { return __hip_atomic_load(p, __ATOMIC_RELAXED, __HIP_MEMORY_SCOPE_AGENT); }
__device__ __forceinline__ unsigned xb_add(unsigned* p, unsigned v) { return __hip_atomic_fetch_add(p, v, __ATOMIC_RELAXED, __HIP_MEMORY_SCOPE_AGENT); }
__device__ __forceinline__ unsigned xb_xcc_id() { return (unsigned)__builtin_amdgcn_s_getreg((3 << 11) | 20) & 0xFu; }
#define XB_SPIN(cond, bar) do { unsigned _sp = 0; while (cond) { __builtin_amdgcn_s_sleep(1); \
    if ((++_sp & 255u) == 0u) { if (xb_ld(&(bar)[XB_TMO])) break; if (_sp > XB_SPIN_CAP) { atomicAdd(&(bar)[XB_TMO], 1u); break; } } } } while (0)

struct XcdBarrier {
    unsigned* bar; unsigned x;
    volatile LAS unsigned* st;
};

__device__ __forceinline__ XcdBarrier xcd_barrier_post(unsigned* bar, volatile LAS unsigned* st) {
    XcdBarrier b; b.bar = bar; b.x = xb_xcc_id(); b.st = st;
    if (threadIdx.x == 0) (void)xb_add(&bar[XB_XCNT(b.x)], 1u);
    return b;
}
__device__ __forceinline__ void xcd_barrier_complete(unsigned* bar, unsigned x, unsigned& nloc, unsigned& nx) {
    const unsigned G = gridDim.x * gridDim.y * gridDim.z;
    unsigned sum, cnt, mine, sp = 0u;
    for (;;) {
        sum = 0u; cnt = 0u; mine = 0u;
#pragma unroll
        for (unsigned j = 0; j < 16; ++j) { const unsigned c = xb_ld(&bar[XB_XCNT(j)]); sum += c; cnt += (c > 0u) ? 1u : 0u; mine = (j == x) ? c : mine; }
        if (sum == G) break;
        __builtin_amdgcn_s_sleep(1);
        if ((++sp & 255u) == 0u) { if (xb_ld(&bar[XB_TMO])) break; if (sp > XB_SPIN_CAP) { atomicAdd(&bar[XB_TMO], 1u); break; } }
    }
    nloc = mine > 0u ? mine : 1u; nx = cnt > 0u ? cnt : 1u;
}

__device__ __forceinline__ void xcd_barrier(const XcdBarrier& b) {
    asm volatile("s_waitcnt vmcnt(0)" ::: "memory");
    __syncthreads();
    if (threadIdx.x == 0) {
        unsigned* bar = b.bar;
        __builtin_amdgcn_s_waitcnt(0);
        unsigned nloc = b.st[0], nx = b.st[1];
        if (nloc == 0u) { xcd_barrier_complete(bar, b.x, nloc, nx); b.st[0] = nloc; b.st[1] = nx; }
        const unsigned old = xb_add(&bar[XB_XSUB(b.x)], 1u);
        const unsigned gen = old / nloc;
        if (old + 1u == (gen + 1u) * nloc) {
            __builtin_amdgcn_fence(__ATOMIC_RELEASE, "agent");
            asm volatile("s_waitcnt vmcnt(0)" ::: "memory");
            const unsigned og = xb_add(&bar[XB_TOP], 1u);
            const unsigned tg = og / nx;
            if (og + 1u == (tg + 1u) * nx) xb_add(&bar[XB_TOPGEN], 1u);
            else XB_SPIN(xb_ld(&bar[XB_TOPGEN]) == tg, bar);
            __builtin_amdgcn_fence(__ATOMIC_ACQUIRE, "agent");
            xb_add(&bar[XB_XGEN(b.x)], 1u);
            asm volatile("s_waitcnt vmcnt(0)" ::: "memory");
        } else {
            XB_SPIN(xb_ld(&bar[XB_XGEN(b.x)]) == gen, bar);
            __builtin_amdgcn_fence(__ATOMIC_ACQUIRE, "agent");
            asm volatile("s_waitcnt vmcnt(0)" ::: "memory");
        }
    }
    __syncthreads();
}
namespace pg8 {
#define PG8_LAS __attribute__((address_space(3)))
typedef unsigned short bf16_t;
typedef short bf16x8 __attribute__((ext_vector_type(8)));
typedef float f32x4 __attribute__((ext_vector_type(4)));
typedef float f32x2 __attribute__((ext_vector_type(2)));
typedef unsigned u32x4 __attribute__((ext_vector_type(4)));
typedef unsigned u32x2 __attribute__((ext_vector_type(2)));
constexpr int BM = 256, BK = 64, HALF = 128, HTB = HALF * BK * 2, STAGE_BYTES = 8 * HTB;
__host__ __device__ __forceinline__ int lds_byte(int r, int c) { const int st = (r >> 4) * 2 + (c >> 5), rr = r & 15, cc = c & 31, ob = rr * 64 + cc * 2; return st * 1024 + (ob ^ (((ob >> 9) & 1) << 5)); }
__host__ __device__ __forceinline__ void stage_rc(int b, int& R, int& C) { const int st = b / 1024, sb = b % 1024, swz = sb ^ (((sb >> 9) & 1) << 5); R = (st >> 1) * 16 + swz / 64; C = (st & 1) * 32 + (swz % 64) / 2; }
__host__ __device__ __forceinline__ int perm32(int rho) { const int n = rho >> 4, i = rho & 15; return 8 * (i >> 2) + 4 * n + (i & 3); }
struct Unit { int pm, pn, nt, aux; const char* A; const char* B; };
__device__ __forceinline__ unsigned cvt_pk_bf16(float lo, float hi) { unsigned r; asm volatile("v_cvt_pk_bf16_f32 %0, %1, %2" : "=v"(r) : "v"(lo), "v"(hi)); return r; }
template <class Epi, class Sched>
__device__ __forceinline__ void gemm_phase(PG8_LAS unsigned char* lds, const int lda, const int ldb, const Sched& S, const Epi& E) {
    int tid_ = threadIdx.x; asm volatile("" : "+v"(tid_));
    const int tid = tid_, wid = __builtin_amdgcn_readfirstlane(tid >> 6), lane = tid & 63, wr = wid >> 2, wc = wid & 3, fr = lane & 15, fq = lane >> 4;
    unsigned voffA[2], voffB[2];
#pragma unroll
    for (int i = 0; i < 2; ++i) { int R, C; stage_rc(tid * 16 + i * 8192, R, C); const int Rb = (R & ~31) + perm32(R & 31);
        voffA[i] = (unsigned)(R * lda + C) * 2u; voffB[i] = (unsigned)(Rb * ldb + C) * 2u; }
    const size_t kstep = (size_t)(BK * 2);
    const size_t hstepA = (size_t)HALF * lda * 2, hstepB = (size_t)HALF * ldb * 2;
    const unsigned ldsw = (unsigned)wid * 1024u;
    const int aoff = lds_byte(wr * 64 + fr, fq * 8), boff = lds_byte(wc * 32 + fr, fq * 8);
#define PG8_SA(b, h) (((b) * 2 + (h)) * HTB)
#define PG8_SB(b, h) ((4 + (b) * 2 + (h)) * HTB)
#define PG8_STAGE(bufoff, gbase, voff) do { _Pragma("unroll") for (int _i = 0; _i < 2; ++_i) \
        __builtin_amdgcn_global_load_lds((const unsigned*)((const char*)(gbase) + (voff)[_i]), (PG8_LAS unsigned*)(lds + (bufoff) + ldsw + _i * 8192), 16, 0, 0); } while (0)
#define PG8_LDA(dst, b, h) do { _Pragma("unroll") for (int m = 0; m < 4; ++m) _Pragma("unroll") for (int k = 0; k < 2; ++k) dst[m][k] = *(const PG8_LAS bf16x8*)(lds + PG8_SA(b, h) + aoff + m * 2048 + k * 1024); } while (0)
#define PG8_LDB(dst, b, h) do { _Pragma("unroll") for (int n = 0; n < 2; ++n) _Pragma("unroll") for (int k = 0; k < 2; ++k) dst[n][k] = *(const PG8_LAS bf16x8*)(lds + PG8_SB(b, h) + boff + n * 2048 + k * 1024); } while (0)
#define PG8_MMA(ai, bj, At, Bt) do { __builtin_amdgcn_s_setprio(1); _Pragma("unroll") for (int m = 0; m < 4; ++m) _Pragma("unroll") for (int n = 0; n < 2; ++n) _Pragma("unroll") for (int k = 0; k < 2; ++k) \
        acc[ai][bj][m][n] = __builtin_amdgcn_mfma_f32_16x16x32_bf16(Bt[n][k], At[m][k], acc[ai][bj][m][n], 0, 0, 0); __builtin_amdgcn_s_setprio(0); } while (0)
#define PG8_WAIT_V(n) asm volatile("s_waitcnt vmcnt(" #n ")" ::: "memory")
#define PG8_WAIT_L(n) asm volatile("s_waitcnt lgkmcnt(" #n ")" ::: "memory")
#define PG8_BAR __builtin_amdgcn_s_barrier()
#define PG8_SCHED __builtin_amdgcn_sched_barrier(0)
    Unit cur, nxt; int ui = 0;
    if (!S.next(0, cur)) return;
    f32x4 acc[2][2][4][2];
#pragma unroll
    for (int a = 0; a < 2; ++a)
#pragma unroll
        for (int b = 0; b < 2; ++b)
#pragma unroll
            for (int m = 0; m < 4; ++m)
#pragma unroll
                for (int n = 0; n < 2; ++n) acc[a][b][m][n] = (f32x4){0.f, 0.f, 0.f, 0.f};
    bf16x8 At[4][2], B0[2][2], B1[2][2];
    const char* cA = cur.A; const char* cB = cur.B;
    PG8_STAGE(PG8_SB(0, 0), cB, voffB); PG8_STAGE(PG8_SB(0, 1), cB + hstepB, voffB); PG8_STAGE(PG8_SA(0, 0), cA, voffA); PG8_STAGE(PG8_SA(0, 1), cA + hstepA, voffA);
    if (wr == 1) PG8_BAR;
    PG8_WAIT_V(2); PG8_BAR;
    PG8_STAGE(PG8_SB(1, 0), cB + kstep, voffB); PG8_STAGE(PG8_SA(1, 0), cA + kstep, voffA); PG8_STAGE(PG8_SB(1, 1), cB + hstepB + kstep, voffB);
    PG8_WAIT_V(6); PG8_BAR;
    for (;;) {
        const bool has_next = S.next(ui + 1, nxt);
        const char* nA = has_next ? nxt.A : cA; const char* nB = has_next ? nxt.B : cB;
        const int nt = cur.nt;
        for (int t = 0; t < nt; t += 2) {
            const bool last = (t == nt - 2);
            const char* a1 = cA + (size_t)(t + 1) * kstep;
            const char* a2 = last ? nA : cA + (size_t)(t + 2) * kstep; const char* b2 = last ? nB : cB + (size_t)(t + 2) * kstep;
            const char* a3 = a2 + kstep; const char* b3 = b2 + kstep;
            PG8_LDB(B0, 0, 0); PG8_LDB(B1, 0, 1); PG8_SCHED; PG8_LDA(At, 0, 0); PG8_STAGE(PG8_SA(1, 1), a1 + hstepA, voffA);
            PG8_WAIT_V(8); PG8_WAIT_L(0); PG8_BAR; PG8_MMA(0, 0, At, B0); PG8_MMA(0, 1, At, B1); PG8_BAR; PG8_SCHED;
            PG8_LDA(At, 0, 1); PG8_STAGE(PG8_SB(0, 0), b2, voffB); PG8_STAGE(PG8_SB(0, 1), b2 + hstepB, voffB); PG8_STAGE(PG8_SA(0, 0), a2, voffA);
            PG8_WAIT_V(8); PG8_WAIT_L(0); PG8_BAR; PG8_MMA(1, 0, At, B0); PG8_MMA(1, 1, At, B1); PG8_BAR; PG8_SCHED;
            PG8_LDB(B0, 1, 0); PG8_LDB(B1, 1, 1); PG8_SCHED; PG8_LDA(At, 1, 0); PG8_STAGE(PG8_SA(0, 1), a2 + hstepA, voffA);
            PG8_WAIT_V(8); PG8_WAIT_L(0); PG8_BAR; PG8_MMA(0, 0, At, B0); PG8_MMA(0, 1, At, B1); PG8_BAR; PG8_SCHED;
            PG8_LDA(At, 1, 1); PG8_STAGE(PG8_SB(1, 0), b3, voffB); PG8_STAGE(PG8_SB(1, 1), b3 + hstepB, voffB); PG8_STAGE(PG8_SA(1, 0), a3, voffA);
            PG8_WAIT_V(8); PG8_WAIT_L(0); PG8_BAR; PG8_MMA(1, 0, At, B0); PG8_MMA(1, 1, At, B1); PG8_BAR; PG8_SCHED;
        }
        if (wr == 0) PG8_BAR;
        E(acc, cur, wr, wc, fr, fq);
        if (!has_next) break;
#pragma unroll
        for (int a = 0; a < 2; ++a)
#pragma unroll
            for (int b = 0; b < 2; ++b)
#pragma unroll
                for (int m = 0; m < 4; ++m)
#pragma unroll
                    for (int n = 0; n < 2; ++n) acc[a][b][m][n] = (f32x4){0.f, 0.f, 0.f, 0.f};
        cur = nxt; cA = nA; cB = nB; ++ui;
        if (wr == 1) PG8_BAR;
    }
    PG8_WAIT_V(0);
    PG8_BAR;
#undef PG8_SA
#undef PG8_SB
#undef PG8_STAGE
#undef PG8_LDA
#undef PG8_LDB
#undef PG8_MMA
#undef PG8_WAIT_V
#undef PG8_WAIT_L
#undef PG8_BAR
#undef PG8_SCHED
}
}
#define GAS __attribute__((address_space(1)))
typedef unsigned short bf16;
typedef float f32x4 __attribute__((ext_vector_type(4)));
typedef float f32x2 __attribute__((ext_vector_type(2)));
typedef unsigned u32x4 __attribute__((ext_vector_type(4)));
typedef unsigned u32x2 __attribute__((ext_vector_type(2)));
constexpr int NWAVES = 8, MK_THREADS = 512, MK_LDS = 151552;
constexpr int NPAN = NT / 256;
static_assert(NT % 256 == 0 && NP % 256 == 0 && NS == 256, "row panels");
constexpr int SCH = 512, NSCH = SEQ / SCH;
constexpr int CATK = RET_DK + SCH;
constexpr int N_KVQG = 2816, N_QG1 = 1280;
constexpr int ROPE_NPOS = PAST_LEN + DEC_SEQ;
constexpr int SELP = 8256;
constexpr int WINS = 544;
constexpr size_t MiB = 1u << 20;
constexpr size_t OW_CTL = 0, OW_CTL_BYTES = 1 * MiB;
constexpr size_t OW_WRETIN = 2 * MiB, OW_WRETOUT = 26 * MiB, OW_WFFNIN = 34 * MiB, OW_WFFNOUT = 78 * MiB, OW_WKVQG = 100 * MiB, OW_WQG1 = 106 * MiB, OW_WWO = 109 * MiB, OW_WCMP1 = 113 * MiB;
constexpr size_t OW_TABR = 114 * MiB, OW_TABN = 123 * MiB, OW_XB = 126 * MiB, OW_SSQ = 159 * MiB, OW_POSB = 161 * MiB;
constexpr size_t OW_CMPK = 162 * MiB, OW_CMPVT = 171 * MiB, OW_QC = 180 * MiB, OW_QR = 213 * MiB, OW_GATES = 246 * MiB, OW_AO = 250 * MiB;
constexpr size_t OW_SK = 283 * MiB, OW_SVT = 291 * MiB, OW_WK = 299 * MiB, OW_WVT = 307 * MiB, OW_WKS = 315 * MiB, OW_WVTS = 324 * MiB, OW_R1 = 334 * MiB;
constexpr size_t OW_QP = OW_R1, OW_KP = OW_QP + 33 * MiB, OW_ACAT = OW_KP + 33 * MiB, OW_BCAT = OW_ACAT + 96 * MiB, OW_KDT = OW_BCAT + 96 * MiB, OW_KVS = OW_KDT + 32 * MiB,
    OW_O = OW_KVS + 64 * MiB, OW_SG = OW_O + 65 * MiB, OW_G = OW_SG + 65 * MiB, OW_SQKV = OW_G + 65 * MiB, OW_RET_END = OW_SQKV + 4 * MiB;
constexpr size_t OW_U = OW_R1, OW_GT = OW_U + 90 * MiB, OW_ACT = OW_GT + 90 * MiB, OW_FFN_END = OW_ACT + 90 * MiB;
constexpr size_t OW_ASUB = OW_R1 + 270 * MiB, OW_PART = OW_ASUB + 272 * MiB, OW_CMP_END = OW_PART + 68 * MiB;
constexpr size_t OW_SKS = OW_R1 + 270 * MiB, OW_SVTS = OW_SKS + 130 * MiB, OW_SELS_END = OW_SVTS + 130 * MiB;
constexpr size_t OW_SPLITK = OW_R1 + 612 * MiB;
constexpr size_t OW_END = OW_SPLITK + 8 * MiB;
static_assert(OW_RET_END <= OW_END && OW_FFN_END <= OW_ASUB && OW_CMP_END <= OW_END && OW_SELS_END <= OW_END, "R1 map");
static_assert((size_t)2 * 6144 * 1024 * 2 <= OW_WRETOUT - OW_WRETIN && (size_t)4 * 5632 * 1024 * 2 <= OW_WFFNOUT - OW_WFFNIN && (size_t)4 * 1024 * 2816 * 2 <= OW_WKVQG - OW_WFFNOUT && (size_t)N_KVQG * 1024 * 2 <= OW_WQG1 - OW_WKVQG, "weight map");
static_assert((size_t)ROPE_NPOS * 128 * 8 <= OW_TABN - OW_TABR && (size_t)ROPE_NPOS * 32 * 8 <= OW_XB - OW_TABN && (size_t)NT * 1024 * 2 <= OW_SSQ - OW_XB && (size_t)NT * 16 * 4 <= OW_POSB - OW_SSQ, "map 2");
static_assert((size_t)NSEQ * 4 * 512 * 64 * 2 <= OW_CMPVT - OW_CMPK && (size_t)NT * 1024 * 2 <= OW_QR - OW_QC && (size_t)NT * 48 * 4 <= OW_AO - OW_GATES && (size_t)NT * 1024 * 2 <= OW_SK - OW_AO, "map 3");
static_assert((size_t)2 * 4 * 8192 * 64 * 2 <= OW_SVT - OW_SK && (size_t)32 * 4 * WINS * 64 * 2 <= OW_WVTS - OW_WKS && (size_t)32 * 4 * 64 * WINS * 2 <= OW_R1 - OW_WVTS, "map 4");
static_assert((size_t)NT * 1024 * 2 <= 33 * MiB && (size_t)NP * 4 * CATK * 2 <= 96 * MiB && (size_t)2 * 4 * 16 * 512 * CATK * 2 <= 96 * MiB && (size_t)NT * 2048 * 2 <= 65 * MiB && (size_t)NT * 2816 * 2 <= 90 * MiB, "map 5");
static_assert((size_t)8 * NSEQ * 512 * 1024 * 2 <= 272 * MiB && (size_t)8 * NSEQ * 512 * 256 * 2 <= 68 * MiB && (size_t)32 * 4 * SELP * 64 * 2 <= 130 * MiB, "map 6");

struct OptP {
    const float *x_prompt, *x_sample, *cache_cmp, *cache_sel, *cache_win, *state_ret, *state_conv; const int* page_table;
    const float *norm_mix, *norm_ffn, *ret_w_in, *ret_w_out, *ffn_w_in, *ffn_conv_w, *ffn_conv_b, *ffn_w_out, *kv_norm, *kv_w, *kv_knorm, *cmp_pos, *cmp_w1, *cmp_w2, *nsa_w_qg, *nsa_qnorm, *nsa_w_o;
    float* out; unsigned char* ws; const int* dbg_topi; long ph_lo, ph_hi, dup;
};
__device__ __forceinline__ int opq(int v) { asm volatile("" : "+v"(v)); return v; }
__device__ __forceinline__ int opq_s(int v) { asm volatile("" : "+s"(v)); return v; }
__device__ __forceinline__ size_t vtt_off(int tok, int d) { return (size_t)(tok >> 5) * 2048 + (size_t)d * 32 + (tok & 31); }
struct Frame { __attribute__((address_space(3))) unsigned char* lds; int tid, lane, wave, gw, ngw; };
__device__ __forceinline__ unsigned f2bf(float f) { unsigned u = __builtin_bit_cast(unsigned, f); return (u + 0x7fffu + ((u >> 16) & 1u)) >> 16; }
__device__ __forceinline__ unsigned pk2(float lo, float hi) { return f2bf(lo) | (f2bf(hi) << 16); }
__device__ __forceinline__ float bf2f(unsigned short b) { return __builtin_bit_cast(float, (unsigned)b << 16); }
__device__ __forceinline__ float bflo(unsigned w) { return __builtin_bit_cast(float, w << 16); }
__device__ __forceinline__ float bfhi(unsigned w) { return __builtin_bit_cast(float, w & 0xffff0000u); }
__device__ __forceinline__ float wave_sum(float v) {
#pragma unroll
    for (int o = 1; o < 64; o <<= 1) v += __shfl_xor(v, o);
    return v; }
__device__ __forceinline__ float gelu_tanh(float x) { const float u = x * (0.7978845608028654f + 0.035677408136300125f * x * x); const float e = __builtin_amdgcn_exp2f(u * 2.8853900817779268f); return x - x * __builtin_amdgcn_rcpf(e + 1.f); }
__device__ __forceinline__ float silu_f(float x) { return x / (1.f + __expf(-x)); }
__device__ __forceinline__ float sigmoid_f(float x) { return 1.f / (1.f + __expf(-x)); }
__device__ __forceinline__ float log2gamma(int h) { return log2f(1.f - exp2f(-5.f - (float)h)); }
__device__ __forceinline__ float row_rstd(const float* ssq, int row) { const f32x4* p = (const f32x4*)(ssq + (size_t)row * 16); f32x4 a = p[0], b = p[1], c = p[2], d = p[3];
    const float s = ((a.x + a.y) + (a.z + a.w)) + ((b.x + b.y) + (b.z + b.w)) + ((c.x + c.y) + (c.z + c.w)) + ((d.x + d.y) + (d.z + d.w)); return 1.f / sqrtf(s * (1.f / D_MODEL) + EPS); }

__device__ __forceinline__ void wconv_item(const float* W, int N, const float* gain, bf16* dst, int ldk, int p0, int k0, int c0, int nvalid, __attribute__((address_space(3))) float* scr, int lane) {
    { const int col4 = (lane & 7) * 4; f32x4 v[8]; float gv[8];
#pragma unroll
      for (int i = 0; i < 8; ++i) { const int kk = i * 8 + (lane >> 3); v[i] = col4 < nvalid ? *(const f32x4*)(W + (size_t)(k0 + kk) * N + c0 + col4) : (f32x4){0.f, 0.f, 0.f, 0.f}; gv[i] = gain ? gain[k0 + kk] : 1.f; }
#pragma unroll
      for (int i = 0; i < 8; ++i) { const int kk = i * 8 + (lane >> 3); const f32x4 w = v[i] * gv[i]; scr[kk * 33 + col4] = w.x; scr[kk * 33 + col4 + 1] = w.y; scr[kk * 33 + col4 + 2] = w.z; scr[kk * 33 + col4 + 3] = w.w; } }
    asm volatile("s_waitcnt lgkmcnt(0)" ::: "memory");
    const int c = lane & 7;
#pragma unroll
    for (int j = 0; j < 4; ++j) { const int n = (lane >> 3) + 8 * j; const __attribute__((address_space(3))) float* s = scr + (8 * c) * 33 + n;
        u32x4 o; o.x = pk2(s[0 * 33], s[1 * 33]); o.y = pk2(s[2 * 33], s[3 * 33]); o.z = pk2(s[4 * 33], s[5 * 33]); o.w = pk2(s[6 * 33], s[7 * 33]);
        *(u32x4*)(dst + (size_t)(p0 + n) * ldk + k0 + 8 * c) = o; }
    asm volatile("s_waitcnt lgkmcnt(0)" ::: "memory");
}
struct WJob { const float* W; const float* gain; bf16* dst; int K, Ns, Nd, mode, head_rows, head_c0, tail_c0, ntail; };
__device__ __forceinline__ int wjob_items(const WJob& j) { return (j.Nd / 32) * (j.K / 64); }
__device__ __forceinline__ void wjob_run(const WJob& j, int item, __attribute__((address_space(3))) float* scr, int lane) {
    const int nkb = j.K / 64, pb = item / nkb, kb = item % nkb, p0 = pb * 32; int c0, nvalid = 32;
    if (j.mode == 0) c0 = p0;
    else if (p0 < j.head_rows) { const int T = p0 / 256, cl = p0 % 256, bj = cl / 128, wc = (cl % 128) / 32; c0 = j.head_c0 + 64 * (4 * T + wc) + 32 * bj; }
    else { const int t = p0 - j.head_rows; c0 = j.tail_c0 + t; nvalid = j.ntail - t; if (nvalid > 32) nvalid = 32; if (nvalid < 0) nvalid = 0; }
    wconv_item(j.W, j.Ns, j.gain, j.dst, j.K, p0, kb * 64, c0, nvalid, scr, lane);
}
struct Ctx {
    const __attribute__((address_space(4))) OptP& p;
    __device__ __forceinline__ bf16* w_retin() const { return (bf16*)(p.ws + OW_WRETIN); }
    __device__ __forceinline__ bf16* w_retout() const { return (bf16*)(p.ws + OW_WRETOUT); }
    __device__ __forceinline__ bf16* w_ffnin() const { return (bf16*)(p.ws + OW_WFFNIN); }
    __device__ __forceinline__ bf16* w_ffnout() const { return (bf16*)(p.ws + OW_WFFNOUT); }
    __device__ __forceinline__ bf16* w_kvqg() const { return (bf16*)(p.ws + OW_WKVQG); }
    __device__ __forceinline__ bf16* w_qg1() const { return (bf16*)(p.ws + OW_WQG1); }
    __device__ __forceinline__ bf16* w_wo() const { return (bf16*)(p.ws + OW_WWO); }
    __device__ __forceinline__ bf16* w_cmp1() const { return (bf16*)(p.ws + OW_WCMP1); }
    __device__ __forceinline__ f32x2* tabr() const { return (f32x2*)(p.ws + OW_TABR); }
    __device__ __forceinline__ f32x2* tabn() const { return (f32x2*)(p.ws + OW_TABN); }
    __device__ __forceinline__ bf16* xb() const { return (bf16*)(p.ws + OW_XB); }
    __device__ __forceinline__ float* ssq() const { return (float*)(p.ws + OW_SSQ); }
    __device__ __forceinline__ float* posb() const { return (float*)(p.ws + OW_POSB); }
    __device__ __forceinline__ bf16* cmpk() const { return (bf16*)(p.ws + OW_CMPK); }
    __device__ __forceinline__ bf16* cmpvt() const { return (bf16*)(p.ws + OW_CMPVT); }
    __device__ __forceinline__ bf16* qc() const { return (bf16*)(p.ws + OW_QC); }
    __device__ __forceinline__ bf16* qr() const { return (bf16*)(p.ws + OW_QR); }
    __device__ __forceinline__ bf16* ao() const { return (bf16*)(p.ws + OW_AO); }
    __device__ __forceinline__ float* gates() const { return (float*)(p.ws + OW_GATES); }
    __device__ __forceinline__ bf16* sk() const { return (bf16*)(p.ws + OW_SK); }
    __device__ __forceinline__ bf16* svt() const { return (bf16*)(p.ws + OW_SVT); }
    __device__ __forceinline__ bf16* wk() const { return (bf16*)(p.ws + OW_WK); }
    __device__ __forceinline__ bf16* wvt() const { return (bf16*)(p.ws + OW_WVT); }
    __device__ __forceinline__ bf16* wks() const { return (bf16*)(p.ws + OW_WKS); }
    __device__ __forceinline__ bf16* wvts() const { return (bf16*)(p.ws + OW_WVTS); }
    __device__ __forceinline__ bf16* qp() const { return (bf16*)(p.ws + OW_QP); }
    __device__ __forceinline__ bf16* kp() const { return (bf16*)(p.ws + OW_KP); }
    __device__ __forceinline__ bf16* acat() const { return (bf16*)(p.ws + OW_ACAT); }
    __device__ __forceinline__ bf16* bcat() const { return (bf16*)(p.ws + OW_BCAT); }
    __device__ __forceinline__ bf16* kdt() const { return (bf16*)(p.ws + OW_KDT); }
    __device__ __forceinline__ bf16* o() const { return (bf16*)(p.ws + OW_O); }
    __device__ __forceinline__ bf16* sg() const { return (bf16*)(p.ws + OW_SG); }
    __device__ __forceinline__ bf16* g() const { return (bf16*)(p.ws + OW_G); }
    __device__ __forceinline__ float* kvs() const { return (float*)(p.ws + OW_KVS); }
    __device__ __forceinline__ float* sqkv() const { return (float*)(p.ws + OW_SQKV); }
    __device__ __forceinline__ bf16* u() const { return (bf16*)(p.ws + OW_U); }
    __device__ __forceinline__ bf16* gt() const { return (bf16*)(p.ws + OW_GT); }
    __device__ __forceinline__ bf16* act() const { return (bf16*)(p.ws + OW_ACT); }
    __device__ __forceinline__ bf16* asub() const { return (bf16*)(p.ws + OW_ASUB); }
    __device__ __forceinline__ bf16* part() const { return (bf16*)(p.ws + OW_PART); }
    __device__ __forceinline__ bf16* sks() const { return (bf16*)(p.ws + OW_SKS); }
    __device__ __forceinline__ bf16* svts() const { return (bf16*)(p.ws + OW_SVTS); }
    __device__ __forceinline__ float* x() const { return p.out + O_YP; }
};
__device__ __forceinline__ const __attribute__((address_space(4))) OptP* kargs() { unsigned long long v = (unsigned long long)__builtin_amdgcn_kernarg_segment_ptr(); asm volatile("" : "+s"(v)); return (const __attribute__((address_space(4))) OptP*)v; }
__device__ __forceinline__ int row_pos(int r) { return r < NP ? (r % SEQ) : PAST_LEN + ((r - NP) % DEC_SEQ); }

constexpr int NWJOBS = 21;
__device__ __forceinline__ void make_wjob(const Ctx& c, int j, WJob& w) {
    const auto& p = c.p; w.gain = nullptr; w.mode = 0; w.head_rows = 0; w.head_c0 = 0; w.tail_c0 = 0; w.ntail = 0;
    if (j < 2) { w.W = p.ret_w_in + (size_t)j * D_MODEL * 6 * D_MODEL; w.gain = p.norm_mix + j * D_MODEL; w.dst = c.w_retin() + (size_t)j * 6 * D_MODEL * D_MODEL; w.K = D_MODEL; w.Ns = 6 * D_MODEL; w.Nd = 6 * D_MODEL; }
    else if (j < 4) { const int l = j - 2; w.W = p.ret_w_out + (size_t)l * 2 * D_MODEL * D_MODEL; w.dst = c.w_retout() + (size_t)l * 2 * D_MODEL * D_MODEL; w.K = 2 * D_MODEL; w.Ns = D_MODEL; w.Nd = D_MODEL; }
    else if (j < 8) { const int l = j - 4; w.W = p.ffn_w_in + (size_t)l * D_MODEL * 2 * D_FF; w.gain = p.norm_ffn + l * D_MODEL; w.dst = c.w_ffnin() + (size_t)l * 2 * D_FF * D_MODEL; w.K = D_MODEL; w.Ns = 2 * D_FF; w.Nd = 2 * D_FF; }
    else if (j < 12) { const int l = j - 8; w.W = p.ffn_w_out + (size_t)l * D_FF * D_MODEL; w.dst = c.w_ffnout() + (size_t)l * D_FF * D_MODEL; w.K = D_FF; w.Ns = D_MODEL; w.Nd = D_MODEL; }
    else if (j == 12) { w.W = p.kv_w; w.gain = p.kv_norm; w.dst = c.w_kvqg(); w.K = D_MODEL; w.Ns = D_KV; w.Nd = D_KV; w.mode = 1; w.head_rows = D_KV; }
    else if (j < 15) { const int q = j - 13; w.W = p.nsa_w_qg + (size_t)q * D_MODEL * D_QG; w.gain = p.norm_mix + (2 + q) * D_MODEL; w.dst = q == 0 ? c.w_kvqg() + (size_t)D_KV * D_MODEL : c.w_qg1(); w.K = D_MODEL; w.Ns = D_QG; w.Nd = N_QG1;
        w.mode = 1; w.head_rows = D_Q; w.tail_c0 = D_Q; w.ntail = 3 * N_HEADS; }
    else if (j < 17) { const int q = j - 15; w.W = p.nsa_w_o + (size_t)q * D_Q * D_MODEL; w.dst = c.w_wo() + (size_t)q * D_Q * D_MODEL; w.K = D_Q; w.Ns = D_MODEL; w.Nd = D_MODEL; }
    else { const int q = j - 17, cc = q >> 1, r = q & 1; w.W = p.cmp_w1 + ((size_t)cc * 2048 + (size_t)r * 1024) * CMP_HID; w.dst = c.w_cmp1() + ((size_t)cc * 256 + r * 128) * 1024; w.K = 1024; w.Ns = CMP_HID; w.Nd = CMP_HID; }
}
__device__ __forceinline__ void p0_prologue(const Ctx& c, Frame F) { F.tid = opq((int)threadIdx.x); F.lane = F.tid & 63;
    __attribute__((address_space(3))) float* scr = (__attribute__((address_space(3))) float*)(F.lds + F.wave * 16384);
    int base = 0;
    for (int j = 0; j < NWJOBS; ++j) { WJob w; make_wjob(c, j, w); const int n = wjob_items(w);
        int it = F.gw - (base % F.ngw); if (it < 0) it += F.ngw;
        for (; it < n; it += F.ngw) wjob_run(w, it, scr, F.lane);
        base += n; }
    for (long i = (long)opq_s(F.gw) * 64 + opq(F.lane); i < (long)ROPE_NPOS * 160; i += (long)F.ngw * 64) { const int pos = (int)(i / 160), k = (int)(i % 160);
        if (k < 128) { const float inv = expf(-9.210340371976184f * (float)k / 128.f); const float ang = (float)pos * inv; c.tabr()[(size_t)pos * 128 + k] = (f32x2){cosf(ang), sinf(ang)}; }
        else { const int kk = k - 128; const float inv = expf(-9.210340371976184f * (float)kk / 32.f); const float ang = (float)pos * inv; c.tabn()[(size_t)pos * 32 + kk] = (f32x2){cosf(ang), sinf(ang)}; } }
    for (int r = opq_s(F.gw); r < NT; r += F.ngw) { const float* src = r < NP ? c.p.x_prompt + (size_t)r * D_MODEL : c.p.x_sample + (size_t)(r - NP) * D_MODEL;
        float s = 0.f;
#pragma unroll
        for (int j = 0; j < 4; ++j) { const f32x4 v = ((const f32x4*)src)[F.lane + 64 * j]; ((f32x4*)(c.x() + (size_t)r * D_MODEL))[F.lane + 64 * j] = v; s += (v.x * v.x + v.y * v.y) + (v.z * v.z + v.w * v.w);
            u32x2 w; w.x = pk2(v.x, v.y); w.y = pk2(v.z, v.w); ((u32x2*)(c.xb() + (size_t)r * D_MODEL))[F.lane + 64 * j] = w; }
        s = wave_sum(s); if (F.lane < 16) c.ssq()[(size_t)r * 16 + F.lane] = F.lane == 0 ? s : 0.f; }
    for (int i = opq_s(F.gw); i < 2 * 32; i += F.ngw) { const int cc = i >> 5, j = i & 31; float a0 = 0.f, a1 = 0.f; const float* pp = c.p.cmp_pos + (size_t)cc * CMP_LEN * HEAD_DIM + j * 64; const float* w = c.p.cmp_w1 + ((size_t)cc * CMP_LEN * HEAD_DIM + j * 64) * CMP_HID + F.lane;
#pragma unroll 8
        for (int ld = 0; ld < 64; ++ld) { const float pv = pp[ld]; a0 += pv * w[(size_t)ld * CMP_HID]; a1 += pv * w[(size_t)ld * CMP_HID + 64]; }
        c.posb()[(size_t)i * CMP_HID + F.lane] = a0; c.posb()[(size_t)i * CMP_HID + 64 + F.lane] = a1; }
}

struct SchedDense {
    const char* A; const char* B; int lda, ldb, nM, nN, nt, G, c;
    __device__ __forceinline__ bool next(int i, pg8::Unit& u) const { const long L = (long)i * G + c; if (L >= (long)nM * nN) return false;
        const int grp = 8 * nN, gid = (int)(L / grp), fm = gid * 8, gsz = (nM - fm) < 8 ? (nM - fm) : 8, w = (int)(L % grp);
        u.pm = fm + w % gsz; u.pn = w / gsz; u.nt = nt; u.aux = 0; u.A = A + (size_t)u.pm * 256 * lda * 2; u.B = B + (size_t)u.pn * 256 * ldb * 2; return true; }
};
typedef const f32x4 (&AccRef)[2][2][4][2];
#define EPI_ROWS(ai, m) _Pragma("unroll") for (int ai = 0; ai < 2; ++ai) _Pragma("unroll") for (int m = 0; m < 4; ++m)
__device__ __forceinline__ u32x4 pack8(const f32x4 a, const f32x4 b) { u32x4 w; w.x = pg8::cvt_pk_bf16(a.x, a.y); w.y = pg8::cvt_pk_bf16(a.z, a.w); w.z = pg8::cvt_pk_bf16(b.x, b.y); w.w = pg8::cvt_pk_bf16(b.z, b.w); return w; }
__device__ __forceinline__ void store_t4(bf16* base, size_t pitch, const f32x4 v) { base[0] = (bf16)f2bf(v.x); base[pitch] = (bf16)f2bf(v.y); base[2 * pitch] = (bf16)f2bf(v.z); base[3 * pitch] = (bf16)f2bf(v.w); }

typedef __attribute__((address_space(3))) unsigned char lds_b;
__device__ __forceinline__ void tr_store32(lds_b* scr, const f32x4 (&v)[2][2], bf16* dst, size_t pitch, int fr, int fq) {
#pragma unroll
    for (int mh = 0; mh < 2; ++mh)
#pragma unroll
        for (int n = 0; n < 2; ++n) { lds_b* p = scr + (8 * fq + 4 * n) * 72 + (16 * mh + fr) * 2;
            *(__attribute__((address_space(3))) unsigned short*)(p) = (unsigned short)f2bf(v[mh][n].x); *(__attribute__((address_space(3))) unsigned short*)(p + 72) = (unsigned short)f2bf(v[mh][n].y);
            *(__attribute__((address_space(3))) unsigned short*)(p + 144) = (unsigned short)f2bf(v[mh][n].z); *(__attribute__((address_space(3))) unsigned short*)(p + 216) = (unsigned short)f2bf(v[mh][n].w); }
    asm volatile("s_waitcnt lgkmcnt(0)" ::: "memory");
    const int lane = fr + 16 * fq;
#pragma unroll
    for (int t = 0; t < 2; ++t) { const int q = lane + 64 * t, col = q >> 2, tc = q & 3; const lds_b* p = scr + col * 72 + tc * 16;
        const u32x2 a = *(const __attribute__((address_space(3))) u32x2*)p, b = *(const __attribute__((address_space(3))) u32x2*)(p + 8);
        *(u32x4*)(dst + (size_t)col * pitch + tc * 8) = (u32x4){a.x, a.y, b.x, b.y}; }
    asm volatile("s_waitcnt lgkmcnt(0)" ::: "memory");
}
struct EpiRetIn { const Ctx* c; lds_b* scr0;
    __device__ __forceinline__ void operator()(AccRef acc, const pg8::Unit& u, int wr, int wc, int fr, int fq) const { asm volatile("" : "+v"(fr), "+v"(fq));
        const Ctx& C = *c; const int pn = u.pn; f32x4 kt1[2][2], kt2[2][2], vt[2][2][2];
        EPI_ROWS(ai, m) { const int row = u.pm * 256 + ai * 128 + wr * 64 + m * 16 + fr; const float rs = row_rstd(C.ssq(), row); const bool prompt = row < NP;
            const int s = prompt ? row / SEQ : 0, t = prompt ? row % SEQ : (row - NP) % DEC_SEQ, pos = prompt ? t : PAST_LEN + t, j = t / SCH, il = t % SCH, srow = row - NP;
            if (pn < 8) {
                const int head = pn & 3; const bool isk = pn >= 4; const float sc = isk ? 0.0625f : 1.f; const float l2g = log2gamma(head);
                const float dec = prompt ? (isk ? exp2f((float)(SCH - 1 - il) * l2g) : exp2f((float)(il + 1) * l2g)) : 1.f;
                f32x4 o1[2], o2[2];
#pragma unroll
                for (int n = 0; n < 2; ++n) { const int i0 = 32 * wc + 8 * fq + 4 * n; const f32x4* tp = (const f32x4*)(C.tabr() + (size_t)pos * 128 + i0); const f32x4 t01 = tp[0], t23 = tp[1];
                    const f32x4 x1 = acc[ai][0][m][n] * (rs * sc), x2 = acc[ai][1][m][n] * (rs * sc);
                    o1[n] = (f32x4){x1.x * t01.x - x2.x * t01.y, x1.y * t01.z - x2.y * t01.w, x1.z * t23.x - x2.z * t23.y, x1.w * t23.z - x2.w * t23.w};
                    o2[n] = (f32x4){x2.x * t01.x + x1.x * t01.y, x2.y * t01.z + x1.y * t01.w, x2.z * t23.x + x1.z * t23.y, x2.w * t23.z + x1.w * t23.w}; }
                const int i8 = 32 * wc + 8 * fq;
                if (prompt) {
                    bf16* dst = (isk ? C.kp() : C.qp()) + (size_t)row * 1024 + head * 256 + i8; *(u32x4*)dst = pack8(o1[0], o1[1]); *(u32x4*)(dst + 128) = pack8(o2[0], o2[1]);
                    if (!isk) { bf16* d2 = C.acat() + ((size_t)row * 4 + head) * CATK + i8; *(u32x4*)d2 = pack8(o1[0] * dec, o1[1] * dec); *(u32x4*)(d2 + 128) = pack8(o2[0] * dec, o2[1] * dec); }
                    else {
#pragma unroll
                        for (int n = 0; n < 2; ++n) { kt1[m & 1][n] = o1[n] * dec; kt2[m & 1][n] = o2[n] * dec; }
                        if (m & 1) { lds_b* scr = scr0 + (wr * 4 + wc) * 2304; const int t0 = (u.pm * 256 + ai * 128 + wr * 64 + (m - 1) * 16) % SEQ;
                            bf16* d2 = C.kdt() + ((size_t)(s * 4 + head) * 256 + 32 * wc) * SEQ + t0; tr_store32(scr, kt1, d2, SEQ, fr, fq); tr_store32(scr, kt2, d2 + (size_t)128 * SEQ, SEQ, fr, fq); } }
                } else { float* d = C.sqkv() + (size_t)srow * 4096 + (isk ? 1024 : 0) + head * 256 + i8; *(f32x4*)d = o1[0]; *(f32x4*)(d + 4) = o1[1]; *(f32x4*)(d + 128) = o2[0]; *(f32x4*)(d + 132) = o2[1]; }
            } else if (pn < 16) {
                const int head = (pn - 8) >> 1, e0 = ((pn - 8) & 1) * 256;
#pragma unroll
                for (int bj = 0; bj < 2; ++bj) { const int e = e0 + 128 * bj + 32 * wc + 8 * fq; const f32x4 v0 = acc[ai][bj][m][0] * rs, v1 = acc[ai][bj][m][1] * rs;
                    if (prompt) { vt[bj][m & 1][0] = v0; vt[bj][m & 1][1] = v1; }
                    else { float* d = C.sqkv() + (size_t)srow * 4096 + 2048 + head * 512 + e; *(f32x4*)d = v0; *(f32x4*)(d + 4) = v1; } }
                if (prompt && (m & 1)) { lds_b* scr = scr0 + (wr * 4 + wc) * 2304; const int t0 = (u.pm * 256 + ai * 128 + wr * 64 + (m - 1) * 16) % SEQ, j0 = t0 / SCH, il0 = t0 % SCH;
#pragma unroll
                    for (int bj = 0; bj < 2; ++bj) tr_store32(scr, vt[bj], C.bcat() + ((size_t)((s * 4 + head) * NSCH + j0) * 512 + e0 + 128 * bj + 32 * wc) * CATK + RET_DK + il0, CATK, fr, fq); }
            } else {
#pragma unroll
                for (int bj = 0; bj < 2; ++bj) { f32x4 v0 = acc[ai][bj][m][0] * rs, v1 = acc[ai][bj][m][1] * rs;
                    v0 = (f32x4){silu_f(v0.x), silu_f(v0.y), silu_f(v0.z), silu_f(v0.w)}; v1 = (f32x4){silu_f(v1.x), silu_f(v1.y), silu_f(v1.z), silu_f(v1.w)};
                    *(u32x4*)(C.sg() + (size_t)row * 2048 + (pn - 16) * 256 + 128 * bj + 32 * wc + 8 * fq) = pack8(v0, v1); }
            } }
    }
};
struct EpiRes { const Ctx* c; bool dry;
    __device__ __forceinline__ void operator()(AccRef acc, const pg8::Unit& u, int wr, int wc, int fr, int fq) const { asm volatile("" : "+v"(fr), "+v"(fq));
        const Ctx& C = *c;
        if (u.aux >= 16) {
            if (!dry) { float* P = (float*)(C.p.ws + OW_SPLITK) + (size_t)(u.aux - 16) * 256 * D_MODEL;
                EPI_ROWS(ai, m) { const int rl = ai * 128 + wr * 64 + m * 16 + fr;
#pragma unroll
                    for (int bj = 0; bj < 2; ++bj) { float* d = P + (size_t)rl * D_MODEL + u.pn * 256 + 128 * bj + 32 * wc + 8 * fq; *(f32x4*)d = acc[ai][bj][m][0]; *(f32x4*)(d + 4) = acc[ai][bj][m][1]; } } }
            return; }
        EPI_ROWS(ai, m) { const int row = u.pm * 256 + ai * 128 + wr * 64 + m * 16 + fr; float ss = 0.f;
#pragma unroll
            for (int bj = 0; bj < 2; ++bj) { const size_t off = (size_t)row * D_MODEL + u.pn * 256 + 128 * bj + 32 * wc + 8 * fq; f32x4* xp = (f32x4*)(C.x() + off);
                const f32x4 a = xp[0] + acc[ai][bj][m][0], b = xp[1] + acc[ai][bj][m][1]; if (!dry) { xp[0] = a; xp[1] = b; *(u32x4*)(C.xb() + off) = pack8(a, b); }
                ss += ((a.x * a.x + a.y * a.y) + (a.z * a.z + a.w * a.w)) + ((b.x * b.x + b.y * b.y) + (b.z * b.z + b.w * b.w)); }
            ss += __shfl_xor(ss, 16); ss += __shfl_xor(ss, 32);
            if (fq == 0 && !dry) C.ssq()[(size_t)row * 16 + u.pn * 4 + wc] = ss; }
    }
};
struct EpiFfnIn { const Ctx* c; int layer;
    __device__ __forceinline__ void operator()(AccRef acc, const pg8::Unit& u, int wr, int wc, int fr, int fq) const { asm volatile("" : "+v"(fr), "+v"(fq));
        const Ctx& C = *c; const bool isu = u.pn < 11; const int ct = isu ? u.pn : u.pn - 11;
        EPI_ROWS(ai, m) { const int row = u.pm * 256 + ai * 128 + wr * 64 + m * 16 + fr; const float rs = row_rstd(C.ssq(), row);
            const bool prompt = row < NP; const int t = prompt ? row % SEQ : (row - NP) % DEC_SEQ, T = prompt ? SEQ : DEC_SEQ;
#pragma unroll
            for (int bj = 0; bj < 2; ++bj) { const int f = ct * 256 + 128 * bj + 32 * wc + 8 * fq; const f32x4 v0 = acc[ai][bj][m][0] * rs, v1 = acc[ai][bj][m][1] * rs;
                *(u32x4*)((isu ? C.u() : C.gt()) + (size_t)row * D_FF + f) = pack8(v0, v1);
                if (isu && t >= T - 2) { const int jr = t - (T - 2);
                    float* d = C.p.out + (prompt ? O_CONVP + ((size_t)(layer * BATCH + row / SEQ) * 2 + jr) * D_FF : O_CONVS + ((size_t)(layer * DEC_BATCH + (row - NP) / DEC_SEQ) * 2 + jr) * D_FF) + f;
                    *(f32x4*)d = v0; *(f32x4*)(d + 4) = v1; } } }
    }
};
struct EpiKvqg { const Ctx* c; int tile0, jq;
    __device__ __forceinline__ void operator()(AccRef acc, const pg8::Unit& u, int wr, int wc, int fr, int fq) const { asm volatile("" : "+v"(fr), "+v"(fq));
        const Ctx& C = *c; const int T = u.pn + tile0;
        EPI_ROWS(ai, m) { const int row = u.pm * 256 + ai * 128 + wr * 64 + m * 16 + fr; const float rs0 = row_rstd(C.ssq(), row); const bool prompt = row < NP;
            const int s = prompt ? row / SEQ : 0, t = prompt ? row % SEQ : (row - NP) % DEC_SEQ, pos = prompt ? t : PAST_LEN + t, b = prompt ? 0 : (row - NP) / DEC_SEQ, srow = row - NP;
            f32x4 x[2][2];
#pragma unroll
            for (int bj = 0; bj < 2; ++bj)
#pragma unroll
                for (int n = 0; n < 2; ++n) x[bj][n] = acc[ai][bj][m][n] * rs0;
            if (T == 10) {
                if (wc < 2) {
#pragma unroll
                    for (int n = 0; n < 2; ++n) { const int col = 32 * wc + 8 * fq + 4 * n; if (col < 3 * N_HEADS) { const f32x4 v = x[0][n]; *(f32x4*)(C.gates() + (size_t)row * 48 + col) = (f32x4){sigmoid_f(v.x), sigmoid_f(v.y), sigmoid_f(v.z), sigmoid_f(v.w)}; } } }
                continue; }
            const bool normed = (T == 2 || T == 4 || T >= 6);
            f32x4 y[2][2];
            if (normed) {
                float ss = 0.f;
#pragma unroll
                for (int bj = 0; bj < 2; ++bj)
#pragma unroll
                    for (int n = 0; n < 2; ++n) { const f32x4 v = x[bj][n]; ss += (v.x * v.x + v.y * v.y) + (v.z * v.z + v.w * v.w); }
                ss += __shfl_xor(ss, 16); ss += __shfl_xor(ss, 32);
                const float rs = 1.f / sqrtf(ss * (1.f / HEAD_DIM) + EPS);
                const float* gn = T == 2 ? C.p.kv_knorm + HEAD_DIM : T == 4 ? C.p.kv_knorm + 2 * HEAD_DIM : C.p.nsa_qnorm + jq * HEAD_DIM;
#pragma unroll
                for (int bj = 0; bj < 2; ++bj)
#pragma unroll
                    for (int n = 0; n < 2; ++n) { const f32x4 g = *(const f32x4*)(gn + 32 * bj + 8 * fq + 4 * n); x[bj][n] = x[bj][n] * rs * g; }
#pragma unroll
                for (int n = 0; n < 2; ++n) { const f32x4* tp = (const f32x4*)(C.tabn() + (size_t)pos * 32 + 8 * fq + 4 * n); const f32x4 t01 = tp[0], t23 = tp[1]; const f32x4 x1 = x[0][n], x2 = x[1][n];
                    y[0][n] = (f32x4){x1.x * t01.x - x2.x * t01.y, x1.y * t01.z - x2.y * t01.w, x1.z * t23.x - x2.z * t23.y, x1.w * t23.z - x2.w * t23.w};
                    y[1][n] = (f32x4){x2.x * t01.x + x1.x * t01.y, x2.y * t01.z + x1.y * t01.w, x2.z * t23.x + x1.z * t23.y, x2.w * t23.z + x1.w * t23.w}; }
            }
            if (T >= 6) {
                const int head = 4 * (T - 6) + wc;
#pragma unroll
                for (int bj = 0; bj < 2; ++bj) { const size_t off = ((size_t)row * N_HEADS + head) * HEAD_DIM + 32 * bj + 8 * fq; *(u32x4*)(C.qc() + off) = pack8(x[bj][0], x[bj][1]); *(u32x4*)(C.qr() + off) = pack8(y[bj][0], y[bj][1]); }
                continue; }
            const int kvh = wc, br = T >> 1, cc = T & 1;
            float* od = nullptr;
            if (br == 0) od = C.p.out + (prompt ? O_CMPP + (size_t)row * KVROW : O_CMPS + (size_t)srow * KVROW);
            else if (br == 1) od = C.p.out + (prompt ? O_SELP + (size_t)row * KVROW : O_SELS + (size_t)srow * KVROW);
            else { if (prompt) { if (t >= SEQ - WIN_P) od = C.p.out + O_WINP + ((size_t)s * WIN_P + (t - (SEQ - WIN_P))) * KVROW; } else od = C.p.out + O_WINS + ((size_t)b * WIN_S + (WIN_S - DEC_SEQ + t)) * KVROW; }
#pragma unroll
            for (int bj = 0; bj < 2; ++bj)
#pragma unroll
                for (int n = 0; n < 2; ++n) { const f32x4 v = (normed ? y[bj][n] : x[bj][n]); const int d = 32 * bj + 8 * fq + 4 * n;
                    if (od) *(f32x4*)(od + cc * KVH + kvh * HEAD_DIM + d) = v;
                    u32x2 w; w.x = pg8::cvt_pk_bf16(v.x, v.y); w.y = pg8::cvt_pk_bf16(v.z, v.w);
                    if (br == 0) { if (prompt) *(u32x2*)(C.asub() + ((size_t)((cc * N_KV + kvh) * NSEQ + s) * 512 + t / 16) * 1024 + (t % 16) * 64 + d) = w; }
                    else if (cc == 0) {
                        bf16* kd = br == 1 ? (prompt ? C.sk() + ((size_t)(s * N_KV + kvh) * SEQ + t) * 64 : C.sks() + ((size_t)(b * N_KV + kvh) * SELP + PAST_LEN + t) * 64)
                                           : (prompt ? C.wk() + ((size_t)(s * N_KV + kvh) * SEQ + t) * 64 : C.wks() + ((size_t)(b * N_KV + kvh) * WINS + WIN_BUF + t) * 64);
                        *(u32x2*)(kd + d) = w; }
                    else {
                        if (br == 1) { if (prompt) store_t4(C.svt() + (size_t)(s * N_KV + kvh) * 64 * SEQ + vtt_off(t, d), 32, v); else store_t4(C.svts() + (size_t)(b * N_KV + kvh) * 64 * SELP + vtt_off(PAST_LEN + t, d), 32, v); }
                        else { if (prompt) store_t4(C.wvt() + (size_t)(s * N_KV + kvh) * 64 * SEQ + vtt_off(t, d), 32, v); else store_t4(C.wvts() + (size_t)(b * N_KV + kvh) * 64 * WINS + vtt_off(WIN_BUF + t, d), 32, v); } } } }
    }
};
struct EpiP { const Ctx* c;
    __device__ __forceinline__ void operator()(AccRef acc, const pg8::Unit& u, int wr, int wc, int fr, int fq) const { asm volatile("" : "+v"(fr), "+v"(fq));
        const Ctx& C = *c; const int head = u.aux & 3, sj = u.aux >> 2;
        const float l2g = log2gamma(head);
        EPI_ROWS(ai, m) { const int iq = u.pm * 256 + ai * 128 + wr * 64 + m * 16 + fr; const size_t row = (size_t)sj * SCH + iq;
#pragma unroll
            for (int bj = 0; bj < 2; ++bj) { const int ik = u.pn * 256 + 128 * bj + 32 * wc + 8 * fq; f32x4 v0 = acc[ai][bj][m][0], v1 = acc[ai][bj][m][1]; const float df = (float)(iq - ik);
                v0 = (f32x4){ik <= iq ? v0.x * exp2f(df * l2g) : 0.f, ik + 1 <= iq ? v0.y * exp2f((df - 1.f) * l2g) : 0.f, ik + 2 <= iq ? v0.z * exp2f((df - 2.f) * l2g) : 0.f, ik + 3 <= iq ? v0.w * exp2f((df - 3.f) * l2g) : 0.f};
                v1 = (f32x4){ik + 4 <= iq ? v1.x * exp2f((df - 4.f) * l2g) : 0.f, ik + 5 <= iq ? v1.y * exp2f((df - 5.f) * l2g) : 0.f, ik + 6 <= iq ? v1.z * exp2f((df - 6.f) * l2g) : 0.f, ik + 7 <= iq ? v1.w * exp2f((df - 7.f) * l2g) : 0.f};
                *(u32x4*)(C.acat() + (row * 4 + head) * CATK + RET_DK + ik) = pack8(v0, v1); } }
    }
};
struct EpiKV { const Ctx* c;
    __device__ __forceinline__ void operator()(AccRef acc, const pg8::Unit& u, int wr, int wc, int fr, int fq) const { asm volatile("" : "+v"(fr), "+v"(fq));
        const Ctx& C = *c;
        EPI_ROWS(ai, m) { const int e = u.pm * 256 + ai * 128 + wr * 64 + m * 16 + fr;
#pragma unroll
            for (int bj = 0; bj < 2; ++bj) { float* d = C.kvs() + ((size_t)u.aux * 512 + e) * 256 + 128 * bj + 32 * wc + 8 * fq; *(f32x4*)d = acc[ai][bj][m][0]; *(f32x4*)(d + 4) = acc[ai][bj][m][1]; } }
    }
};
struct EpiOut { const Ctx* c;
    __device__ __forceinline__ void operator()(AccRef acc, const pg8::Unit& u, int wr, int wc, int fr, int fq) const { asm volatile("" : "+v"(fr), "+v"(fq));
        const Ctx& C = *c; const int head = u.aux & 3, sj = u.aux >> 2;
        EPI_ROWS(ai, m) { const size_t row = (size_t)sj * SCH + u.pm * 256 + ai * 128 + wr * 64 + m * 16 + fr;
#pragma unroll
            for (int bj = 0; bj < 2; ++bj) *(u32x4*)(C.o() + row * 2048 + head * 512 + u.pn * 256 + 128 * bj + 32 * wc + 8 * fq) = pack8(acc[ai][bj][m][0], acc[ai][bj][m][1]); }
    }
};
struct EpiCmp1 { const Ctx* c;
    __device__ __forceinline__ void operator()(AccRef acc, const pg8::Unit& u, int wr, int wc, int fr, int fq) const { asm volatile("" : "+v"(fr), "+v"(fq));
        const Ctx& C = *c;
        EPI_ROWS(ai, m) { const size_t row = (size_t)u.pm * 256 + ai * 128 + wr * 64 + m * 16 + fr;
#pragma unroll
            for (int bj = 0; bj < 2; ++bj) *(u32x4*)(C.part() + row * 256 + 128 * bj + 32 * wc + 8 * fq) = pack8(acc[ai][bj][m][0], acc[ai][bj][m][1]); }
    }
};
struct SchedPKV {
    const Ctx* c; int G, cu, which;
    __device__ __forceinline__ bool next(int i, pg8::Unit& u) const { const Ctx& C = *c; const long L = (long)i * G + cu;
        if (which == 0) { if (L >= (long)BATCH * 4 * NSCH * 3) return false; const int k = (int)(L % 3), shj = (int)(L / 3), head = shj % 4, sj = shj / 4;
            u.pm = k == 0 ? 0 : 1; u.pn = k == 2 ? 1 : 0; u.nt = 4; u.aux = sj * 4 + head;
            u.A = (const char*)(C.qp() + ((size_t)sj * SCH + u.pm * 256) * 1024 + head * 256); u.B = (const char*)(C.kp() + ((size_t)sj * SCH + u.pn * 256) * 1024 + head * 256); return true; }
        else { if (L >= (long)BATCH * 4 * NSCH * 2) return false; const int eh = (int)(L % 2), q = (int)(L / 2), j = q % NSCH, sh = q / NSCH;
            u.pm = eh; u.pn = 0; u.nt = 8; u.aux = sh * NSCH + j;
            u.A = (const char*)(C.bcat() + ((size_t)(sh * NSCH + j) * 512 + eh * 256) * CATK + RET_DK); u.B = (const char*)(C.kdt() + (size_t)sh * 256 * SEQ + j * SCH); return true; } }
};
struct SchedOut { const Ctx* c; int G, cu;
    __device__ __forceinline__ bool next(int i, pg8::Unit& u) const { const Ctx& C = *c; const long L = (long)i * G + cu; if (L >= (long)BATCH * 4 * NSCH * 4) return false;
        const int k = (int)(L % 4), shj = (int)(L / 4), head = shj % 4, sj = shj / 4, s = sj / NSCH, j = sj % NSCH;
        u.pm = k >> 1; u.pn = k & 1; u.nt = u.pm == 0 ? 8 : 12; u.aux = sj * 4 + head;
        u.A = (const char*)(C.acat() + (((size_t)sj * SCH + u.pm * 256) * 4 + head) * CATK); u.B = (const char*)(C.bcat() + ((size_t)((s * 4 + head) * NSCH + j) * 512 + u.pn * 256) * CATK); return true; }
};
typedef __attribute__((address_space(3))) float lds_f32;
__device__ __forceinline__ void bf8_to_f32(const u32x4 w, float (&v)[8]) { v[0] = bflo(w.x); v[1] = bfhi(w.x); v[2] = bflo(w.y); v[3] = bfhi(w.y); v[4] = bflo(w.z); v[5] = bfhi(w.z); v[6] = bflo(w.w); v[7] = bfhi(w.w); }
__device__ __forceinline__ void ph_ret_scan(const Ctx& c, Frame F, int layer) { F.tid = opq((int)threadIdx.x); F.lane = F.tid & 63;
    for (long idx = (long)opq_s(blockIdx.x) * MK_THREADS + opq(F.tid); idx < (long)BATCH * 4 * 512 * 32; idx += (long)gridDim.x * MK_THREADS) {
        const int dch = (int)(idx % 32), e = (int)((idx / 32) % 512), sh = (int)(idx / (32 * 512)), head = sh % 4, s = sh / 4; const float dec = exp2f((float)SCH * log2gamma(head));
        float S[8];
#pragma unroll
        for (int k = 0; k < 8; ++k) S[k] = 0.f;
        for (int j = 0; j < NSCH; ++j) { const size_t rowi = (size_t)(sh * NSCH + j) * 512 + e;
            u32x4 w; w.x = pk2(S[0], S[1]); w.y = pk2(S[2], S[3]); w.z = pk2(S[4], S[5]); w.w = pk2(S[6], S[7]); *(u32x4*)(c.bcat() + rowi * CATK + dch * 8) = w;
            const f32x4 a = *(const f32x4*)(c.kvs() + rowi * 256 + dch * 8), b = *(const f32x4*)(c.kvs() + rowi * 256 + dch * 8 + 4);
            S[0] = S[0] * dec + a.x; S[1] = S[1] * dec + a.y; S[2] = S[2] * dec + a.z; S[3] = S[3] * dec + a.w; S[4] = S[4] * dec + b.x; S[5] = S[5] * dec + b.y; S[6] = S[6] * dec + b.z; S[7] = S[7] * dec + b.w; }
        float* o = c.p.out + O_RETP + ((size_t)(layer * BATCH + s) * RET_HEADS + head) * RET_DK * RET_DV + (size_t)(dch * 8) * RET_DV + e;
#pragma unroll
        for (int k = 0; k < 8; ++k) o[(size_t)k * RET_DV] = S[k]; }
}
__device__ __forceinline__ void ph_ret_sample(const Ctx& c, Frame F, int layer) { F.tid = opq((int)threadIdx.x); F.lane = F.tid & 63;
    lds_f32* qd = (lds_f32*)(F.lds); lds_f32* kd = qd + 8 * 256; lds_f32* vv = kd + 8 * 256; lds_f32* sc = vv + 8 * 256; lds_f32* part = sc + 64;
    for (int item = blockIdx.x; item < DEC_BATCH * 4 * 2; item += gridDim.x) { const int eh = item & 1, head = (item >> 1) & 3, b = item >> 3; const float l2g = log2gamma(head);
        __syncthreads();
        for (int i = F.tid; i < 8 * 256; i += MK_THREADS) { const int t = i >> 8, d = i & 255; const float* r = c.sqkv() + (size_t)(b * 8 + t) * 4096;
            qd[i] = r[head * 256 + d]; kd[i] = r[1024 + head * 256 + d]; vv[i] = r[2048 + head * 512 + eh * 256 + d]; }
        __syncthreads();
        if (F.tid < 64) { const int t = F.tid >> 3, m = F.tid & 7; float a = 0.f; if (m <= t) { for (int d = 0; d < 256; ++d) a += qd[t * 256 + d] * kd[m * 256 + d]; a *= exp2f((float)(t - m) * l2g); } sc[F.tid] = a; }
        __syncthreads();
        const int el = F.tid & 255, dh = F.tid >> 8, e = eh * 256 + el; const size_t sbase = ((size_t)(layer * DEC_BATCH + b) * RET_HEADS + head) * RET_DK * RET_DV;
        float o[8], vloc[8], qdec[8], kdec[8];
#pragma unroll
        for (int t = 0; t < 8; ++t) { o[t] = 0.f; vloc[t] = vv[t * 256 + el]; qdec[t] = exp2f((float)(t + 1) * l2g); kdec[t] = exp2f((float)(7 - t) * l2g); }
        const float dec8 = exp2f(8.f * l2g);
        float kv8[8];
#pragma unroll
        for (int t = 0; t < 8; ++t) kv8[t] = kdec[t] * vloc[t];
#pragma unroll 1
        for (int d0 = dh * 128; d0 < dh * 128 + 128; d0 += 8) { float s0[8];
#pragma unroll
            for (int k = 0; k < 8; ++k) s0[k] = c.p.state_ret[sbase + (size_t)(d0 + k) * RET_DV + e];
#pragma unroll
            for (int k = 0; k < 8; ++k) { const int d = d0 + k; float sn = s0[k] * dec8;
#pragma unroll
                for (int t = 0; t < 8; ++t) { o[t] += qd[t * 256 + d] * s0[k]; sn += kd[t * 256 + d] * kv8[t]; }
                c.p.out[O_RETS + sbase + (size_t)d * RET_DV + e] = sn; } }
        if (dh == 1) {
#pragma unroll
            for (int t = 0; t < 8; ++t) part[t * 256 + el] = o[t]; }
        __syncthreads();
        if (dh == 0) {
#pragma unroll
            for (int t = 0; t < 8; ++t) { float a = (o[t] + part[t * 256 + el]) * qdec[t];
#pragma unroll
                for (int m = 0; m < 8; ++m) if (m <= t) a += sc[t * 8 + m] * vloc[m];
                c.o()[(size_t)(NP + b * 8 + t) * 2048 + head * 512 + e] = (bf16)f2bf(a); } }
    }
    __syncthreads();
}
__device__ __forceinline__ void ph_ret_gate(const Ctx& c, Frame F) { F.tid = opq((int)threadIdx.x); F.lane = F.tid & 63;
    for (long i = opq_s(F.gw); i < (long)NT * RET_HEADS; i += F.ngw) { const size_t off = (size_t)i * RET_DV + F.lane * 8; float o[8], g[8]; bf8_to_f32(*(const u32x4*)(c.o() + off), o); bf8_to_f32(*(const u32x4*)(c.sg() + off), g);
        float ss = 0.f;
#pragma unroll
        for (int k = 0; k < 8; ++k) ss += o[k] * o[k];
        ss = wave_sum(ss); const float rs = 1.f / sqrtf(ss * (1.f / RET_DV) + EPS);
        u32x4 w; w.x = pk2(o[0] * rs * g[0], o[1] * rs * g[1]); w.y = pk2(o[2] * rs * g[2], o[3] * rs * g[3]); w.z = pk2(o[4] * rs * g[4], o[5] * rs * g[5]); w.w = pk2(o[6] * rs * g[6], o[7] * rs * g[7]);
        *(u32x4*)(c.g() + off) = w; }
}
__device__ __forceinline__ void ph_conv(const Ctx& c, Frame F, int layer) { F.tid = opq((int)threadIdx.x); F.lane = F.tid & 63;
    constexpr int NCHK = D_FF / 8, NSEG = NT / 64; const float* cw = c.p.ffn_conv_w + (size_t)layer * 3 * D_FF; const float* cb = c.p.ffn_conv_b + (size_t)layer * D_FF;
    for (long it = (long)opq_s(blockIdx.x) * MK_THREADS + opq(F.tid); it < (long)NSEG * NCHK; it += (long)gridDim.x * MK_THREADS) { const int ch = (int)(it % NCHK), seg = (int)(it / NCHK), f = ch * 8, row0 = seg * 64; const bool prompt = row0 < NP;
        float w0[8], w1[8], w2[8], bb[8];
#pragma unroll
        for (int k = 0; k < 2; ++k) { const f32x4 a = *(const f32x4*)(cw + f + 4 * k), b = *(const f32x4*)(cw + D_FF + f + 4 * k), d = *(const f32x4*)(cw + 2 * D_FF + f + 4 * k), e = *(const f32x4*)(cb + f + 4 * k);
            w0[4 * k] = a.x; w0[4 * k + 1] = a.y; w0[4 * k + 2] = a.z; w0[4 * k + 3] = a.w; w1[4 * k] = b.x; w1[4 * k + 1] = b.y; w1[4 * k + 2] = b.z; w1[4 * k + 3] = b.w;
            w2[4 * k] = d.x; w2[4 * k + 1] = d.y; w2[4 * k + 2] = d.z; w2[4 * k + 3] = d.w; bb[4 * k] = e.x; bb[4 * k + 1] = e.y; bb[4 * k + 2] = e.z; bb[4 * k + 3] = e.w; }
        float u1[8], u2[8];
#pragma unroll
        for (int k = 0; k < 8; ++k) { u1[k] = 0.f; u2[k] = 0.f; }
        if (prompt && (row0 % SEQ) != 0) { bf8_to_f32(*(const u32x4*)(c.u() + (size_t)(row0 - 1) * D_FF + f), u1); bf8_to_f32(*(const u32x4*)(c.u() + (size_t)(row0 - 2) * D_FF + f), u2); }
#pragma unroll 1
        for (int r4 = 0; r4 < 64; r4 += 4) { u32x4 uu[4], gg[4];
#pragma unroll
            for (int j = 0; j < 4; ++j) { const size_t off = (size_t)(row0 + r4 + j) * D_FF + f; uu[j] = *(const u32x4*)(c.u() + off); gg[j] = *(const u32x4*)(c.gt() + off); }
#pragma unroll
            for (int j = 0; j < 4; ++j) { const int row = row0 + r4 + j;
                if (!prompt && ((row - NP) % DEC_SEQ) == 0) { const float* buf = c.p.state_conv + ((size_t)(layer * DEC_BATCH + (row - NP) / DEC_SEQ) * 2) * D_FF + f;
#pragma unroll
                    for (int k = 0; k < 8; ++k) { u2[k] = buf[k]; u1[k] = buf[D_FF + k]; } }
                float u0[8], gt[8], rr[8]; bf8_to_f32(uu[j], u0); bf8_to_f32(gg[j], gt);
#pragma unroll
                for (int k = 0; k < 8; ++k) { const float cc = bb[k] + w0[k] * u2[k] + w1[k] * u1[k] + w2[k] * u0[k]; rr[k] = gelu_tanh(cc) * gt[k]; u2[k] = u1[k]; u1[k] = u0[k]; }
                u32x4 w; w.x = pk2(rr[0], rr[1]); w.y = pk2(rr[2], rr[3]); w.z = pk2(rr[4], rr[5]); w.w = pk2(rr[6], rr[7]); *(u32x4*)(c.act() + (size_t)row * D_FF + f) = w; } } }
}

struct SchedResSplit { const char* A; const char* B; int ld, nt, G, c;
    __device__ __forceinline__ bool next(int i, pg8::Unit& u) const { const long L = (long)i * G + c;
        if (L < 256) { const int w = (int)(L % 32), gid = (int)(L / 32); u.pm = gid * 8 + w % 8; u.pn = w / 8; u.nt = nt; u.aux = 0; u.A = A + (size_t)u.pm * 256 * ld * 2; u.B = B + (size_t)u.pn * 256 * ld * 2; return true; }
        const int j = (int)(L - 256); if (j >= 32) return false;
        const int pn = j >> 3, sl = j & 7, pairs = nt / 2, q = pairs / 8, rm = pairs % 8, t0 = 2 * (sl * q + (sl < rm ? sl : rm)), np = q + (sl < rm ? 1 : 0);
        u.pm = 64; u.pn = pn; u.nt = 2 * np; u.aux = 16 + sl; u.A = A + (size_t)64 * 256 * ld * 2 + (size_t)t0 * 128; u.B = B + (size_t)pn * 256 * ld * 2 + (size_t)t0 * 128; return true; }
};
__device__ __forceinline__ void ph_fix_sample(const Ctx& c, Frame F, bool dry) { F.tid = opq((int)threadIdx.x); F.lane = F.tid & 63;
    const float* P = (const float*)(c.p.ws + OW_SPLITK);
    for (int rl = opq_s(F.gw); rl < NS; rl += F.ngw) { const int r = NP + rl; float s = 0.f;
#pragma unroll
        for (int j = 0; j < 4; ++j) { f32x4 v = ((const f32x4*)(c.x() + (size_t)r * D_MODEL))[F.lane + 64 * j];
#pragma unroll
            for (int sl = 0; sl < 8; ++sl) v = v + ((const f32x4*)(P + ((size_t)sl * 256 + rl) * D_MODEL))[F.lane + 64 * j];
            s += (v.x * v.x + v.y * v.y) + (v.z * v.z + v.w * v.w);
            if (!dry) { ((f32x4*)(c.x() + (size_t)r * D_MODEL))[F.lane + 64 * j] = v; u32x2 w; w.x = pk2(v.x, v.y); w.y = pk2(v.z, v.w); ((u32x2*)(c.xb() + (size_t)r * D_MODEL))[F.lane + 64 * j] = w; } }
        s = wave_sum(s); if (F.lane < 16 && !dry) c.ssq()[(size_t)r * 16 + F.lane] = F.lane == 0 ? s : 0.f; }
}
__device__ __forceinline__ const float* paged_row_f(const float* cache, const int* pt, int b, int p) { const int page = pt[b * N_PAGES + p / PAGE_SIZE]; return cache + ((size_t)page * PAGE_SIZE + p % PAGE_SIZE) * KVROW; }
__device__ __forceinline__ void ph_cmp_convert(const Ctx& c, Frame F) { F.tid = opq((int)threadIdx.x); F.lane = F.tid & 63;
    const int cc = F.lane >> 5, kvh = (F.lane >> 3) & 3, d = (F.lane & 7) * 8;
    for (long i0 = (long)opq_s(F.gw) * 8; i0 < (long)DEC_BATCH * PAST_LEN; i0 += (long)F.ngw * 8) { const int b = (int)(i0 / PAST_LEN), p = (int)(i0 % PAST_LEN);
        const float* src = paged_row_f(c.p.cache_cmp, c.p.page_table, b, p) + F.lane * 8; f32x4 a[8], bb[8];
#pragma unroll
        for (int k = 0; k < 8; ++k) { a[k] = ((const f32x4*)(src + (size_t)k * KVROW))[0]; bb[k] = ((const f32x4*)(src + (size_t)k * KVROW))[1]; }
        bf16* dst = c.asub() + ((size_t)((cc * N_KV + kvh) * NSEQ + BATCH + b) * 512 + p / 16) * 1024 + (p % 16) * 64 + d;
#pragma unroll
        for (int k = 0; k < 8; ++k) *(u32x4*)(dst + k * 64) = pack8(a[k], bb[k]); }
}
struct SchedCmp { const Ctx* c; int G, cu;
    __device__ __forceinline__ bool next(int i, pg8::Unit& u) const { const long L = (long)i * G + cu; constexpr int NU = 8 * NSEQ * 512 / 256; if (L >= NU) return false;
        u.pm = (int)L; u.pn = 0; u.nt = 16; u.aux = 0; u.A = (const char*)(c->asub() + (size_t)L * 256 * 1024); u.B = (const char*)(c->w_cmp1() + (size_t)(L / (NU / 2)) * 256 * 1024); return true; }
};
__device__ __forceinline__ void ph_cmp_stage2(const Ctx& c, Frame F) { F.tid = opq((int)threadIdx.x); F.lane = F.tid & 63;
    lds_f32* hid = (lds_f32*)(F.lds + F.wave * 1024);
    constexpr long PER_C = (long)4 * NSEQ * 512;
#pragma unroll 1
    for (int cc = 0; cc < 2; ++cc) {
        float w2r[CMP_HID];
#pragma unroll
        for (int hh = 0; hh < CMP_HID; ++hh) w2r[hh] = c.p.cmp_w2[((size_t)cc * CMP_HID + hh) * HEAD_DIM + F.lane];
        float pb0 = 0.f, pb1 = 0.f;
#pragma unroll 8
        for (int j = 0; j < 32; ++j) { pb0 += c.posb()[(size_t)(cc * 32 + j) * CMP_HID + F.lane]; pb1 += c.posb()[(size_t)(cc * 32 + j) * CMP_HID + 64 + F.lane]; }
        const float kg = c.p.kv_knorm[F.lane];
        for (long ii0 = (long)opq_s(F.gw) * 4; ii0 < PER_C; ii0 += (long)F.ngw * 4) { float a0[4], a1[4];
#pragma unroll
            for (int k = 0; k < 4; ++k) { const bf16* p0 = c.part() + (size_t)(cc * PER_C + ii0 + k) * 256; const bf16* p1 = p0 + 256 + 128; const bool real = ((ii0 + k) % 512) < NCMP;
                a0[k] = real ? bf2f(p0[F.lane]) + bf2f(p1[F.lane]) : 0.f; a1[k] = real ? bf2f(p0[F.lane + 64]) + bf2f(p1[F.lane + 64]) : 0.f; }
#pragma unroll
            for (int k = 0; k < 4; ++k) { const long ii = ii0 + k; const int n = (int)(ii % 512), s = (int)((ii / 512) % NSEQ), kvh = (int)(ii / (512 * NSEQ));
                if (n >= NCMP) {
                    if (cc == 0) c.cmpk()[((size_t)(s * N_KV + kvh) * 512 + n) * 64 + F.lane] = 0; else c.cmpvt()[(size_t)(s * N_KV + kvh) * 64 * 512 + vtt_off(n, F.lane)] = 0; continue; }
                hid[F.lane] = gelu_tanh(a0[k] + pb0); hid[F.lane + 64] = gelu_tanh(a1[k] + pb1);
                asm volatile("s_waitcnt lgkmcnt(0)" ::: "memory");
                float o0 = 0.f, o1 = 0.f;
#pragma unroll
                for (int h4 = 0; h4 < CMP_HID / 4; ++h4) { const f32x4 hv = *(const __attribute__((address_space(3))) f32x4*)(hid + 4 * h4); o0 += hv.x * w2r[4 * h4] + hv.z * w2r[4 * h4 + 2]; o1 += hv.y * w2r[4 * h4 + 1] + hv.w * w2r[4 * h4 + 3]; }
                const float o = o0 + o1;
                asm volatile("s_waitcnt lgkmcnt(0)" ::: "memory");
                if (cc == 0) { const float ss = wave_sum(o * o); const float rs = 1.f / sqrtf(ss * (1.f / HEAD_DIM) + EPS); c.cmpk()[((size_t)(s * N_KV + kvh) * 512 + n) * 64 + F.lane] = (bf16)f2bf(o * rs * kg); }
                else c.cmpvt()[(size_t)(s * N_KV + kvh) * 64 * 512 + vtt_off(n, F.lane)] = (bf16)f2bf(o); } } }
}
__device__ __forceinline__ void kvt_item(const float* srck, const float* srcv, int pitch, bf16* dstk, bf16* dstv, int ldt, lds_f32* scr, int lane) {
#pragma unroll
    for (int i = 0; i < 8; ++i) { const int tok = i * 8 + (lane >> 3), d8 = (lane & 7) * 8; const f32x4* sp = (const f32x4*)(srck + (size_t)tok * pitch + d8); *(u32x4*)(dstk + (size_t)tok * 64 + d8) = pack8(sp[0], sp[1]); }
#pragma unroll
    for (int half = 0; half < 2; ++half) {
        { const int col4 = (lane & 7) * 4; f32x4 v[8];
#pragma unroll
          for (int i = 0; i < 8; ++i) { const int tok = i * 8 + (lane >> 3); v[i] = *(const f32x4*)(srcv + (size_t)tok * pitch + half * 32 + col4); }
#pragma unroll
          for (int i = 0; i < 8; ++i) { const int tok = i * 8 + (lane >> 3); scr[tok * 33 + col4] = v[i].x; scr[tok * 33 + col4 + 1] = v[i].y; scr[tok * 33 + col4 + 2] = v[i].z; scr[tok * 33 + col4 + 3] = v[i].w; } }
        asm volatile("s_waitcnt lgkmcnt(0)" ::: "memory");
        const int cch = lane & 7;
#pragma unroll
        for (int j = 0; j < 4; ++j) { const int n = (lane >> 3) + 8 * j; const lds_f32* s = scr + (8 * cch) * 33 + n;
            u32x4 o; o.x = pk2(s[0 * 33], s[1 * 33]); o.y = pk2(s[2 * 33], s[3 * 33]); o.z = pk2(s[4 * 33], s[5 * 33]); o.w = pk2(s[6 * 33], s[7 * 33]);
            *(u32x4*)(dstv + (size_t)(cch >> 2) * 2048 + (size_t)(half * 32 + n) * 32 + ((8 * cch) & 31)) = o; }
        asm volatile("s_waitcnt lgkmcnt(0)" ::: "memory"); }
}
__device__ __forceinline__ void ph_sel_convert(const Ctx& c, Frame F) { F.tid = opq((int)threadIdx.x); F.lane = F.tid & 63;
    lds_f32* scr = (lds_f32*)(F.lds + 8192 + F.wave * 16384);
    constexpr int NB_SEL = PAST_LEN / 64, NB_WIN = WIN_BUF / 64;
    for (long i = opq_s(F.gw); i < (long)DEC_BATCH * N_KV * (NB_SEL + NB_WIN); i += F.ngw) { const int blk = (int)(i % (NB_SEL + NB_WIN)), bk = (int)(i / (NB_SEL + NB_WIN)), kvh = bk % N_KV, b = bk / N_KV;
        if (blk < NB_SEL) { const float* src = paged_row_f(c.p.cache_sel, c.p.page_table, b, blk * 64) + kvh * 64;
            kvt_item(src, src + KVH, KVROW, c.sks() + ((size_t)bk * SELP + blk * 64) * 64, c.svts() + (size_t)bk * 64 * SELP + (size_t)blk * 4096, SELP, scr, F.lane); }
        else { const int wb = blk - NB_SEL; const float* src = c.p.cache_win + ((size_t)b * WIN_BUF + wb * 64) * KVROW + kvh * 64;
            kvt_item(src, src + KVH, KVROW, c.wks() + ((size_t)bk * WINS + wb * 64) * 64, c.wvts() + (size_t)bk * 64 * WINS + (size_t)wb * 4096, WINS, scr, F.lane); } }
    for (long i = (long)opq_s(blockIdx.x) * MK_THREADS + opq(F.tid); i < (long)DEC_BATCH * N_KV * 64 * (SELP - PAST_LEN - DEC_SEQ); i += (long)gridDim.x * MK_THREADS) { const int pt = (int)(i % (SELP - PAST_LEN - DEC_SEQ)) + PAST_LEN + DEC_SEQ, d = (int)((i / (SELP - PAST_LEN - DEC_SEQ)) % 64); const long bk = i / ((SELP - PAST_LEN - DEC_SEQ) * 64);
        c.sks()[((size_t)bk * SELP + pt) * 64 + d] = 0; c.svts()[(size_t)bk * 64 * SELP + vtt_off(pt, d)] = 0; }
    for (long i = (long)opq_s(blockIdx.x) * MK_THREADS + opq(F.tid); i < (long)DEC_BATCH * N_KV * 64 * (WINS - WIN_BUF - DEC_SEQ); i += (long)gridDim.x * MK_THREADS) { const int pt = (int)(i % (WINS - WIN_BUF - DEC_SEQ)) + WIN_BUF + DEC_SEQ, d = (int)((i / (WINS - WIN_BUF - DEC_SEQ)) % 64); const long bk = i / ((WINS - WIN_BUF - DEC_SEQ) * 64);
        c.wks()[((size_t)bk * WINS + pt) * 64 + d] = 0; c.wvts()[(size_t)bk * 64 * WINS + vtt_off(pt, d)] = 0; }
    for (long i = (long)opq_s(blockIdx.x) * MK_THREADS + opq(F.tid); i < (long)DEC_BATCH * (WIN_S - DEC_SEQ) * (KVROW / 4); i += (long)gridDim.x * MK_THREADS) { const int q4 = (int)(i % (KVROW / 4)), j = (int)((i / (KVROW / 4)) % (WIN_S - DEC_SEQ)), b = (int)(i / ((long)(KVROW / 4) * (WIN_S - DEC_SEQ)));
        ((f32x4*)(c.p.out + O_WINS + ((size_t)b * WIN_S + j) * KVROW))[q4] = ((const f32x4*)(c.p.cache_win + ((size_t)b * WIN_BUF + (WIN_BUF - (WIN_S - DEC_SEQ) + j)) * KVROW))[q4]; }
}
typedef float f32x16 __attribute__((ext_vector_type(16)));
typedef short s16x8 __attribute__((ext_vector_type(8)));
typedef short s16x4 __attribute__((ext_vector_type(4)));
typedef __bf16 bf16x2_t __attribute__((ext_vector_type(2)));
typedef __attribute__((address_space(3))) unsigned lds_u32;
#define MFMA32(a, b, c) __builtin_amdgcn_mfma_f32_32x32x16_bf16((a), (b), (c), 0, 0, 0)
__device__ __forceinline__ unsigned cvtpk(float lo, float hi) { const f32x2 v = {lo, hi}; const bf16x2_t b = __builtin_convertvector(v, bf16x2_t); return __builtin_bit_cast(unsigned, b); }
__device__ __forceinline__ int crow16(int i, int h) { return (i & 3) + 8 * (i >> 2) + 4 * h; }
#define CROWK(k_) (((k_) & 3) + 4 * (((k_) >> 2) & 1) + 16 * ((k_) >> 3))
constexpr float LOG2E = 1.4426950408889634f;
typedef __attribute__((address_space(3))) unsigned char lds_u8;
__device__ __forceinline__ void att_dma_offsets(int (&ko)[4], int (&vo)[4], int lane) {
#pragma unroll
    for (int j = 0; j < 4; ++j) { const int p = 64 * j + lane; { const int row = p >> 3, ch = (p & 7) ^ ((row >> 1) & 7), key = (row & ~12) | ((row & 4) << 1) | ((row & 8) >> 1); ko[j] = key * 64 + ch * 8; }
        { const int row = p >> 2, ch = (p & 3) ^ ((row >> 2) & 3); vo[j] = row * 32 + ch * 8; } } }
__device__ __forceinline__ void att_dma(const bf16* src, const int (&off)[4], lds_u8* dst) {
#pragma unroll
    for (int j = 0; j < 4; ++j) __builtin_amdgcn_global_load_lds((const unsigned*)(src + off[j]), (__attribute__((address_space(3))) unsigned*)(dst + j * 1024), 16, 0, 0); }
__device__ __forceinline__ f32x16 att_qk_lds(const lds_u8* kb, const s16x8 (&q)[4], int r, int h) { f32x16 s;
#pragma unroll
    for (int i = 0; i < 16; ++i) s[i] = 0.f;
    const lds_u8* rowp = kb + r * 128; const int kx = (r >> 1) & 7;
#pragma unroll
    for (int ks = 0; ks < 4; ++ks) { const s16x8 kf = *(const __attribute__((address_space(3))) s16x8*)(rowp + (((2 * ks + h) ^ kx) << 4)); s = MFMA32(kf, q[ks], s); }
    return s; }
__device__ __forceinline__ void att_pv_lds(const lds_u8* vb, const float (&e)[16], f32x16 (&o)[2], int r, int h) { const int vx = (r >> 2) & 3;
#pragma unroll
    for (int s2 = 0; s2 < 2; ++s2) { u32x4 pw; pw.x = cvtpk(e[8 * s2], e[8 * s2 + 1]); pw.y = cvtpk(e[8 * s2 + 2], e[8 * s2 + 3]); pw.z = cvtpk(e[8 * s2 + 4], e[8 * s2 + 5]); pw.w = cvtpk(e[8 * s2 + 6], e[8 * s2 + 7]);
        const s16x8 pb = __builtin_bit_cast(s16x8, pw);
#pragma unroll
        for (int dt = 0; dt < 2; ++dt) { const s16x8 vf = *(const __attribute__((address_space(3))) s16x8*)(vb + (32 * dt + r) * 64 + (((2 * s2 + h) ^ vx) << 4)); o[dt] = MFMA32(vf, pb, o[dt]); } } }
#define ATT_WALK(NT_, ...) do { const int nt_ = (NT_); \
    asm volatile("s_waitcnt vmcnt(0) lgkmcnt(0)" ::: "memory"); \
    if (nt_ > 0) { att_dma(KT__(0), ko, kbuf0); if (PV__) att_dma(VT__(0), vo, vbuf0); } \
    _Pragma("unroll 1") for (int i = 0; i < nt_; ++i) { lds_u8* const kb_ = (i & 1) ? kbuf1 : kbuf0; lds_u8* const vbuf = (i & 1) ? vbuf1 : vbuf0; (void)vbuf; \
        if (i + 1 < nt_) { att_dma(KT__(i + 1), ko, (i & 1) ? kbuf0 : kbuf1); if (PV__) att_dma(VT__(i + 1), vo, (i & 1) ? vbuf0 : vbuf1); \
            if (PV__) asm volatile("s_waitcnt vmcnt(8)" ::: "memory"); else asm volatile("s_waitcnt vmcnt(4)" ::: "memory"); } \
        else asm volatile("s_waitcnt vmcnt(0)" ::: "memory"); \
        const f32x16 sc = att_qk_lds(kb_, q, r, h); __VA_ARGS__ \
        asm volatile("s_waitcnt lgkmcnt(0)" ::: "memory"); } } while (0)
__device__ __forceinline__ void ph_attention(const Ctx& c, Frame F, int jq, int rep) { F.tid = opq((int)threadIdx.x); F.lane = F.tid & 63;
    const int lane = F.lane, r = lane & 31, h = lane >> 5, qi = r >> 2, g = r & 3;
    lds_u8* const wl = (lds_u8*)(F.lds + F.wave * 17920);
    lds_u32* selm = (lds_u32*)wl; __attribute__((address_space(3))) int* tl = (__attribute__((address_space(3))) int*)(wl + 256);
    lds_u8* const kbuf0 = wl + 1536; lds_u8* const kbuf1 = wl + 5632; lds_u8* const vbuf0 = wl + 9728; lds_u8* const vbuf1 = wl + 13824; lds_f32* imp = (lds_f32*)vbuf1;
    int ko[4], vo[4]; att_dma_offsets(ko, vo, lane);
    unsigned* ctr0 = (unsigned*)(c.p.ws + OW_CTL) + 8192 + (jq * 2 + rep) * 512;
    const unsigned x0 = xb_xcc_id() & 7u;
    float gq = fabsf(c.p.nsa_qnorm[jq * HEAD_DIM + lane]), gk0 = fabsf(c.p.kv_knorm[lane]), gk1 = fabsf(c.p.kv_knorm[HEAD_DIM + lane]), gk2 = fabsf(c.p.kv_knorm[2 * HEAD_DIM + lane]);
#pragma unroll
    for (int o = 1; o < 64; o <<= 1) { gq = fmaxf(gq, __shfl_xor(gq, o)); gk0 = fmaxf(gk0, __shfl_xor(gk0, o)); gk1 = fmaxf(gk1, __shfl_xor(gk1, o)); gk2 = fmaxf(gk2, __shfl_xor(gk2, o)); }
    const float c1 = 0.125f * LOG2E, c2c = 8.1f * gq * gk0 * LOG2E, c2s = 8.1f * gq * gk1 * LOG2E, c2w = 8.1f * gq * gk2 * LOG2E;
    constexpr int NQ_S = DEC_BATCH * N_KV / 8, NQ_P = SEQ / 8;
    for (int kx = 0; kx < 8; ++kx) { const int xq = (int)((x0 + kx) & 7u); unsigned* ctr = ctr0 + 64 * xq;
    for (;;) {
        unsigned ui = 0; if (lane == 0) ui = __hip_atomic_fetch_add(ctr, 1u, __ATOMIC_RELAXED, __HIP_MEMORY_SCOPE_AGENT); ui = __builtin_amdgcn_readfirstlane(ui);
        if (ui >= (unsigned)(NQ_S + NQ_P)) break;
        int s, kvh, row0, pos0; bool prompt;
        if (ui < (unsigned)NQ_S) { prompt = false; const int v = xq * NQ_S + (int)ui, b = v / N_KV; kvh = v % N_KV; s = BATCH + b; row0 = NP + b * DEC_SEQ; pos0 = PAST_LEN; }
        else { prompt = true; const int tg = (SEQ / 8 - 1) - ((int)ui - NQ_S); s = xq / N_KV; kvh = xq % N_KV; row0 = s * SEQ + tg * 8; pos0 = tg * 8; }
        const int pos = pos0 + qi, posmax = pos0 + 7, cur = pos0 >> 6; const int head = kvh * GROUP + g, row = row0 + qi;
        const bf16* ck = c.cmpk() + (size_t)(s * N_KV + kvh) * 512 * 64; const bf16* cvt = c.cmpvt() + (size_t)(s * N_KV + kvh) * 64 * 512;
        const bf16 *sk, *svt, *wk, *wvt; size_t svp, wvp; int wbase;
        if (prompt) { sk = c.sk() + (size_t)(s * N_KV + kvh) * SEQ * 64; svt = c.svt() + (size_t)(s * N_KV + kvh) * 64 * SEQ; svp = SEQ; wk = c.wk() + (size_t)(s * N_KV + kvh) * SEQ * 64; wvt = c.wvt() + (size_t)(s * N_KV + kvh) * 64 * SEQ; wvp = SEQ; wbase = 0; }
        else { const int bk = (s - BATCH) * N_KV + kvh; sk = c.sks() + (size_t)bk * SELP * 64; svt = c.svts() + (size_t)bk * 64 * SELP; svp = SELP; wk = c.wks() + (size_t)bk * WINS * 64; wvt = c.wvts() + (size_t)bk * 64 * WINS; wvp = WINS; wbase = PAST_LEN - WIN_BUF; }
        f32x16 ob[2], ot[2];
#pragma unroll
        for (int i = 0; i < 16; ++i) { ob[0][i] = 0.f; ob[1][i] = 0.f; }
        const float gate0 = c.gates()[(size_t)row * 48 + head * 3 + 0], gate1 = c.gates()[(size_t)row * 48 + head * 3 + 1], gate2 = c.gates()[(size_t)row * 48 + head * 3 + 2];
        s16x8 q[4];
        {   const bf16* qb = c.qc() + ((size_t)row * N_HEADS + head) * 64 + 8 * h;
#pragma unroll
            for (int ks = 0; ks < 4; ++ks) q[ks] = *(const s16x8*)(qb + 16 * ks);
            int nc = pos - (CMP_LEN - 1); nc = nc < 0 ? 0 : nc / CMP_STRIDE + 1; nc = nc < NCMP ? nc : NCMP;
            int ncmin = pos0 - (CMP_LEN - 1); ncmin = ncmin < 0 ? 0 : ncmin / CMP_STRIDE + 1; ncmin = ncmin < NCMP ? ncmin : NCMP;
            int ncmax = posmax - (CMP_LEN - 1); ncmax = ncmax < 0 ? 0 : ncmax / CMP_STRIDE + 1; ncmax = ncmax < NCMP ? ncmax : NCMP;
            float l = 0.f;
#define KP_(i_) (ck + (size_t)(i_) * 32 * 64)
#define VP_(i_) (cvt + (size_t)(i_) * 2048)

#define KT__(i_) KP_(i_)
#define VT__(i_) VP_(i_)
#define PV__ 1
            ATT_WALK((ncmax + 31) >> 5, { const int lim = nc - i * 32 - 8 * h; float e[16];
                if (i * 32 + 32 <= ncmin) { _Pragma("unroll") for (int k = 0; k < 16; ++k) { e[k] = __builtin_amdgcn_exp2f(sc[k] * c1 - c2c); l += e[k]; } }
                else { _Pragma("unroll") for (int k = 0; k < 16; ++k) { e[k] = (CROWK(k) < lim) ? __builtin_amdgcn_exp2f(sc[k] * c1 - c2c) : 0.f; l += e[k]; } }
                att_pv_lds(vbuf, e, ob, r, h); });
#undef KT__
#undef VT__
#undef PV__

            l += __shfl_xor(l, 32);
            const float invl = 1.f / (l > TINY ? l : TINY), f0 = gate0 * invl;
#pragma unroll
            for (int i = 0; i < 16; ++i) { ot[0][i] = ob[0][i] * f0; ot[1][i] = ob[1][i] * f0; ob[0][i] = 0.f; ob[1][i] = 0.f; }
            for (int i = lane; i < 8 * 128; i += 64) imp[i] = 0.f;
            if (lane < 64) selm[lane] = 0u;

#define KT__(i_) KP_(i_)
#define VT__(i_) VP_(i_)
#define PV__ 0
            ATT_WALK((ncmax + 31) >> 5, { const int n0 = i * 32, lim = nc - n0 - 8 * h;
                _Pragma("unroll") for (int a = 0; a < 4; ++a) { float e4[4];
                    _Pragma("unroll") for (int k = 0; k < 4; ++k) { const int ii = 4 * a + k; e4[k] = (CROWK(ii) < lim) ? __builtin_amdgcn_exp2f(sc[ii] * c1 - c2c) * invl : 0.f; }
                    float u = (e4[0] + e4[1]) + (e4[2] + 0.5f * e4[3]), v = 0.5f * e4[3];
                    u += __shfl_xor(u, 1); u += __shfl_xor(u, 2); v += __shfl_xor(v, 1); v += __shfl_xor(v, 2);
                    const int sb = (n0 >> 2) + 4 * (a >> 1) + (a & 1) + 2 * h;
                    if (g == 0 && sb < 127) { __hip_atomic_fetch_add(imp + qi * 128 + sb, u, __ATOMIC_RELAXED, __HIP_MEMORY_SCOPE_WORKGROUP); __hip_atomic_fetch_add(imp + qi * 128 + sb + 1, v, __ATOMIC_RELAXED, __HIP_MEMORY_SCOPE_WORKGROUP); } } });
#undef KT__
#undef VT__
#undef PV__

#undef KP_
#undef VP_
        }
        {   const int tq = lane >> 3, sub = lane & 7; const int nforced = cur == 0 ? 1 : (cur == 1 ? 2 : 3), kx = SEL_TOPK - nforced, ncand = cur - 2 > 0 ? cur - 2 : 0;
            if (c.p.dbg_topi) {
                if (sub == 0) { const int* ti = c.p.dbg_topi + ((size_t)(row0 + tq) * N_KV + kvh) * SEL_TOPK; for (int k = 0; k < SEL_TOPK; ++k) { const int sb = ti[k]; if (sb >= 0) selm[tq * 8 + (sb >> 5)] |= 1u << (sb & 31); } }
            } else {
            if (sub == 0) { selm[tq * 8 + 0] |= 1u; selm[tq * 8 + (cur >> 5)] |= 1u << (cur & 31); if (cur >= 1) selm[tq * 8 + ((cur - 1) >> 5)] |= 1u << ((cur - 1) & 31); }
            if (ncand <= kx) { if (sub == 0) for (int sb = 1; sb <= cur - 2; ++sb) selm[tq * 8 + (sb >> 5)] |= 1u << (sb & 31); }
            else for (int it = 0; it < kx; ++it) { float best = -3e38f; int bi = 0x7fffffff;
                for (int sb = 1 + sub; sb <= cur - 2; sb += 8) { const float v = imp[tq * 128 + sb]; if (v > best) { best = v; bi = sb; } }
#pragma unroll
                for (int o = 1; o < 8; o <<= 1) { const float ob2 = __shfl_xor(best, o); const int oi = __shfl_xor(bi, o); if (ob2 > best || (ob2 == best && oi < bi)) { best = ob2; bi = oi; } }
                if (bi != 0x7fffffff) { if (sub == ((bi - 1) & 7)) imp[tq * 128 + bi] = -3.4e38f; if (sub == 0) selm[tq * 8 + (bi >> 5)] |= 1u << (bi & 31); } }
            }
        }
        {   const bf16* qb = c.qr() + ((size_t)row * N_HEADS + head) * 64 + 8 * h;
#pragma unroll
            for (int ks = 0; ks < 4; ++ks) q[ks] = *(const s16x8*)(qb + 16 * ks);
            float l = 0.f;
            int ntl = 0;
            for (int sb = 0; sb <= cur; ++sb) { const unsigned mw = selm[qi * 8 + (sb >> 5)]; const bool bit = (mw >> (sb & 31)) & 1u; if (!__any(bit)) continue;
                const bool two = sb * 64 + 32 <= posmax; if (lane == 0) { tl[ntl] = sb * 64; if (two) tl[ntl + 1] = sb * 64 + 32; } ntl += two ? 2 : 1; }
#define KP_(i_) (sk + (size_t)tl[(i_)] * 64)
#define VP_(i_) (svt + (size_t)(tl[(i_)] >> 5) * 2048)

#define KT__(i_) KP_(i_)
#define VT__(i_) VP_(i_)
#define PV__ 1
            ATT_WALK(ntl, { const int tok0 = tl[i], sb = tok0 >> 6; const bool bit = (selm[qi * 8 + (sb >> 5)] >> (sb & 31)) & 1u; const int lim = bit ? pos - tok0 - 8 * h : -1; float e[16];
                if (tok0 + 31 <= pos0) { const float c2e = bit ? c2s : 1e30f; _Pragma("unroll") for (int k = 0; k < 16; ++k) { e[k] = __builtin_amdgcn_exp2f(sc[k] * c1 - c2e); l += e[k]; } }
                else { _Pragma("unroll") for (int k = 0; k < 16; ++k) { e[k] = (CROWK(k) <= lim) ? __builtin_amdgcn_exp2f(sc[k] * c1 - c2s) : 0.f; l += e[k]; } }
                att_pv_lds(vbuf, e, ob, r, h); });
#undef KT__
#undef VT__
#undef PV__

#undef KP_
#undef VP_
            l += __shfl_xor(l, 32);
            { const float f1 = gate1 / (l > TINY ? l : TINY);
#pragma unroll
              for (int i = 0; i < 16; ++i) { ot[0][i] += ob[0][i] * f1; ot[1][i] += ob[1][i] * f1; ob[0][i] = 0.f; ob[1][i] = 0.f; } }
            l = 0.f;
            int lo = pos0 - (WINDOW - 1); if (lo < wbase) lo = wbase; if (lo < 0) lo = 0; const int i0 = (lo - wbase) & ~31;
#define KP_(i_) (wk + (size_t)(i0 + 32 * (i_)) * 64)
#define VP_(i_) (wvt + (size_t)((i0 >> 5) + (i_)) * 2048)

#define KT__(i_) KP_(i_)
#define VT__(i_) VP_(i_)
#define PV__ 1
            ATT_WALK(((posmax - wbase - i0) >> 5) + 1, { const int tok0 = i0 + 32 * i + wbase; const int hi_ = pos - tok0 - 8 * h, lo_ = hi_ - WINDOW; float e[16];
                if (tok0 + 31 <= pos0 && tok0 > posmax - WINDOW) { _Pragma("unroll") for (int k = 0; k < 16; ++k) { e[k] = __builtin_amdgcn_exp2f(sc[k] * c1 - c2w); l += e[k]; } }
                else { _Pragma("unroll") for (int k = 0; k < 16; ++k) { e[k] = (CROWK(k) <= hi_ && CROWK(k) > lo_) ? __builtin_amdgcn_exp2f(sc[k] * c1 - c2w) : 0.f; l += e[k]; } }
                att_pv_lds(vbuf, e, ob, r, h); });
#undef KT__
#undef VT__
#undef PV__

#undef KP_
#undef VP_
            l += __shfl_xor(l, 32);
            { const float f2 = gate2 / (l > TINY ? l : TINY);
#pragma unroll
              for (int i = 0; i < 16; ++i) { ob[0][i] = ot[0][i] + ob[0][i] * f2; ob[1][i] = ot[1][i] + ob[1][i] * f2; } }
        }
        bf16* od = c.ao() + (size_t)row * D_Q + head * 64;
#pragma unroll
        for (int dt = 0; dt < 2; ++dt)
#pragma unroll
            for (int a = 0; a < 4; ++a) { u32x2 w; w.x = cvtpk(ob[dt][4 * a], ob[dt][4 * a + 1]); w.y = cvtpk(ob[dt][4 * a + 2], ob[dt][4 * a + 3]); *(u32x2*)(od + 32 * dt + 8 * a + 4 * h) = w; }
    }
    }
}
constexpr int PH_KVQG = 19, PH_CMPG = 20, PH_CMP2 = 21, PH_ATT0 = 22, PH_QG1 = 27, PH_ATT1 = 28, NPH = 33;
__device__ __forceinline__ void gemm_dense(const Ctx& c, const Frame& F, const bf16* A, int lda, const bf16* B, int ldb, int nM, int nN, int K) { (void)c; (void)F; (void)A; (void)lda; (void)B; (void)ldb; (void)nM; (void)nN; (void)K; }
#ifndef OPT_ATTN
__device__ __forceinline__ void ph_attention(const Ctx& c, const Frame& F, int jq, int rep) { (void)c; (void)F; (void)jq; (void)rep; }
#endif
__global__ void __launch_bounds__(MK_THREADS, 2) fwd(OptP p) {
    extern __shared__ __attribute__((aligned(16))) unsigned char lds_raw[];
    Frame F; F.lds = (__attribute__((address_space(3))) unsigned char*)lds_raw; F.tid = threadIdx.x; F.lane = F.tid & 63; F.wave = __builtin_amdgcn_readfirstlane(F.tid >> 6);
    F.gw = blockIdx.x * NWAVES + F.wave; F.ngw = gridDim.x * NWAVES;
    volatile LAS unsigned* misc = (volatile LAS unsigned*)(F.lds + MK_LDS - 64);
    if (F.tid < 4) misc[F.tid] = 0u;
    __syncthreads();
    XcdBarrier bar = xcd_barrier_post((unsigned*)(p.ws + OW_CTL) + 4096, misc);
    const int lo = (int)p.ph_lo, hi = (int)p.ph_hi, G = gridDim.x, cu = blockIdx.x; const unsigned long long dupm = (unsigned long long)p.dup;
#ifdef ONLY_PHASE
#define IN(k) ((k) == ONLY_PHASE)
#else
#define IN(k) (lo <= (k) && (k) < hi)
#endif
#ifdef DOUBLE_BARRIER
#define SEAM(k) do { if (IN(k) && IN((k) + 1)) { xcd_barrier(bar); xcd_barrier(bar); } } while (0)
#else
#define SEAM(k) do { if (IN(k) && IN((k) + 1)) xcd_barrier(bar); } while (0)
#endif
    PG8_LAS unsigned char* gl = (PG8_LAS unsigned char*)F.lds;
    if (IN(0)) for (int rep = (int)((dupm >> (0)) & 1ull); rep >= 0; --rep) { const Ctx c{*kargs()}; p0_prologue(c, F); } SEAM(0);
    { constexpr int l = 0; constexpr int b0 = 1 + 9 * l;
        if (IN(b0)) for (int rep = (int)((dupm >> (b0)) & 1ull); rep >= 0; --rep) { const Ctx c{*kargs()}; SchedDense S{(const char*)c.xb(), (const char*)(c.w_retin() + (size_t)l * 6 * D_MODEL * D_MODEL), D_MODEL, D_MODEL, NPAN, 24, 16, opq_s(G), opq_s(cu)}; EpiRetIn E{&c, (lds_b*)(F.lds + 131072)}; pg8::gemm_phase(gl, D_MODEL, D_MODEL, S, E); } SEAM(b0);
        if (IN(b0 + 1)) for (int rep = (int)((dupm >> (b0 + 1)) & 1ull); rep >= 0; --rep) { const Ctx c{*kargs()}; { SchedPKV S{&c, opq_s(G), opq_s(cu), 0}; EpiP E{&c}; pg8::gemm_phase(gl, 1024, 1024, S, E); }
                          { SchedPKV S{&c, opq_s(G), opq_s(cu), 1}; EpiKV E{&c}; pg8::gemm_phase(gl, CATK, SEQ, S, E); }
                          ph_ret_sample(c, F, l); } SEAM(b0 + 1);
        if (IN(b0 + 2)) for (int rep = (int)((dupm >> (b0 + 2)) & 1ull); rep >= 0; --rep) { const Ctx c{*kargs()}; ph_ret_scan(c, F, l); } SEAM(b0 + 2);
        if (IN(b0 + 3)) for (int rep = (int)((dupm >> (b0 + 3)) & 1ull); rep >= 0; --rep) { const Ctx c{*kargs()}; SchedOut S{&c, opq_s(G), opq_s(cu)}; EpiOut E{&c}; pg8::gemm_phase(gl, 4 * CATK, CATK, S, E); } SEAM(b0 + 3);
        if (IN(b0 + 4)) for (int rep = (int)((dupm >> (b0 + 4)) & 1ull); rep >= 0; --rep) { const Ctx c{*kargs()}; ph_ret_gate(c, F); } SEAM(b0 + 4);
        if (IN(b0 + 5)) for (int rep = (int)((dupm >> (b0 + 5)) & 1ull); rep >= 0; --rep) { const Ctx c{*kargs()}; SchedResSplit S{(const char*)c.g(), (const char*)(c.w_retout() + (size_t)l * 2 * D_MODEL * D_MODEL), 2 * D_MODEL, 32, opq_s(G), opq_s(cu)}; EpiRes E{&c, rep != 0}; pg8::gemm_phase(gl, 2 * D_MODEL, 2 * D_MODEL, S, E); xcd_barrier(bar); ph_fix_sample(c, F, rep != 0); } SEAM(b0 + 5);
        if (IN(b0 + 6)) for (int rep = (int)((dupm >> (b0 + 6)) & 1ull); rep >= 0; --rep) { const Ctx c{*kargs()}; SchedDense S{(const char*)c.xb(), (const char*)(c.w_ffnin() + (size_t)l * 2 * D_FF * D_MODEL), D_MODEL, D_MODEL, NPAN, 22, 16, opq_s(G), opq_s(cu)}; EpiFfnIn E{&c, l}; pg8::gemm_phase(gl, D_MODEL, D_MODEL, S, E); } SEAM(b0 + 6);
        if (IN(b0 + 7)) for (int rep = (int)((dupm >> (b0 + 7)) & 1ull); rep >= 0; --rep) { const Ctx c{*kargs()}; ph_conv(c, F, l); } SEAM(b0 + 7);
        if (IN(b0 + 8)) for (int rep = (int)((dupm >> (b0 + 8)) & 1ull); rep >= 0; --rep) { const Ctx c{*kargs()}; SchedResSplit S{(const char*)c.act(), (const char*)(c.w_ffnout() + (size_t)l * D_FF * D_MODEL), D_FF, D_FF / 64, opq_s(G), opq_s(cu)}; EpiRes E{&c, rep != 0}; pg8::gemm_phase(gl, D_FF, D_FF, S, E); xcd_barrier(bar); ph_fix_sample(c, F, rep != 0); } SEAM(b0 + 8);
        }
    { constexpr int l = 1; constexpr int b0 = 1 + 9 * l;
        if (IN(b0)) for (int rep = (int)((dupm >> (b0)) & 1ull); rep >= 0; --rep) { const Ctx c{*kargs()}; SchedDense S{(const char*)c.xb(), (const char*)(c.w_retin() + (size_t)l * 6 * D_MODEL * D_MODEL), D_MODEL, D_MODEL, NPAN, 24, 16, opq_s(G), opq_s(cu)}; EpiRetIn E{&c, (lds_b*)(F.lds + 131072)}; pg8::gemm_phase(gl, D_MODEL, D_MODEL, S, E); } SEAM(b0);
        if (IN(b0 + 1)) for (int rep = (int)((dupm >> (b0 + 1)) & 1ull); rep >= 0; --rep) { const Ctx c{*kargs()}; { SchedPKV S{&c, opq_s(G), opq_s(cu), 0}; EpiP E{&c}; pg8::gemm_phase(gl, 1024, 1024, S, E); }
                          { SchedPKV S{&c, opq_s(G), opq_s(cu), 1}; EpiKV E{&c}; pg8::gemm_phase(gl, CATK, SEQ, S, E); }
                          ph_ret_sample(c, F, l); } SEAM(b0 + 1);
        if (IN(b0 + 2)) for (int rep = (int)((dupm >> (b0 + 2)) & 1ull); rep >= 0; --rep) { const Ctx c{*kargs()}; ph_ret_scan(c, F, l); } SEAM(b0 + 2);
        if (IN(b0 + 3)) for (int rep = (int)((dupm >> (b0 + 3)) & 1ull); rep >= 0; --rep) { const Ctx c{*kargs()}; SchedOut S{&c, opq_s(G), opq_s(cu)}; EpiOut E{&c}; pg8::gemm_phase(gl, 4 * CATK, CATK, S, E); } SEAM(b0 + 3);
        if (IN(b0 + 4)) for (int rep = (int)((dupm >> (b0 + 4)) & 1ull); rep >= 0; --rep) { const Ctx c{*kargs()}; ph_ret_gate(c, F); } SEAM(b0 + 4);
        if (IN(b0 + 5)) for (int rep = (int)((dupm >> (b0 + 5)) & 1ull); rep >= 0; --rep) { const Ctx c{*kargs()}; SchedResSplit S{(const char*)c.g(), (const char*)(c.w_retout() + (size_t)l * 2 * D_MODEL * D_MODEL), 2 * D_MODEL, 32, opq_s(G), opq_s(cu)}; EpiRes E{&c, rep != 0}; pg8::gemm_phase(gl, 2 * D_MODEL, 2 * D_MODEL, S, E); xcd_barrier(bar); ph_fix_sample(c, F, rep != 0); } SEAM(b0 + 5);
        if (IN(b0 + 6)) for (int rep = (int)((dupm >> (b0 + 6)) & 1ull); rep >= 0; --rep) { const Ctx c{*kargs()}; SchedDense S{(const char*)c.xb(), (const char*)(c.w_ffnin() + (size_t)l * 2 * D_FF * D_MODEL), D_MODEL, D_MODEL, NPAN, 22, 16, opq_s(G), opq_s(cu)}; EpiFfnIn E{&c, l}; pg8::gemm_phase(gl, D_MODEL, D_MODEL, S, E); } SEAM(b0 + 6);
        if (IN(b0 + 7)) for (int rep = (int)((dupm >> (b0 + 7)) & 1ull); rep >= 0; --rep) { const Ctx c{*kargs()}; ph_conv(c, F, l); } SEAM(b0 + 7);
        if (IN(b0 + 8)) for (int rep = (int)((dupm >> (b0 + 8)) & 1ull); rep >= 0; --rep) { const Ctx c{*kargs()}; SchedResSplit S{(const char*)c.act(), (const char*)(c.w_ffnout() + (size_t)l * D_FF * D_MODEL), D_FF, D_FF / 64, opq_s(G), opq_s(cu)}; EpiRes E{&c, rep != 0}; pg8::gemm_phase(gl, D_FF, D_FF, S, E); xcd_barrier(bar); ph_fix_sample(c, F, rep != 0); } SEAM(b0 + 8);
        }
    if (IN(PH_KVQG)) for (int rep = (int)((dupm >> (PH_KVQG)) & 1ull); rep >= 0; --rep) { const Ctx c{*kargs()}; { SchedDense S{(const char*)c.xb(), (const char*)c.w_kvqg(), D_MODEL, D_MODEL, NPAN, N_KVQG / 256, 16, opq_s(G), opq_s(cu)}; EpiKvqg E{&c, 0, 0}; pg8::gemm_phase(gl, D_MODEL, D_MODEL, S, E); }
                       ph_cmp_convert(c, F); } SEAM(PH_KVQG);
    if (IN(PH_CMPG)) for (int rep = (int)((dupm >> (PH_CMPG)) & 1ull); rep >= 0; --rep) { const Ctx c{*kargs()}; SchedCmp S{&c, opq_s(G), opq_s(cu)}; EpiCmp1 E{&c}; pg8::gemm_phase(gl, 1024, 1024, S, E); } SEAM(PH_CMPG);
    if (IN(PH_CMP2)) for (int rep = (int)((dupm >> (PH_CMP2)) & 1ull); rep >= 0; --rep) { const Ctx c{*kargs()};
#ifdef ABL21
        if (!(rep && ABL21 == 1)) ph_cmp_stage2(c, F); if (!(rep && ABL21 == 2)) ph_sel_convert(c, F);
#else
        ph_cmp_stage2(c, F); ph_sel_convert(c, F);
#endif
    } SEAM(PH_CMP2);
    { constexpr int jq = 0; constexpr int l = N_A + jq, a0 = jq == 0 ? PH_ATT0 : PH_ATT1;
        if (jq == 1) { if (IN(PH_QG1)) for (int rep = (int)((dupm >> (PH_QG1)) & 1ull); rep >= 0; --rep) { const Ctx c{*kargs()}; SchedDense S{(const char*)c.xb(), (const char*)c.w_qg1(), D_MODEL, D_MODEL, NPAN, N_QG1 / 256, 16, opq_s(G), opq_s(cu)}; EpiKvqg E{&c, 6, 1}; pg8::gemm_phase(gl, D_MODEL, D_MODEL, S, E); } SEAM(PH_QG1); }
        if (IN(a0)) for (int rep = (int)((dupm >> (a0)) & 1ull); rep >= 0; --rep) { const Ctx c{*kargs()}; ph_attention(c, F, jq, rep); } SEAM(a0);
        if (IN(a0 + 1)) for (int rep = (int)((dupm >> (a0 + 1)) & 1ull); rep >= 0; --rep) { const Ctx c{*kargs()}; SchedResSplit S{(const char*)c.ao(), (const char*)(c.w_wo() + (size_t)jq * D_Q * D_MODEL), D_Q, 16, opq_s(G), opq_s(cu)}; EpiRes E{&c, rep != 0}; pg8::gemm_phase(gl, D_Q, D_Q, S, E); xcd_barrier(bar); ph_fix_sample(c, F, rep != 0); } SEAM(a0 + 1);
        if (IN(a0 + 2)) for (int rep = (int)((dupm >> (a0 + 2)) & 1ull); rep >= 0; --rep) { const Ctx c{*kargs()}; SchedDense S{(const char*)c.xb(), (const char*)(c.w_ffnin() + (size_t)l * 2 * D_FF * D_MODEL), D_MODEL, D_MODEL, NPAN, 22, 16, opq_s(G), opq_s(cu)}; EpiFfnIn E{&c, l}; pg8::gemm_phase(gl, D_MODEL, D_MODEL, S, E); } SEAM(a0 + 2);
        if (IN(a0 + 3)) for (int rep = (int)((dupm >> (a0 + 3)) & 1ull); rep >= 0; --rep) { const Ctx c{*kargs()}; ph_conv(c, F, l); } SEAM(a0 + 3);
        if (IN(a0 + 4)) for (int rep = (int)((dupm >> (a0 + 4)) & 1ull); rep >= 0; --rep) { const Ctx c{*kargs()}; SchedResSplit S{(const char*)c.act(), (const char*)(c.w_ffnout() + (size_t)l * D_FF * D_MODEL), D_FF, D_FF / 64, opq_s(G), opq_s(cu)}; EpiRes E{&c, rep != 0}; pg8::gemm_phase(gl, D_FF, D_FF, S, E); xcd_barrier(bar); ph_fix_sample(c, F, rep != 0); } SEAM(a0 + 4);
        }
    { constexpr int jq = 1; constexpr int l = N_A + jq, a0 = jq == 0 ? PH_ATT0 : PH_ATT1;
        if (jq == 1) { if (IN(PH_QG1)) for (int rep = (int)((dupm >> (PH_QG1)) & 1ull); rep >= 0; --rep) { const Ctx c{*kargs()}; SchedDense S{(const char*)c.xb(), (const char*)c.w_qg1(), D_MODEL, D_MODEL, NPAN, N_QG1 / 256, 16, opq_s(G), opq_s(cu)}; EpiKvqg E{&c, 6, 1}; pg8::gemm_phase(gl, D_MODEL, D_MODEL, S, E); } SEAM(PH_QG1); }
        if (IN(a0)) for (int rep = (int)((dupm >> (a0)) & 1ull); rep >= 0; --rep) { const Ctx c{*kargs()}; ph_attention(c, F, jq, rep); } SEAM(a0);
        if (IN(a0 + 1)) for (int rep = (int)((dupm >> (a0 + 1)) & 1ull); rep >= 0; --rep) { const Ctx c{*kargs()}; SchedResSplit S{(const char*)c.ao(), (const char*)(c.w_wo() + (size_t)jq * D_Q * D_MODEL), D_Q, 16, opq_s(G), opq_s(cu)}; EpiRes E{&c, rep != 0}; pg8::gemm_phase(gl, D_Q, D_Q, S, E); xcd_barrier(bar); ph_fix_sample(c, F, rep != 0); } SEAM(a0 + 1);
        if (IN(a0 + 2)) for (int rep = (int)((dupm >> (a0 + 2)) & 1ull); rep >= 0; --rep) { const Ctx c{*kargs()}; SchedDense S{(const char*)c.xb(), (const char*)(c.w_ffnin() + (size_t)l * 2 * D_FF * D_MODEL), D_MODEL, D_MODEL, NPAN, 22, 16, opq_s(G), opq_s(cu)}; EpiFfnIn E{&c, l}; pg8::gemm_phase(gl, D_MODEL, D_MODEL, S, E); } SEAM(a0 + 2);
        if (IN(a0 + 3)) for (int rep = (int)((dupm >> (a0 + 3)) & 1ull); rep >= 0; --rep) { const Ctx c{*kargs()}; ph_conv(c, F, l); } SEAM(a0 + 3);
        if (IN(a0 + 4)) for (int rep = (int)((dupm >> (a0 + 4)) & 1ull); rep >= 0; --rep) { const Ctx c{*kargs()}; SchedResSplit S{(const char*)c.act(), (const char*)(c.w_ffnout() + (size_t)l * D_FF * D_MODEL), D_FF, D_FF / 64, opq_s(G), opq_s(cu)}; EpiRes E{&c, rep != 0}; pg8::gemm_phase(gl, D_FF, D_FF, S, E); xcd_barrier(bar); ph_fix_sample(c, F, rep != 0); } SEAM(a0 + 4);
        }
#undef IN
#undef SEAM
}
static_assert(PH_ATT0 + 5 == PH_QG1 && PH_ATT1 + 5 == NPH && 1 + 9 * N_A == PH_KVQG, "phase numbering");
static void opt_fill(OptP& p, void* const* d_in, float* out, unsigned char* ws) {
    p.x_prompt = (const float*)d_in[0]; p.x_sample = (const float*)d_in[1]; p.cache_cmp = (const float*)d_in[2]; p.cache_sel = (const float*)d_in[3]; p.cache_win = (const float*)d_in[4];
    p.state_ret = (const float*)d_in[5]; p.state_conv = (const float*)d_in[6]; p.page_table = (const int*)d_in[7]; p.norm_mix = (const float*)d_in[8]; p.norm_ffn = (const float*)d_in[9];
    p.ret_w_in = (const float*)d_in[10]; p.ret_w_out = (const float*)d_in[11]; p.ffn_w_in = (const float*)d_in[12]; p.ffn_conv_w = (const float*)d_in[13]; p.ffn_conv_b = (const float*)d_in[14];
    p.ffn_w_out = (const float*)d_in[15]; p.kv_norm = (const float*)d_in[16]; p.kv_w = (const float*)d_in[17]; p.kv_knorm = (const float*)d_in[18]; p.cmp_pos = (const float*)d_in[19];
    p.cmp_w1 = (const float*)d_in[20]; p.cmp_w2 = (const float*)d_in[21]; p.nsa_w_qg = (const float*)d_in[22]; p.nsa_qnorm = (const float*)d_in[23]; p.nsa_w_o = (const float*)d_in[24];
    p.out = out; p.ws = ws; p.ph_lo = 0; p.ph_hi = NPH;
}
static int opt_grid() {
    static int grid = 0;
    if (grid == 0) { int dev = 0, cus = 0, per_cu = 0;
        if (hipGetDevice(&dev) != hipSuccess || hipDeviceGetAttribute(&cus, hipDeviceAttributeMultiprocessorCount, dev) != hipSuccess) { grid = -1; return grid; }
        if (hipFuncSetAttribute((const void*)fwd, hipFuncAttributeMaxDynamicSharedMemorySize, MK_LDS) != hipSuccess) { fprintf(stderr, "hipFuncSetAttribute failed\n"); grid = -1; return grid; }
        if (hipOccupancyMaxActiveBlocksPerMultiprocessor(&per_cu, (const void*)fwd, MK_THREADS, MK_LDS) != hipSuccess || per_cu < 1) { fprintf(stderr, "occupancy query says %d\n", per_cu); grid = -1; return grid; }
        (void)hipGetLastError(); grid = cus; }
    return grid;
}
extern "C" void kernel_launch(void* const* d_in, const int* in_sizes, int n_in, void* d_out, int out_size, void* d_ws, size_t ws_size, hipStream_t stream) {
    const int grid = opt_grid();
    if (n_in != 25 || out_size != (int)O_END || ws_size < OW_END || grid < 0) { fprintf(stderr, "kernel_launch: sizes n_in %d out %d ws %zu need %zu grid %d\n", n_in, out_size, ws_size, (size_t)OW_END, grid); return; }
    OptP op; memset(&op, 0, sizeof(op)); opt_fill(op, d_in, (float*)d_out, (unsigned char*)d_ws);
#ifdef DUP_MASK
    op.dup = (long)(DUP_MASK);
#endif
    hipMemsetAsync((unsigned char*)d_ws + OW_CTL, 0, OW_CTL_BYTES, stream);
    hipLaunchKernelGGL(fwd, dim3(grid), dim3(MK_THREADS), MK_LDS, stream, op);
}
```

```cpp
#define OPT_ATTN
#define ROR_BPERMUTE 1
#include <hip/hip_runtime.h>
#include <cstdio>
#include <cstring>
#include <cmath>
#ifdef SMALL_CFG
constexpr int D_MODEL = 64, BATCH = 2, SEQ = 2048, DEC_BATCH = 3, DEC_SEQ = 8, PAST_LEN = 2048, N_HEADS = 8, N_KV = 2, HEAD_DIM = 32, CMP_HID = 16, D_FF = 96;
#else
constexpr int D_MODEL = 1024, BATCH = 2, SEQ = 8192, DEC_BATCH = 32, DEC_SEQ = 8, PAST_LEN = 8192, N_HEADS = 16, N_KV = 4, HEAD_DIM = 64, CMP_HID = 128, D_FF = 2816;
#endif
constexpr int DEPTH = 4, PAGE_SIZE = 128, N_A = 2, N_B = 2, RET_HEADS = 4, RET_DK = D_MODEL / RET_HEADS, RET_DV = 2 * D_MODEL / RET_HEADS, RET_CHUNK = 128;
constexpr int GROUP = N_HEADS / N_KV, CMP_LEN = 32, CMP_STRIDE = 16, SEL_BLOCK = 64, SEL_TOPK = 16, WINDOW = 512;
constexpr int D_Q = N_HEADS * HEAD_DIM, D_QG = D_Q + 3 * N_HEADS, D_KV = 6 * N_KV * HEAD_DIM, KVROW = 2 * N_KV * HEAD_DIM, KVH = N_KV * HEAD_DIM;
constexpr int NP = BATCH * SEQ, NS = DEC_BATCH * DEC_SEQ, NT = NP + NS, NSEQ = BATCH + DEC_BATCH;
constexpr int NCHP = SEQ / RET_CHUNK, NCH = BATCH * NCHP + DEC_BATCH;
constexpr int N_PAGES = PAST_LEN / PAGE_SIZE, WIN_BUF = (WINDOW < PAST_LEN ? WINDOW : PAST_LEN);
constexpr int NCMP = SEQ / CMP_STRIDE - 1;
static_assert((PAST_LEN + DEC_SEQ) / CMP_STRIDE - 1 == NCMP && PAST_LEN == SEQ, "both groups have the same compressed-block count");
constexpr int NSEL_P = SEQ / SEL_BLOCK, NSEL_S = (PAST_LEN + DEC_SEQ + SEL_BLOCK - 1) / SEL_BLOCK, NSEL_MAX = NSEL_S;
constexpr int WIN_P = (WINDOW < SEQ ? WINDOW : SEQ), WIN_S = (WINDOW < PAST_LEN + DEC_SEQ ? WINDOW : PAST_LEN + DEC_SEQ);
constexpr float EPS = 1e-6f, NEG_INF = -1e30f, TINY = 1e-30f, SEL_FORCE = 1e6f, SEL_NEG = -1e6f;
constexpr long O_YP = 0, O_YS = O_YP + (long)NP * D_MODEL, O_RETP = O_YS + (long)NS * D_MODEL, O_RETS = O_RETP + (long)N_A * BATCH * RET_HEADS * RET_DK * RET_DV,
    O_CONVP = O_RETS + (long)N_A * DEC_BATCH * RET_HEADS * RET_DK * RET_DV, O_CONVS = O_CONVP + (long)DEPTH * BATCH * 2 * D_FF, O_CMPP = O_CONVS + (long)DEPTH * DEC_BATCH * 2 * D_FF,
    O_CMPS = O_CMPP + (long)NP * KVROW, O_SELP = O_CMPS + (long)NS * KVROW, O_SELS = O_SELP + (long)NP * KVROW, O_WINP = O_SELS + (long)NS * KVROW,
    O_WINS = O_WINP + (long)BATCH * WIN_P * KVROW, O_END = O_WINS + (long)DEC_BATCH * WIN_S * KVROW;

struct NvP {
    const float *x_prompt, *x_sample, *cache_cmp, *cache_sel, *cache_win, *state_ret, *state_conv; const int* page_table;
    const float *norm_mix, *norm_ffn, *ret_w_in, *ret_w_out, *ffn_w_in, *ffn_conv_w, *ffn_conv_b, *ffn_w_out, *kv_norm, *kv_w, *kv_knorm, *cmp_pos, *cmp_w1, *cmp_w2, *nsa_w_qg, *nsa_qnorm, *nsa_w_o;
    float* out;
    float *x, *rstd, *h, *proj, *SB, *SC, *RO, *G, *act, *kv, *winbuf, *posb, *hid, *cmpk, *cmpv, *qc, *qr, *gates, *oc, *mc, *lc, *imp, *os, *ao; int* topi;
};
constexpr long cmax(long a, long b) { return a > b ? a : b; }
constexpr long NW_RSTD = 0, NW_H = NW_RSTD + NT, NW_PROJ = NW_H + (long)NT * D_MODEL, NW_ACT = NW_PROJ + (long)NT * cmax(6 * D_MODEL, 2 * D_FF), NW_UNION = NW_ACT + (long)NT * D_FF,
    NW_SB = NW_UNION, NW_SC = NW_SB + (long)NCH * RET_HEADS * RET_DK * RET_DV, NW_RO = NW_SC + (long)NCH * RET_HEADS * RET_CHUNK * RET_CHUNK, NW_G = NW_RO + (long)NT * 2 * D_MODEL, NW_A_END = NW_G + (long)NT * 2 * D_MODEL,
    NW_KV = NW_UNION, NW_WIN = NW_KV + (long)NT * D_KV, NW_POSB = NW_WIN + (long)NT * KVROW,
    NW_HID = NW_POSB + 2 * CMP_HID, NW_CMPK = NW_HID + (long)NSEQ * NCMP * 2 * N_KV * CMP_HID, NW_CMPV = NW_CMPK + (long)NSEQ * NCMP * KVH, NW_QC = NW_CMPV + (long)NSEQ * NCMP * KVH,
    NW_QR = NW_QC + (long)NT * D_Q, NW_GATES = NW_QR + (long)NT * D_Q, NW_OC = NW_GATES + (long)NT * 3 * N_HEADS, NW_MC = NW_OC + (long)NT * D_Q, NW_LC = NW_MC + (long)NT * N_HEADS,
    NW_IMP = NW_LC + (long)NT * N_HEADS, NW_OS = NW_IMP + (long)NT * N_KV * NSEL_MAX, NW_AO = NW_OS + (long)NT * D_Q, NW_TOPI = NW_AO + (long)NT * D_Q, NW_B_END = NW_TOPI + (long)NT * N_KV * SEL_TOPK,
    NW_END = ((cmax(NW_A_END, NW_B_END) + 1023) / 1024) * 1024;

struct Tok { int s, t, T, past, pos; };
__device__ __forceinline__ Tok tok_of(int r) {
    Tok k; if (r < NP) { k.s = r / SEQ; k.t = r % SEQ; k.T = SEQ; k.past = 0; k.pos = k.t; }
    else { int q = r - NP; k.s = BATCH + q / DEC_SEQ; k.t = q % DEC_SEQ; k.T = DEC_SEQ; k.past = PAST_LEN; k.pos = PAST_LEN + k.t; } return k; }
__device__ __forceinline__ int seq_row0(int s) { return s < BATCH ? s * SEQ : NP + (s - BATCH) * DEC_SEQ; }
__device__ __forceinline__ float nv_gelu(float x) { return 0.5f * x * (1.f + tanhf(0.7978845608028654f * (x + 0.044715f * x * x * x))); }
__device__ __forceinline__ float nv_silu(float x) { return x / (1.f + expf(-x)); }
__device__ __forceinline__ float nv_loggamma(int h) { return log1pf(-exp2f(-5.f - (float)h)); }
__device__ __forceinline__ float nv_ropefreq(int i, int half) { return expf(-9.210340371976184f * (float)i / (float)half); }
__device__ __forceinline__ void chunk_of(int c, int& s, int& row0, int& L) { if (c < BATCH * NCHP) { s = c / NCHP; row0 = s * SEQ + (c % NCHP) * RET_CHUNK; L = RET_CHUNK; } else { s = BATCH + (c - BATCH * NCHP); row0 = NP + (s - BATCH) * DEC_SEQ; L = DEC_SEQ; } }
__device__ __forceinline__ int chunk_of_row(int r) { return r < NP ? (r / SEQ) * NCHP + (r % SEQ) / RET_CHUNK : BATCH * NCHP + (r - NP) / DEC_SEQ; }
__device__ __forceinline__ const float* paged_row(const float* cache, const int* pt, int b, int p) { const int page = pt[b * N_PAGES + p / PAGE_SIZE]; return cache + ((long)page * PAGE_SIZE + p % PAGE_SIZE) * KVROW; }
__device__ __forceinline__ const float* cmp_row(const NvP& p, int s, int tok) { if (s < BATCH) return p.out + O_CMPP + ((long)s * SEQ + tok) * KVROW; const int b = s - BATCH; if (tok < PAST_LEN) return paged_row(p.cache_cmp, p.page_table, b, tok); return p.out + O_CMPS + ((long)b * DEC_SEQ + tok - PAST_LEN) * KVROW; }
__device__ __forceinline__ const float* sel_row(const NvP& p, int s, int tok) { if (s < BATCH) return p.out + O_SELP + ((long)s * SEQ + tok) * KVROW; const int b = s - BATCH; if (tok < PAST_LEN) return paged_row(p.cache_sel, p.page_table, b, tok); return p.out + O_SELS + ((long)b * DEC_SEQ + tok - PAST_LEN) * KVROW; }
__device__ __forceinline__ const float* win_row(const NvP& p, int s, int tok) { if (s < BATCH) return p.winbuf + ((long)s * SEQ + tok) * KVROW; const int b = s - BATCH; if (tok < PAST_LEN) return p.cache_win + ((long)b * WIN_BUF + (tok - (PAST_LEN - WIN_BUF))) * KVROW; return p.winbuf + ((long)NP + (long)b * DEC_SEQ + tok - PAST_LEN) * KVROW; }

#define GSL(i, n) for (long i = gtid; i < (long)(n); i += gsz)

__device__ void nv_init_x(const NvP& p, long gtid, long gsz) { GSL(i, (long)NT * D_MODEL) p.x[i] = i < (long)NP * D_MODEL ? p.x_prompt[i] : p.x_sample[i - (long)NP * D_MODEL]; }
__device__ void nv_rowstat(const NvP& p, long gtid, long gsz) { GSL(r, NT) { float ss = 0.f; for (int c = 0; c < D_MODEL; ++c) { float v = p.x[r * D_MODEL + c]; ss += v * v; } p.rstd[r] = 1.f / sqrtf(ss / D_MODEL + EPS); } }
__device__ void nv_norm(const NvP& p, const float* g, long gtid, long gsz) { GSL(i, (long)NT * D_MODEL) { long r = i / D_MODEL; int c = (int)(i % D_MODEL); p.h[i] = p.x[i] * p.rstd[r] * g[c]; } }
__device__ void nv_gemm(const float* A, const float* W, float* C, int M, int N, int K, bool accum, long gtid, long gsz) {
    const int nt = N / 8, mt = (M + 7) / 8;
    GSL(ti, (long)nt * mt) { const int m0 = (int)(ti / nt) * 8, n0 = (int)(ti % nt) * 8;
        float acc[8][8];
#pragma unroll
        for (int i = 0; i < 8; ++i)
#pragma unroll
            for (int j = 0; j < 8; ++j) acc[i][j] = 0.f;
        for (int k = 0; k < K; ++k) { float w[8];
#pragma unroll
            for (int j = 0; j < 8; ++j) w[j] = W[(long)k * N + n0 + j];
#pragma unroll
            for (int i = 0; i < 8; ++i) { const int m = m0 + i < M ? m0 + i : M - 1; const float a = A[(long)m * K + k];
#pragma unroll
                for (int j = 0; j < 8; ++j) acc[i][j] += a * w[j]; } }
#pragma unroll
        for (int i = 0; i < 8; ++i) if (m0 + i < M)
#pragma unroll
            for (int j = 0; j < 8; ++j) { float* c = C + (long)(m0 + i) * N + n0 + j; *c = accum ? *c + acc[i][j] : acc[i][j]; } }
}
__device__ void nv_ret_rope(const NvP& p, long gtid, long gsz) { constexpr int half = RET_DK / 2;
    GSL(i, (long)NT * 2 * RET_HEADS * half) { int ii = (int)(i % half); long q = i / half; int hh = (int)(q % RET_HEADS); q /= RET_HEADS; int which = (int)(q % 2); int r = (int)(q / 2);
        Tok tk = tok_of(r); float ang = (float)tk.pos * nv_ropefreq(ii, half), cs = cosf(ang), sn = sinf(ang);
        float* b = p.proj + (long)r * 6 * D_MODEL + which * D_MODEL + hh * RET_DK; float x1 = b[ii], x2 = b[ii + half]; float sc = which ? 1.f / sqrtf((float)RET_DK) : 1.f;
        b[ii] = (x1 * cs - x2 * sn) * sc; b[ii + half] = (x2 * cs + x1 * sn) * sc; } }
__device__ void nv_ret_kv(const NvP& p, long gtid, long gsz) {
    GSL(i, (long)NCH * RET_HEADS * RET_DK * RET_DV) { int e = (int)(i % RET_DV); long q = i / RET_DV; int d = (int)(q % RET_DK); q /= RET_DK; int hh = (int)(q % RET_HEADS); int c = (int)(q / RET_HEADS);
        int s, row0, L; chunk_of(c, s, row0, L); const float lg = nv_loggamma(hh); float acc = 0.f;
        for (int m = 0; m < L; ++m) { const float* pr = p.proj + (long)(row0 + m) * 6 * D_MODEL; acc += pr[D_MODEL + hh * RET_DK + d] * expf((float)(L - 1 - m) * lg) * pr[2 * D_MODEL + hh * RET_DV + e]; }
        p.SB[i] = acc; } }
__device__ void nv_ret_scan(const NvP& p, int layer, long gtid, long gsz) { constexpr long HS = (long)RET_HEADS * RET_DK * RET_DV;
    GSL(i, (long)NSEQ * HS) { int s = (int)(i / HS); long j = i % HS; int hh = (int)(j / ((long)RET_DK * RET_DV)); const float lg = nv_loggamma(hh);
        float S = s < BATCH ? 0.f : p.state_ret[((long)layer * DEC_BATCH + (s - BATCH)) * HS + j];
        int c0 = s < BATCH ? s * NCHP : BATCH * NCHP + (s - BATCH), nc = s < BATCH ? NCHP : 1, L = s < BATCH ? RET_CHUNK : DEC_SEQ; const float dec = expf((float)L * lg);
        for (int c = 0; c < nc; ++c) { float* sb = p.SB + (long)(c0 + c) * HS + j; float kvv = *sb; *sb = S; S = S * dec + kvv; }
        if (s < BATCH) p.out[O_RETP + ((long)layer * BATCH + s) * HS + j] = S; else p.out[O_RETS + ((long)layer * DEC_BATCH + (s - BATCH)) * HS + j] = S; } }
__device__ void nv_ret_scores(const NvP& p, long gtid, long gsz) {
    GSL(i, (long)NCH * RET_HEADS * RET_CHUNK * RET_CHUNK) { int m = (int)(i % RET_CHUNK); long q = i / RET_CHUNK; int l = (int)(q % RET_CHUNK); q /= RET_CHUNK; int hh = (int)(q % RET_HEADS); int c = (int)(q / RET_HEADS);
        int s, row0, L; chunk_of(c, s, row0, L); float v = 0.f;
        if (l < L && m <= l) { const float* ql = p.proj + (long)(row0 + l) * 6 * D_MODEL + hh * RET_DK; const float* km = p.proj + (long)(row0 + m) * 6 * D_MODEL + D_MODEL + hh * RET_DK;
            float acc = 0.f; for (int d = 0; d < RET_DK; ++d) acc += ql[d] * km[d]; v = acc * expf((float)(l - m) * nv_loggamma(hh)); }
        p.SC[i] = v; } }
__device__ void nv_ret_out(const NvP& p, long gtid, long gsz) {
    GSL(i, (long)NT * RET_HEADS * RET_DV) { int e = (int)(i % RET_DV); long q = i / RET_DV; int hh = (int)(q % RET_HEADS); int r = (int)(q / RET_HEADS);
        int c = chunk_of_row(r), s, row0, L; chunk_of(c, s, row0, L); int l = r - row0; const float lg = nv_loggamma(hh);
        const float* sc = p.SC + (((long)c * RET_HEADS + hh) * RET_CHUNK + l) * RET_CHUNK; float acc = 0.f;
        for (int m = 0; m <= l; ++m) acc += sc[m] * p.proj[(long)(row0 + m) * 6 * D_MODEL + 2 * D_MODEL + hh * RET_DV + e];
        const float* ql = p.proj + (long)r * 6 * D_MODEL + hh * RET_DK; const float* sb = p.SB + ((long)c * RET_HEADS + hh) * RET_DK * RET_DV + e; float a2 = 0.f;
        for (int d = 0; d < RET_DK; ++d) a2 += ql[d] * sb[(long)d * RET_DV];
        p.RO[i] = acc + a2 * expf((float)(l + 1) * lg); } }
__device__ void nv_ret_gate(const NvP& p, long gtid, long gsz) {
    GSL(i, (long)NT * RET_HEADS) { int hh = (int)(i % RET_HEADS); long r = i / RET_HEADS; const float* ro = p.RO + i * RET_DV; float ss = 0.f; for (int e = 0; e < RET_DV; ++e) ss += ro[e] * ro[e];
        const float rs = 1.f / sqrtf(ss / RET_DV + EPS); const float* g = p.proj + r * 6 * D_MODEL + 4 * D_MODEL + hh * RET_DV;
        for (int e = 0; e < RET_DV; ++e) p.G[i * RET_DV + e] = ro[e] * rs * nv_silu(g[e]); } }
__device__ void nv_conv(const NvP& p, int layer, long gtid, long gsz) {
    const float* cw = p.ffn_conv_w + (long)layer * 3 * D_FF; const float* cb = p.ffn_conv_b + (long)layer * D_FF;
    GSL(i, (long)NT * D_FF) { int f = (int)(i % D_FF); int r = (int)(i / D_FF); Tok tk = tok_of(r);
        const float* pr = p.proj + (long)r * 2 * D_FF; float u0 = pr[f];
        float um1, um2;
        const float* buf = tk.s < BATCH ? nullptr : p.state_conv + (((long)layer * DEC_BATCH + (tk.s - BATCH)) * 2) * D_FF;
        um1 = tk.t >= 1 ? pr[f - 2 * D_FF] : (buf ? buf[D_FF + f] : 0.f);
        um2 = tk.t >= 2 ? pr[f - 4 * D_FF] : (buf ? buf[(long)tk.t * D_FF + f] : 0.f);
        float c = cb[f] + cw[f] * um2 + cw[D_FF + f] * um1 + cw[2 * D_FF + f] * u0;
        p.act[i] = nv_gelu(c) * pr[D_FF + f];
        if (tk.t >= tk.T - 2) { int j = tk.t - (tk.T - 2); if (tk.s < BATCH) p.out[O_CONVP + (((long)layer * BATCH + tk.s) * 2 + j) * D_FF + f] = u0; else p.out[O_CONVS + (((long)layer * DEC_BATCH + (tk.s - BATCH)) * 2 + j) * D_FF + f] = u0; } } }
__device__ void nv_kv_post(const NvP& p, long gtid, long gsz) { constexpr int half = HEAD_DIM / 2;
    GSL(i, (long)NT * 3 * N_KV) { int kh = (int)(i % N_KV); long q = i / N_KV; int br = (int)(q % 3); int r = (int)(q / 3); Tok tk = tok_of(r);
        const float* kk = p.kv + (long)r * D_KV + (2 * br) * KVH + kh * HEAD_DIM; const float* vv = kk + KVH;
        float* dst; float* dst2 = nullptr;
        if (br == 0) dst = p.out + (r < NP ? O_CMPP + (long)r * KVROW : O_CMPS + (long)(r - NP) * KVROW);
        else if (br == 1) dst = p.out + (r < NP ? O_SELP + (long)r * KVROW : O_SELS + (long)(r - NP) * KVROW);
        else { dst = p.winbuf + (long)r * KVROW;
            if (tk.s < BATCH) { if (tk.t >= SEQ - WIN_P) dst2 = p.out + O_WINP + ((long)tk.s * WIN_P + (tk.t - (SEQ - WIN_P))) * KVROW; }
            else dst2 = p.out + O_WINS + ((long)(tk.s - BATCH) * WIN_S + (WIN_S - DEC_SEQ + tk.t)) * KVROW; }
        float rs = 1.f; if (br != 0) { float ss = 0.f; _Pragma("unroll") for (int d = 0; d < HEAD_DIM; ++d) ss += kk[d] * kk[d]; rs = 1.f / sqrtf(ss / HEAD_DIM + EPS); }
        const float* gn = p.kv_knorm + br * HEAD_DIM;
        for (int d = 0; d < half; ++d) { float k1, k2;
            if (br == 0) { k1 = kk[d]; k2 = kk[d + half]; }
            else { float x1 = kk[d] * rs * gn[d], x2 = kk[d + half] * rs * gn[d + half]; float ang = (float)tk.pos * nv_ropefreq(d, half), cs = cosf(ang), sn = sinf(ang); k1 = x1 * cs - x2 * sn; k2 = x2 * cs + x1 * sn; }
            dst[kh * HEAD_DIM + d] = k1; dst[kh * HEAD_DIM + d + half] = k2; dst[KVH + kh * HEAD_DIM + d] = vv[d]; dst[KVH + kh * HEAD_DIM + d + half] = vv[d + half];
            if (dst2) { dst2[kh * HEAD_DIM + d] = k1; dst2[kh * HEAD_DIM + d + half] = k2; dst2[KVH + kh * HEAD_DIM + d] = vv[d]; dst2[KVH + kh * HEAD_DIM + d + half] = vv[d + half]; } } } }
__device__ void nv_win_copy(const NvP& p, long gtid, long gsz) { constexpr int keep = WIN_S - DEC_SEQ;
    GSL(i, (long)DEC_BATCH * keep * KVROW) { int c = (int)(i % KVROW); long q = i / KVROW; int j = (int)(q % keep); int b = (int)(q / keep);
        p.out[O_WINS + ((long)b * WIN_S + j) * KVROW + c] = p.cache_win[((long)b * WIN_BUF + (WIN_BUF - keep + j)) * KVROW + c]; } }
__device__ void nv_cmp_posb(const NvP& p, long gtid, long gsz) { GSL(i, 2 * CMP_HID) { int hh = (int)(i % CMP_HID), c = (int)(i / CMP_HID); float acc = 0.f;
        for (int ld = 0; ld < CMP_LEN * HEAD_DIM; ++ld) acc += p.cmp_pos[(long)c * CMP_LEN * HEAD_DIM + ld] * p.cmp_w1[((long)c * CMP_LEN * HEAD_DIM + ld) * CMP_HID + hh]; p.posb[i] = acc; } }
__device__ void nv_cmp_hid(const NvP& p, long gtid, long gsz) {
    GSL(i, (long)NSEQ * NCMP * 2 * N_KV * CMP_HID) { int hh = (int)(i % CMP_HID); long q = i / CMP_HID; int kh = (int)(q % N_KV); q /= N_KV; int c = (int)(q % 2); q /= 2; int n = (int)(q % NCMP); int s = (int)(q / NCMP);
        float acc = p.posb[c * CMP_HID + hh];
        for (int l = 0; l < CMP_LEN; ++l) { const float* row = cmp_row(p, s, n * CMP_STRIDE + l) + c * KVH + kh * HEAD_DIM; const float* w = p.cmp_w1 + ((long)c * CMP_LEN * HEAD_DIM + (long)l * HEAD_DIM) * CMP_HID + hh;
            _Pragma("unroll") for (int d = 0; d < HEAD_DIM; ++d) acc += row[d] * w[(long)d * CMP_HID]; }
        p.hid[i] = nv_gelu(acc); } }
__device__ void nv_cmp_out(const NvP& p, long gtid, long gsz) {
    GSL(i, (long)NSEQ * NCMP * 2 * N_KV) { int kh = (int)(i % N_KV); long q = i / N_KV; int c = (int)(q % 2); long sn = q / 2; const float* hd = p.hid + i * CMP_HID; float o[HEAD_DIM];
        _Pragma("unroll") for (int d = 0; d < HEAD_DIM; ++d) o[d] = 0.f;
        for (int hh = 0; hh < CMP_HID; ++hh) { const float hv = hd[hh]; const float* w = p.cmp_w2 + ((long)c * CMP_HID + hh) * HEAD_DIM; _Pragma("unroll") for (int d = 0; d < HEAD_DIM; ++d) o[d] += hv * w[d]; }
        if (c == 0) { float ss = 0.f; _Pragma("unroll") for (int d = 0; d < HEAD_DIM; ++d) ss += o[d] * o[d]; const float rs = 1.f / sqrtf(ss / HEAD_DIM + EPS); _Pragma("unroll") for (int d = 0; d < HEAD_DIM; ++d) p.cmpk[(sn * N_KV + kh) * HEAD_DIM + d] = o[d] * rs * p.kv_knorm[d]; }
        else _Pragma("unroll") for (int d = 0; d < HEAD_DIM; ++d) p.cmpv[(sn * N_KV + kh) * HEAD_DIM + d] = o[d]; } }
__device__ void nv_q_post(const NvP& p, int j, long gtid, long gsz) { constexpr int half = HEAD_DIM / 2; const float* gn = p.nsa_qnorm + (long)j * HEAD_DIM;
    GSL(i, (long)NT * N_HEADS) { int hd = (int)(i % N_HEADS); int r = (int)(i / N_HEADS); Tok tk = tok_of(r); const float* qq = p.proj + (long)r * D_QG + hd * HEAD_DIM;
        float ss = 0.f; _Pragma("unroll") for (int d = 0; d < HEAD_DIM; ++d) ss += qq[d] * qq[d]; const float rs = 1.f / sqrtf(ss / HEAD_DIM + EPS);
        for (int d = 0; d < half; ++d) { float x1 = qq[d] * rs * gn[d], x2 = qq[d + half] * rs * gn[d + half]; float ang = (float)tk.pos * nv_ropefreq(d, half), cs = cosf(ang), sn = sinf(ang);
            p.qc[i * HEAD_DIM + d] = x1; p.qc[i * HEAD_DIM + d + half] = x2; p.qr[i * HEAD_DIM + d] = x1 * cs - x2 * sn; p.qr[i * HEAD_DIM + d + half] = x2 * cs + x1 * sn; }
        for (int g = 0; g < 3; ++g) p.gates[i * 3 + g] = 1.f / (1.f + expf(-p.proj[(long)r * D_QG + D_Q + hd * 3 + g])); } }
__device__ __forceinline__ int n_cmp_valid(int pos) { int n = pos - (CMP_LEN - 1); if (n < 0) return 0; n = n / CMP_STRIDE + 1; return n < NCMP ? n : NCMP; }
__device__ void nv_nsa_cmp(const NvP& p, long gtid, long gsz) { const float scale = 1.f / sqrtf((float)HEAD_DIM);
    GSL(i, (long)NT * N_HEADS) { int hd = (int)(i % N_HEADS); int r = (int)(i / N_HEADS); Tok tk = tok_of(r); const int kh = hd / GROUP, nc = n_cmp_valid(tk.pos);
        const float* q = p.qc + i * HEAD_DIM; const float* K = p.cmpk + ((long)tk.s * NCMP * N_KV + kh) * HEAD_DIM; const float* V = p.cmpv + ((long)tk.s * NCMP * N_KV + kh) * HEAD_DIM;
        float m = NEG_INF; for (int n = 0; n < nc; ++n) { float a = 0.f; _Pragma("unroll") for (int d = 0; d < HEAD_DIM; ++d) a += q[d] * K[(long)n * KVH + d]; a *= scale; m = a > m ? a : m; }
        float l = 0.f, o[HEAD_DIM]; _Pragma("unroll") for (int d = 0; d < HEAD_DIM; ++d) o[d] = 0.f;
        for (int n = 0; n < nc; ++n) { float a = 0.f; _Pragma("unroll") for (int d = 0; d < HEAD_DIM; ++d) a += q[d] * K[(long)n * KVH + d]; const float e = expf(a * scale - m); l += e; _Pragma("unroll") for (int d = 0; d < HEAD_DIM; ++d) o[d] += e * V[(long)n * KVH + d]; }
        const float inv = 1.f / (l > TINY ? l : TINY); _Pragma("unroll") for (int d = 0; d < HEAD_DIM; ++d) p.oc[i * HEAD_DIM + d] = o[d] * inv; p.mc[i] = m; p.lc[i] = l; } }
__device__ void nv_nsa_imp(const NvP& p, long gtid, long gsz) { const float scale = 1.f / sqrtf((float)HEAD_DIM);
    GSL(i, (long)NT * N_KV * NSEL_MAX) { int sb = (int)(i % NSEL_MAX); long q = i / NSEL_MAX; int kh = (int)(q % N_KV); int r = (int)(q / N_KV); Tok tk = tok_of(r); const int nc = n_cmp_valid(tk.pos);
        const int nsel = tk.s < BATCH ? NSEL_P : NSEL_S; float v;
        if (sb >= nsel) v = -3e6f;
        else { const int cur = tk.pos / SEL_BLOCK;
            if (sb == 0 || sb == cur || sb == cur - 1) v = SEL_FORCE; else if (sb * SEL_BLOCK > tk.pos) v = SEL_NEG;
            else { float acc = 0.f; const float* K = p.cmpk + ((long)tk.s * NCMP * N_KV + kh) * HEAD_DIM;
                for (int n = 4 * sb - 1; n <= 4 * sb + 3; ++n) { if (n < 0 || n >= nc) continue;
                    int lo = n * CMP_STRIDE > sb * SEL_BLOCK ? n * CMP_STRIDE : sb * SEL_BLOCK, hi = n * CMP_STRIDE + CMP_LEN < (sb + 1) * SEL_BLOCK ? n * CMP_STRIDE + CMP_LEN : (sb + 1) * SEL_BLOCK; if (hi <= lo) continue; const float w = (float)(hi - lo) / CMP_LEN;
                    for (int g = 0; g < GROUP; ++g) { const int hd = kh * GROUP + g; const float* qq = p.qc + ((long)r * N_HEADS + hd) * HEAD_DIM; float a = 0.f; _Pragma("unroll") for (int d = 0; d < HEAD_DIM; ++d) a += qq[d] * K[(long)n * KVH + d];
                        const float l = p.lc[(long)r * N_HEADS + hd]; acc += w * expf(a * scale - p.mc[(long)r * N_HEADS + hd]) / (l > TINY ? l : TINY); } }
                v = acc; } }
        p.imp[i] = v; } }
__device__ void nv_nsa_topk(const NvP& p, long gtid, long gsz) {
    GSL(i, (long)NT * N_KV) { int r = (int)(i / N_KV); Tok tk = tok_of(r); const int nsel = tk.s < BATCH ? NSEL_P : NSEL_S; const float* im = p.imp + i * NSEL_MAX; unsigned long long t0 = 0, t1 = 0, t2 = 0;
        for (int k = 0; k < SEL_TOPK; ++k) { float best = -4e6f; int bi = -1;
            for (int sb = 0; sb < nsel; ++sb) { const bool taken = sb < 64 ? (t0 >> sb) & 1 : sb < 128 ? (t1 >> (sb - 64)) & 1 : (t2 >> (sb - 128)) & 1; if (!taken && im[sb] > best) { best = im[sb]; bi = sb; } }
            if (bi >= 0) { if (bi < 64) t0 |= 1ull << bi; else if (bi < 128) t1 |= 1ull << (bi - 64); else t2 |= 1ull << (bi - 128); }
            p.topi[i * SEL_TOPK + k] = (bi >= 0 && best > 0.5f * SEL_NEG) ? bi : -1; } } }
__device__ void nv_nsa_sel(const NvP& p, long gtid, long gsz) { const float scale = 1.f / sqrtf((float)HEAD_DIM);
    GSL(i, (long)NT * N_HEADS) { int hd = (int)(i % N_HEADS); int r = (int)(i / N_HEADS); Tok tk = tok_of(r); const int kh = hd / GROUP; const float* q = p.qr + i * HEAD_DIM; const int* ti = p.topi + ((long)r * N_KV + kh) * SEL_TOPK;
        float m = NEG_INF;
        for (int k = 0; k < SEL_TOPK; ++k) { const int sb = ti[k]; if (sb < 0) continue; for (int j = 0; j < SEL_BLOCK; ++j) { const int tok = sb * SEL_BLOCK + j; if (tok > tk.pos) break; const float* kr = sel_row(p, tk.s, tok) + kh * HEAD_DIM; float a = 0.f; _Pragma("unroll") for (int d = 0; d < HEAD_DIM; ++d) a += q[d] * kr[d]; a *= scale; m = a > m ? a : m; } }
        float l = 0.f, o[HEAD_DIM]; _Pragma("unroll") for (int d = 0; d < HEAD_DIM; ++d) o[d] = 0.f;
        for (int k = 0; k < SEL_TOPK; ++k) { const int sb = ti[k]; if (sb < 0) continue; for (int j = 0; j < SEL_BLOCK; ++j) { const int tok = sb * SEL_BLOCK + j; if (tok > tk.pos) break; const float* kr = sel_row(p, tk.s, tok) + kh * HEAD_DIM; float a = 0.f; _Pragma("unroll") for (int d = 0; d < HEAD_DIM; ++d) a += q[d] * kr[d];
                const float e = expf(a * scale - m); l += e; const float* vr = kr + KVH; _Pragma("unroll") for (int d = 0; d < HEAD_DIM; ++d) o[d] += e * vr[d]; } }
        const float inv = 1.f / (l > TINY ? l : TINY); _Pragma("unroll") for (int d = 0; d < HEAD_DIM; ++d) p.os[i * HEAD_DIM + d] = o[d] * inv; } }
__device__ void nv_nsa_win(const NvP& p, long gtid, long gsz) { const float scale = 1.f / sqrtf((float)HEAD_DIM);
    GSL(i, (long)NT * N_HEADS) { int hd = (int)(i % N_HEADS); int r = (int)(i / N_HEADS); Tok tk = tok_of(r); const int kh = hd / GROUP; const float* q = p.qr + i * HEAD_DIM;
        int lo = tk.pos - WINDOW + 1; if (lo < 0) lo = 0; if (lo < tk.past - WIN_BUF) lo = tk.past - WIN_BUF;
        float m = NEG_INF; for (int tok = lo; tok <= tk.pos; ++tok) { const float* kr = win_row(p, tk.s, tok) + kh * HEAD_DIM; float a = 0.f; _Pragma("unroll") for (int d = 0; d < HEAD_DIM; ++d) a += q[d] * kr[d]; a *= scale; m = a > m ? a : m; }
        float l = 0.f, o[HEAD_DIM]; _Pragma("unroll") for (int d = 0; d < HEAD_DIM; ++d) o[d] = 0.f;
        for (int tok = lo; tok <= tk.pos; ++tok) { const float* kr = win_row(p, tk.s, tok) + kh * HEAD_DIM; float a = 0.f; _Pragma("unroll") for (int d = 0; d < HEAD_DIM; ++d) a += q[d] * kr[d]; const float e = expf(a * scale - m); l += e; const float* vr = kr + KVH; _Pragma("unroll") for (int d = 0; d < HEAD_DIM; ++d) o[d] += e * vr[d]; }
        const float inv = 1.f / (l > TINY ? l : TINY); const float* g = p.gates + i * 3;
        _Pragma("unroll") for (int d = 0; d < HEAD_DIM; ++d) p.ao[i * HEAD_DIM + d] = g[0] * p.oc[i * HEAD_DIM + d] + g[1] * p.os[i * HEAD_DIM + d] + g[2] * o[d] * inv; } }
enum NvPhase { NV_INIT, NV_ROWSTAT, NV_NORM_MIX, NV_NORM_FFN, NV_NORM_KV, NV_G_RETIN, NV_RET_ROPE, NV_RET_KV, NV_RET_SCAN, NV_RET_SCORES, NV_RET_OUT, NV_RET_GATE, NV_G_RETOUT, NV_G_FFNIN, NV_CONV, NV_G_FFNOUT,
    NV_G_KV, NV_KV_POST, NV_WIN_COPY, NV_CMP_POSB, NV_CMP_HID, NV_CMP_OUT, NV_G_QG, NV_Q_POST, NV_NSA_CMP, NV_NSA_IMP, NV_NSA_TOPK, NV_NSA_SEL, NV_NSA_WIN, NV_G_WO, NV_NPH };
__device__ void nv_dispatch(const NvP& p, int ph, int a, long gtid, long gsz) {
    switch (ph) {
    case NV_INIT: nv_init_x(p, gtid, gsz); break;
    case NV_ROWSTAT: nv_rowstat(p, gtid, gsz); break;
    case NV_NORM_MIX: nv_norm(p, p.norm_mix + (long)a * D_MODEL, gtid, gsz); break;
    case NV_NORM_FFN: nv_norm(p, p.norm_ffn + (long)a * D_MODEL, gtid, gsz); break;
    case NV_NORM_KV: nv_norm(p, p.kv_norm, gtid, gsz); break;
    case NV_G_RETIN: nv_gemm(p.h, p.ret_w_in + (long)a * D_MODEL * 6 * D_MODEL, p.proj, NT, 6 * D_MODEL, D_MODEL, false, gtid, gsz); break;
    case NV_RET_ROPE: nv_ret_rope(p, gtid, gsz); break;
    case NV_RET_KV: nv_ret_kv(p, gtid, gsz); break;
    case NV_RET_SCAN: nv_ret_scan(p, a, gtid, gsz); break;
    case NV_RET_SCORES: nv_ret_scores(p, gtid, gsz); break;
    case NV_RET_OUT: nv_ret_out(p, gtid, gsz); break;
    case NV_RET_GATE: nv_ret_gate(p, gtid, gsz); break;
    case NV_G_RETOUT: nv_gemm(p.G, p.ret_w_out + (long)a * 2 * D_MODEL * D_MODEL, p.x, NT, D_MODEL, 2 * D_MODEL, true, gtid, gsz); break;
    case NV_G_FFNIN: nv_gemm(p.h, p.ffn_w_in + (long)a * D_MODEL * 2 * D_FF, p.proj, NT, 2 * D_FF, D_MODEL, false, gtid, gsz); break;
    case NV_CONV: nv_conv(p, a, gtid, gsz); break;
    case NV_G_FFNOUT: nv_gemm(p.act, p.ffn_w_out + (long)a * D_FF * D_MODEL, p.x, NT, D_MODEL, D_FF, true, gtid, gsz); break;
    case NV_G_KV: nv_gemm(p.h, p.kv_w, p.kv, NT, D_KV, D_MODEL, false, gtid, gsz); break;
    case NV_KV_POST: nv_kv_post(p, gtid, gsz); break;
    case NV_WIN_COPY: nv_win_copy(p, gtid, gsz); break;
    case NV_CMP_POSB: nv_cmp_posb(p, gtid, gsz); break;
    case NV_CMP_HID: nv_cmp_hid(p, gtid, gsz); break;
    case NV_CMP_OUT: nv_cmp_out(p, gtid, gsz); break;
    case NV_G_QG: nv_gemm(p.h, p.nsa_w_qg + (long)a * D_MODEL * D_QG, p.proj, NT, D_QG, D_MODEL, false, gtid, gsz); break;
    case NV_Q_POST: nv_q_post(p, a, gtid, gsz); break;
    case NV_NSA_CMP: nv_nsa_cmp(p, gtid, gsz); break;
    case NV_NSA_IMP: nv_nsa_imp(p, gtid, gsz); break;
    case NV_NSA_TOPK: nv_nsa_topk(p, gtid, gsz); break;
    case NV_NSA_SEL: nv_nsa_sel(p, gtid, gsz); break;
    case NV_NSA_WIN: nv_nsa_win(p, gtid, gsz); break;
    case NV_G_WO: nv_gemm(p.ao, p.nsa_w_o + (long)a * D_Q * D_MODEL, p.x, NT, D_MODEL, D_Q, true, gtid, gsz); break;
    default: break; }
}
struct NvStep { int ph, a; };
template <class PT> __host__ __device__ inline int nv_program(PT st) { int n = 0;
#define S_(ph_, a_) do { st[n].ph = (ph_); st[n].a = (a_); ++n; } while (0)
    S_(NV_INIT, 0);
    for (int l = 0; l < DEPTH; ++l) {
        if (l == N_A) { S_(NV_ROWSTAT, 0); S_(NV_NORM_KV, 0); S_(NV_G_KV, 0); S_(NV_KV_POST, 0); S_(NV_WIN_COPY, 0); S_(NV_CMP_POSB, 0); S_(NV_CMP_HID, 0); S_(NV_CMP_OUT, 0); }
        S_(NV_ROWSTAT, 0); S_(NV_NORM_MIX, l);
        if (l < N_A) { S_(NV_G_RETIN, l); S_(NV_RET_ROPE, 0); S_(NV_RET_KV, 0); S_(NV_RET_SCAN, l); S_(NV_RET_SCORES, 0); S_(NV_RET_OUT, 0); S_(NV_RET_GATE, 0); S_(NV_G_RETOUT, l); }
        else { const int j = l - N_A; S_(NV_G_QG, j); S_(NV_Q_POST, j); S_(NV_NSA_CMP, 0); S_(NV_NSA_IMP, 0); S_(NV_NSA_TOPK, 0); S_(NV_NSA_SEL, 0); S_(NV_NSA_WIN, 0); S_(NV_G_WO, j); }
        S_(NV_ROWSTAT, 0); S_(NV_NORM_FFN, l); S_(NV_G_FFNIN, l); S_(NV_CONV, l); S_(NV_G_FFNOUT, l);
    }
#undef S_
    return n; }
static void nv_fill_params(NvP& p, void* const* d_in, float* out, float* ws) {
    p.x_prompt = (const float*)d_in[0]; p.x_sample = (const float*)d_in[1]; p.cache_cmp = (const float*)d_in[2]; p.cache_sel = (const float*)d_in[3]; p.cache_win = (const float*)d_in[4];
    p.state_ret = (const float*)d_in[5]; p.state_conv = (const float*)d_in[6]; p.page_table = (const int*)d_in[7]; p.norm_mix = (const float*)d_in[8]; p.norm_ffn = (const float*)d_in[9];
    p.ret_w_in = (const float*)d_in[10]; p.ret_w_out = (const float*)d_in[11]; p.ffn_w_in = (const float*)d_in[12]; p.ffn_conv_w = (const float*)d_in[13]; p.ffn_conv_b = (const float*)d_in[14];
    p.ffn_w_out = (const float*)d_in[15]; p.kv_norm = (const float*)d_in[16]; p.kv_w = (const float*)d_in[17]; p.kv_knorm = (const float*)d_in[18]; p.cmp_pos = (const float*)d_in[19];
    p.cmp_w1 = (const float*)d_in[20]; p.cmp_w2 = (const float*)d_in[21]; p.nsa_w_qg = (const float*)d_in[22]; p.nsa_qnorm = (const float*)d_in[23]; p.nsa_w_o = (const float*)d_in[24];
    p.out = out; p.x = out + O_YP;
    p.rstd = ws + NW_RSTD; p.h = ws + NW_H; p.proj = ws + NW_PROJ; p.SB = ws + NW_SB; p.SC = ws + NW_SC; p.RO = ws + NW_RO; p.G = ws + NW_G; p.act = ws + NW_ACT; p.kv = ws + NW_KV; p.winbuf = ws + NW_WIN;
    p.posb = ws + NW_POSB; p.hid = ws + NW_HID; p.cmpk = ws + NW_CMPK; p.cmpv = ws + NW_CMPV; p.qc = ws + NW_QC; p.qr = ws + NW_QR; p.gates = ws + NW_GATES; p.oc = ws + NW_OC; p.mc = ws + NW_MC; p.lc = ws + NW_LC;
    p.imp = ws + NW_IMP; p.os = ws + NW_OS; p.ao = ws + NW_AO; p.topi = (int*)(ws + NW_TOPI);
}
#define XB_TMO      128
#define XB_XCNT(j)  (256  + 64 * (j))
#define XB_XSUB(j)  (1280 + 64 * (j))
#define XB_XGEN(j)  (2304 + 64 * (j))
#define XB_TOP      3328
#define XB_TOPGEN   3392
#define XCD_BAR_WORDS 3456
#define XB_SPIN_CAP (1u << 18)
#define LAS __attribute__((address_space(3)))

__device__ __forceinline__ unsigned xb_ld(unsigned* p)              { return __hip_atomic_load(p, __ATOMIC_RELAXED, __HIP_MEMORY_SCOPE_AGENT); }
__device__ __forceinline__ unsigned xb_add(unsigned* p, unsigned v) { return __hip_atomic_fetch_add(p, v, __ATOMIC_RELAXED, __HIP_MEMORY_SCOPE_AGENT); }
__device__ __forceinline__ unsigned xb_xcc_id() { return (unsigned)__builtin_amdgcn_s_getreg((3 << 11) | 20) & 0xFu; }
#define XB_SPIN(cond, bar) do { unsigned _sp = 0; while (cond) { __builtin_amdgcn_s_sleep(1); \
    if ((++_sp & 255u) == 0u) { if (xb_ld(&(bar)[XB_TMO])) break; if (_sp > XB_SPIN_CAP) { atomicAdd(&(bar)[XB_TMO], 1u); break; } } } } while (0)

struct XcdBarrier {
    unsigned* bar; unsigned x;
    volatile LAS unsigned* st;
};

__device__ __forceinline__ XcdBarrier xcd_barrier_post(unsigned* bar, volatile LAS unsigned* st) {
    XcdBarrier b; b.bar = bar; b.x = xb_xcc_id(); b.st = st;
    if (threadIdx.x == 0) (void)xb_add(&bar[XB_XCNT(b.x)], 1u);
    return b;
}
__device__ __forceinline__ void xcd_barrier_complete(unsigned* bar, unsigned x, unsigned& nloc, unsigned& nx) {
    const unsigned G = gridDim.x * gridDim.y * gridDim.z;
    unsigned sum, cnt, mine, sp = 0u;
    for (;;) {
        sum = 0u; cnt = 0u; mine = 0u;
#pragma unroll
        for (unsigned j = 0; j < 16; ++j) { const unsigned c = xb_ld(&bar[XB_XCNT(j)]); sum += c; cnt += (c > 0u) ? 1u : 0u; mine = (j == x) ? c : mine; }
        if (sum == G) break;
        __builtin_amdgcn_s_sleep(1);
        if ((++sp & 255u) == 0u) { if (xb_ld(&bar[XB_TMO])) break; if (sp > XB_SPIN_CAP) { atomicAdd(&bar[XB_TMO], 1u); break; } }
    }
    nloc = mine > 0u ? mine : 1u; nx = cnt > 0u ? cnt : 1u;
}

__device__ __forceinline__ void xcd_barrier(const XcdBarrier& b) {
    asm volatile("s_waitcnt vmcnt(0)" ::: "memory");
    __syncthreads();
    if (threadIdx.x == 0) {
        unsigned* bar = b.bar;
        __builtin_amdgcn_s_waitcnt(0);
        unsigned nloc = b.st[0], nx = b.st[1];
        if (nloc == 0u) { xcd_barrier_complete(bar, b.x, nloc, nx); b.st[0] = nloc; b.st[1] = nx; }
        const unsigned old = xb_add(&bar[XB_XSUB(b.x)], 1u);
        const unsigned gen = old / nloc;
        if (old + 1u == (gen + 1u) * nloc) {
            __builtin_amdgcn_fence(__ATOMIC_RELEASE, "agent");
            asm volatile("s_waitcnt vmcnt(0)" ::: "memory");
            const unsigned og = xb_add(&bar[XB_TOP], 1u);
            const unsigned tg = og / nx;
            if (og + 1u == (tg + 1u) * nx) xb_add(&bar[XB_TOPGEN], 1u);
            else XB_SPIN(xb_ld(&bar[XB_TOPGEN]) == tg, bar);
            __builtin_amdgcn_fence(__ATOMIC_ACQUIRE, "agent");
            xb_add(&bar[XB_XGEN(b.x)], 1u);
            asm volatile("s_waitcnt vmcnt(0)" ::: "memory");
        } else {
            XB_SPIN(xb_ld(&bar[XB_XGEN(b.x)]) == gen, bar);
            __builtin_amdgcn_fence(__ATOMIC_ACQUIRE, "agent");
            asm volatile("s_waitcnt vmcnt(0)" ::: "memory");
        }
    }
    __syncthreads();
}
namespace pg8 {
#define PG8_LAS __attribute__((address_space(3)))
typedef unsigned short bf16_t;
typedef short bf16x8 __attribute__((ext_vector_type(8)));
typedef float f32x4 __attribute__((ext_vector_type(4)));
typedef float f32x2 __attribute__((ext_vector_type(2)));
typedef unsigned u32x4 __attribute__((ext_vector_type(4)));
typedef unsigned u32x2 __attribute__((ext_vector_type(2)));
constexpr int BM = 256, BK = 64, HALF = 128, HTB = HALF * BK * 2, STAGE_BYTES = 8 * HTB;
__host__ __device__ __forceinline__ int lds_byte(int r, int c) { const int st = (r >> 4) * 2 + (c >> 5), rr = r & 15, cc = c & 31, ob = rr * 64 + cc * 2; return st * 1024 + (ob ^ (((ob >> 9) & 1) << 5)); }
__host__ __device__ __forceinline__ void stage_rc(int b, int& R, int& C) { const int st = b / 1024, sb = b % 1024, swz = sb ^ (((sb >> 9) & 1) << 5); R = (st >> 1) * 16 + swz / 64; C = (st & 1) * 32 + (swz % 64) / 2; }
__host__ __device__ __forceinline__ int perm32(int rho) { const int n = rho >> 4, i = rho & 15; return 8 * (i >> 2) + 4 * n + (i & 3); }
struct Unit { int pm, pn, nt, aux; const char* A; const char* B; };
__device__ __forceinline__ unsigned cvt_pk_bf16(float lo, float hi) { unsigned r; asm volatile("v_cvt_pk_bf16_f32 %0, %1, %2" : "=v"(r) : "v"(lo), "v"(hi)); return r; }
template <class Epi, class Sched, bool ALIGN_EPI = true>
__device__ __forceinline__ void gemm_phase(PG8_LAS unsigned char* lds, const int lda, const int ldb, const Sched& S, const Epi& E) {
    int tid_ = threadIdx.x; asm volatile("" : "+v"(tid_));
    const int tid = tid_, wid = __builtin_amdgcn_readfirstlane(tid >> 6), lane = tid & 63, wr = wid >> 2, wc = wid & 3, fr = lane & 15, fq = lane >> 4;
    unsigned voffA[2], voffB[2];
#pragma unroll
    for (int i = 0; i < 2; ++i) { int R, C; stage_rc(tid * 16 + i * 8192, R, C); const int Rb = (R & ~31) + perm32(R & 31);
        voffA[i] = (unsigned)(R * lda + C) * 2u; voffB[i] = (unsigned)(Rb * ldb + C) * 2u; }
    const size_t kstep = (size_t)(BK * 2);
    const size_t hstepA = (size_t)HALF * lda * 2, hstepB = (size_t)HALF * ldb * 2;
    const unsigned ldsw = (unsigned)wid * 1024u;
    const int aoff = lds_byte(wr * 64 + fr, fq * 8), boff = lds_byte(wc * 32 + fr, fq * 8);
#define PG8_SA(b, h) (((b) * 2 + (h)) * HTB)
#define PG8_SB(b, h) ((4 + (b) * 2 + (h)) * HTB)
#define PG8_STAGE(bufoff, gbase, voff) do { _Pragma("unroll") for (int _i = 0; _i < 2; ++_i) \
        __builtin_amdgcn_global_load_lds((const unsigned*)((const char*)(gbase) + (voff)[_i]), (PG8_LAS unsigned*)(lds + (bufoff) + ldsw + _i * 8192), 16, 0, 0); } while (0)
#define PG8_LDA(dst, b, h) do { _Pragma("unroll") for (int m = 0; m < 4; ++m) _Pragma("unroll") for (int k = 0; k < 2; ++k) dst[m][k] = *(const PG8_LAS bf16x8*)(lds + PG8_SA(b, h) + aoff + m * 2048 + k * 1024); } while (0)
#define PG8_LDB(dst, b, h) do { _Pragma("unroll") for (int n = 0; n < 2; ++n) _Pragma("unroll") for (int k = 0; k < 2; ++k) dst[n][k] = *(const PG8_LAS bf16x8*)(lds + PG8_SB(b, h) + boff + n * 2048 + k * 1024); } while (0)
#define PG8_MMA(ai, bj, At, Bt) do { __builtin_amdgcn_s_setprio(1); _Pragma("unroll") for (int m = 0; m < 4; ++m) _Pragma("unroll") for (int n = 0; n < 2; ++n) _Pragma("unroll") for (int k = 0; k < 2; ++k) \
        acc[ai][bj][m][n] = __builtin_amdgcn_mfma_f32_16x16x32_bf16(Bt[n][k], At[m][k], acc[ai][bj][m][n], 0, 0, 0); __builtin_amdgcn_s_setprio(0); } while (0)
#define PG8_WAIT_V(n) asm volatile("s_waitcnt vmcnt(" #n ")" ::: "memory")
#define PG8_WAIT_L(n) asm volatile("s_waitcnt lgkmcnt(" #n ")" ::: "memory")
#define PG8_BAR __builtin_amdgcn_s_barrier()
#define PG8_SCHED __builtin_amdgcn_sched_barrier(0)
    Unit cur, nxt; int ui = 0;
    if (!S.next(0, cur)) return;
    f32x4 acc[2][2][4][2];
#pragma unroll
    for (int a = 0; a < 2; ++a)
#pragma unroll
        for (int b = 0; b < 2; ++b)
#pragma unroll
            for (int m = 0; m < 4; ++m)
#pragma unroll
                for (int n = 0; n < 2; ++n) acc[a][b][m][n] = (f32x4){0.f, 0.f, 0.f, 0.f};
    bf16x8 At[4][2], B0[2][2], B1[2][2];
    const char* cA = cur.A; const char* cB = cur.B;
    PG8_STAGE(PG8_SB(0, 0), cB, voffB); PG8_STAGE(PG8_SB(0, 1), cB + hstepB, voffB); PG8_STAGE(PG8_SA(0, 0), cA, voffA); PG8_STAGE(PG8_SA(0, 1), cA + hstepA, voffA);
    if (wr == 1) PG8_BAR;
    PG8_WAIT_V(2); PG8_BAR;
    PG8_STAGE(PG8_SB(1, 0), cB + kstep, voffB); PG8_STAGE(PG8_SA(1, 0), cA + kstep, voffA); PG8_STAGE(PG8_SB(1, 1), cB + hstepB + kstep, voffB);
    PG8_WAIT_V(6); PG8_BAR;
    for (;;) {
        const bool has_next = S.next(ui + 1, nxt);
        const char* nA = has_next ? nxt.A : cA; const char* nB = has_next ? nxt.B : cB;
        const int nt = cur.nt;
        for (int t = 0; t < nt; t += 2) {
            const bool last = (t == nt - 2);
            const char* a1 = cA + (size_t)(t + 1) * kstep;
            const char* a2 = last ? nA : cA + (size_t)(t + 2) * kstep; const char* b2 = last ? nB : cB + (size_t)(t + 2) * kstep;
            const char* a3 = a2 + kstep; const char* b3 = b2 + kstep;
            PG8_LDB(B0, 0, 0); PG8_LDB(B1, 0, 1); PG8_SCHED; PG8_LDA(At, 0, 0); PG8_STAGE(PG8_SA(1, 1), a1 + hstepA, voffA);
            PG8_WAIT_V(8); PG8_WAIT_L(0); PG8_BAR; PG8_MMA(0, 0, At, B0); PG8_MMA(0, 1, At, B1); PG8_BAR; PG8_SCHED;
            PG8_LDA(At, 0, 1); PG8_STAGE(PG8_SB(0, 0), b2, voffB); PG8_STAGE(PG8_SB(0, 1), b2 + hstepB, voffB); PG8_STAGE(PG8_SA(0, 0), a2, voffA);
            PG8_WAIT_V(8); PG8_WAIT_L(0); PG8_BAR; PG8_MMA(1, 0, At, B0); PG8_MMA(1, 1, At, B1); PG8_BAR; PG8_SCHED;
            PG8_LDB(B0, 1, 0); PG8_LDB(B1, 1, 1); PG8_SCHED; PG8_LDA(At, 1, 0); PG8_STAGE(PG8_SA(0, 1), a2 + hstepA, voffA);
            PG8_WAIT_V(8); PG8_WAIT_L(0); PG8_BAR; PG8_MMA(0, 0, At, B0); PG8_MMA(0, 1, At, B1); PG8_BAR; PG8_SCHED;
            PG8_LDA(At, 1, 1); PG8_STAGE(PG8_SB(1, 0), b3, voffB); PG8_STAGE(PG8_SB(1, 1), b3 + hstepB, voffB); PG8_STAGE(PG8_SA(1, 0), a3, voffA);
            PG8_WAIT_V(8); PG8_WAIT_L(0); PG8_BAR; PG8_MMA(1, 0, At, B0); PG8_MMA(1, 1, At, B1); PG8_BAR; PG8_SCHED;
        }
        if constexpr (ALIGN_EPI) { if (wr == 0) PG8_BAR; }
        E(acc, cur, wr, wc, fr, fq);
        if (!has_next) break;
#pragma unroll
        for (int a = 0; a < 2; ++a)
#pragma unroll
            for (int b = 0; b < 2; ++b)
#pragma unroll
                for (int m = 0; m < 4; ++m)
#pragma unroll
                    for (int n = 0; n < 2; ++n) acc[a][b][m][n] = (f32x4){0.f, 0.f, 0.f, 0.f};
        cur = nxt; cA = nA; cB = nB; ++ui;
        if constexpr (ALIGN_EPI) { if (wr == 1) PG8_BAR; }
    }
    PG8_WAIT_V(0);
    if constexpr (!ALIGN_EPI) { if (wr == 0) PG8_BAR; }
    PG8_BAR;
#undef PG8_SA
#undef PG8_SB
#undef PG8_STAGE
#undef PG8_LDA
#undef PG8_LDB
#undef PG8_MMA
#undef PG8_WAIT_V
#undef PG8_WAIT_L
#undef PG8_BAR
#undef PG8_SCHED
}
}
#define GAS __attribute__((address_space(1)))
typedef unsigned short bf16;
typedef float f32x4 __attribute__((ext_vector_type(4)));
typedef float f32x2 __attribute__((ext_vector_type(2)));
typedef unsigned u32x4 __attribute__((ext_vector_type(4)));
typedef unsigned u32x2 __attribute__((ext_vector_type(2)));
constexpr int NWAVES = 8, MK_THREADS = 512, MK_LDS = 151552;
constexpr int NPAN = NT / 256;
static_assert(NT % 256 == 0 && NP % 256 == 0 && NS == 256, "row panels");
constexpr int SCH = 512, NSCH = SEQ / SCH;
constexpr int CATK = RET_DK + SCH;
constexpr int N_KVQG = 2816, N_QG1 = 1280;
constexpr int ROPE_NPOS = PAST_LEN + DEC_SEQ;
constexpr int SELP = 8256;
constexpr int WINS = 544;
constexpr size_t MiB = 1u << 20;
constexpr size_t OW_CTL = 0, OW_CTL_BYTES = 1 * MiB;
constexpr size_t OW_WRETIN = 2 * MiB, OW_WRETOUT = 26 * MiB, OW_WFFNIN = 34 * MiB, OW_WFFNOUT = 78 * MiB, OW_WKVQG = 100 * MiB, OW_WQG1 = 106 * MiB, OW_WWO = 109 * MiB, OW_WCMP1 = 113 * MiB;
constexpr size_t OW_TABR = 114 * MiB, OW_TABN = 123 * MiB, OW_XB = 126 * MiB, OW_SSQ = 159 * MiB, OW_POSB = 161 * MiB;
constexpr size_t OW_CMPK = 162 * MiB, OW_CMPVT = 171 * MiB, OW_QC = 180 * MiB, OW_QR = 213 * MiB, OW_GATES = 246 * MiB, OW_AO = 250 * MiB;
constexpr size_t OW_SK = 283 * MiB, OW_SVT = 291 * MiB, OW_WK = 299 * MiB, OW_WVT = 307 * MiB, OW_WKS = 315 * MiB, OW_WVTS = 324 * MiB, OW_R1 = 334 * MiB;
constexpr size_t OW_QP = OW_R1, OW_KP = OW_QP + 33 * MiB, OW_ACAT = OW_KP + 33 * MiB, OW_BCAT = OW_ACAT + 96 * MiB, OW_KDT = OW_BCAT + 96 * MiB, OW_KVS = OW_KDT + 32 * MiB,
    OW_O = OW_KVS + 64 * MiB, OW_SG = OW_O + 65 * MiB, OW_G = OW_SG + 65 * MiB, OW_SQKV = OW_G + 65 * MiB, OW_RET_END = OW_SQKV + 4 * MiB;
constexpr size_t OW_U = OW_R1, OW_GT = OW_U + 90 * MiB, OW_ACT = OW_GT + 90 * MiB, OW_FFN_END = OW_ACT + 90 * MiB;
constexpr size_t OW_ASUB = OW_R1 + 270 * MiB, OW_PART = OW_ASUB + 272 * MiB, OW_CMP_END = OW_PART + 68 * MiB;
constexpr size_t OW_SPLITK = OW_R1 + 612 * MiB;
constexpr size_t OW_SKS = OW_SPLITK + 8 * MiB, OW_SVTS = OW_SKS + 130 * MiB, OW_SELS_END = OW_SVTS + 130 * MiB;
constexpr size_t OW_END = OW_SELS_END;
static_assert(OW_RET_END <= OW_END && OW_FFN_END <= OW_ASUB && OW_CMP_END <= OW_END && OW_SELS_END <= OW_END, "R1 map");
static_assert((size_t)2 * 6144 * 1024 * 2 <= OW_WRETOUT - OW_WRETIN && (size_t)4 * 5632 * 1024 * 2 <= OW_WFFNOUT - OW_WFFNIN && (size_t)4 * 1024 * 2816 * 2 <= OW_WKVQG - OW_WFFNOUT && (size_t)N_KVQG * 1024 * 2 <= OW_WQG1 - OW_WKVQG, "weight map");
static_assert((size_t)ROPE_NPOS * 128 * 8 <= OW_TABN - OW_TABR && (size_t)ROPE_NPOS * 32 * 8 <= OW_XB - OW_TABN && (size_t)NT * 1024 * 2 <= OW_SSQ - OW_XB && (size_t)NT * 16 * 4 <= OW_POSB - OW_SSQ, "map 2");
static_assert((size_t)NSEQ * 4 * 512 * 64 * 2 <= OW_CMPVT - OW_CMPK && (size_t)NT * 1024 * 2 <= OW_QR - OW_QC && (size_t)NT * 48 * 4 <= OW_AO - OW_GATES && (size_t)NT * 1024 * 2 <= OW_SK - OW_AO, "map 3");
static_assert((size_t)2 * 4 * 8192 * 64 * 2 <= OW_SVT - OW_SK && (size_t)32 * 4 * WINS * 64 * 2 <= OW_WVTS - OW_WKS && (size_t)32 * 4 * 64 * WINS * 2 <= OW_R1 - OW_WVTS, "map 4");
static_assert((size_t)NT * 1024 * 2 <= 33 * MiB && (size_t)NP * 4 * CATK * 2 <= 96 * MiB && (size_t)2 * 4 * 16 * 512 * CATK * 2 <= 96 * MiB && (size_t)NT * 2048 * 2 <= 65 * MiB && (size_t)NT * 2816 * 2 <= 90 * MiB, "map 5");
static_assert((size_t)8 * NSEQ * 512 * 1024 * 2 <= 272 * MiB && (size_t)8 * NSEQ * 512 * 256 * 2 <= 68 * MiB && (size_t)32 * 4 * SELP * 64 * 2 <= 130 * MiB, "map 6");

struct OptP {
    const float *x_prompt, *x_sample, *cache_cmp, *cache_sel, *cache_win, *state_ret, *state_conv; const int* page_table;
    const float *norm_mix, *norm_ffn, *ret_w_in, *ret_w_out, *ffn_w_in, *ffn_conv_w, *ffn_conv_b, *ffn_w_out, *kv_norm, *kv_w, *kv_knorm, *cmp_pos, *cmp_w1, *cmp_w2, *nsa_w_qg, *nsa_qnorm, *nsa_w_o;
    float* out; unsigned char* ws; const int* dbg_topi; long ph_lo, ph_hi, dup;
};
__device__ __forceinline__ int opq(int v) { asm volatile("" : "+v"(v)); return v; }
__device__ __forceinline__ int opq_s(int v) { asm volatile("" : "+s"(v)); return v; }
__device__ __forceinline__ size_t vtt_off(int tok, int d) { return (size_t)(tok >> 5) * 2048 + (size_t)d * 32 + (tok & 31); }
struct Frame { __attribute__((address_space(3))) unsigned char* lds; int tid, lane, wave, gw, ngw; };
__device__ __forceinline__ unsigned f2bf(float f) { unsigned u = __builtin_bit_cast(unsigned, f); return (u + 0x7fffu + ((u >> 16) & 1u)) >> 16; }
__device__ __forceinline__ unsigned pk2(float lo, float hi) { return f2bf(lo) | (f2bf(hi) << 16); }
__device__ __forceinline__ float bf2f(unsigned short b) { return __builtin_bit_cast(float, (unsigned)b << 16); }
__device__ __forceinline__ float bflo(unsigned w) { return __builtin_bit_cast(float, w << 16); }
__device__ __forceinline__ float bfhi(unsigned w) { return __builtin_bit_cast(float, w & 0xffff0000u); }
__device__ __forceinline__ float wave_sum(float v) {
#pragma unroll
    for (int o = 1; o < 64; o <<= 1) v += __shfl_xor(v, o);
    return v; }
__device__ __forceinline__ float gelu_tanh(float x) { const float u = x * (0.7978845608028654f + 0.035677408136300125f * x * x); const float e = __builtin_amdgcn_exp2f(u * 2.8853900817779268f); return x - x * __builtin_amdgcn_rcpf(e + 1.f); }
__device__ __forceinline__ float silu_f(float x) { return x * __builtin_amdgcn_rcpf(1.f + __builtin_amdgcn_exp2f(-1.4426950408889634f * x)); }
__device__ __forceinline__ float sigmoid_f(float x) { return 1.f / (1.f + __expf(-x)); }
__device__ __forceinline__ float log2gamma(int h) { return log2f(1.f - exp2f(-5.f - (float)h)); }
__device__ __forceinline__ float row_rstd(const float* ssq, int row) { const f32x4* p = (const f32x4*)(ssq + (size_t)row * 16); f32x4 a = p[0], b = p[1], c = p[2], d = p[3];
    const float s = ((a.x + a.y) + (a.z + a.w)) + ((b.x + b.y) + (b.z + b.w)) + ((c.x + c.y) + (c.z + c.w)) + ((d.x + d.y) + (d.z + d.w)); return 1.f / sqrtf(s * (1.f / D_MODEL) + EPS); }

__device__ __forceinline__ void wconv_item(const float* W, int N, const float* gain, bf16* dst, int ldk, int p0, int k0, int c0, int nvalid, __attribute__((address_space(3))) float* scr, int lane) {
    { const int col4 = (lane & 7) * 4; f32x4 v[8]; float gv[8];
#pragma unroll
      for (int i = 0; i < 8; ++i) { const int kk = i * 8 + (lane >> 3); v[i] = col4 < nvalid ? *(const f32x4*)(W + (size_t)(k0 + kk) * N + c0 + col4) : (f32x4){0.f, 0.f, 0.f, 0.f}; gv[i] = gain ? gain[k0 + kk] : 1.f; }
#pragma unroll
      for (int i = 0; i < 8; ++i) { const int kk = i * 8 + (lane >> 3); const f32x4 w = v[i] * gv[i]; scr[kk * 33 + col4] = w.x; scr[kk * 33 + col4 + 1] = w.y; scr[kk * 33 + col4 + 2] = w.z; scr[kk * 33 + col4 + 3] = w.w; } }
    asm volatile("s_waitcnt lgkmcnt(0)" ::: "memory");
    const int c = lane & 7;
#pragma unroll
    for (int j = 0; j < 4; ++j) { const int n = (lane >> 3) + 8 * j; const __attribute__((address_space(3))) float* s = scr + (8 * c) * 33 + n;
        u32x4 o; o.x = pk2(s[0 * 33], s[1 * 33]); o.y = pk2(s[2 * 33], s[3 * 33]); o.z = pk2(s[4 * 33], s[5 * 33]); o.w = pk2(s[6 * 33], s[7 * 33]);
        *(u32x4*)(dst + (size_t)(p0 + n) * ldk + k0 + 8 * c) = o; }
    asm volatile("s_waitcnt lgkmcnt(0)" ::: "memory");
}
struct WJob { const float* W; const float* gain; bf16* dst; int K, Ns, Nd, mode, head_rows, head_c0, tail_c0, ntail; };
__device__ __forceinline__ int wjob_items(const WJob& j) { return (j.Nd / 32) * (j.K / 64); }
__device__ __forceinline__ void wjob_run(const WJob& j, int item, __attribute__((address_space(3))) float* scr, int lane) {
    const int nkb = j.K / 64, pb = item / nkb, kb = item % nkb, p0 = pb * 32; int c0, nvalid = 32;
    if (j.mode == 0) c0 = p0;
    else if (j.mode == 2) { const int T = p0 / 256, cl = p0 % 256; c0 = cl < 128 ? 128 * T + cl : j.tail_c0 + 128 * T + (cl - 128); }
    else if (p0 < j.head_rows) { const int T = p0 / 256, cl = p0 % 256, bj = cl / 128, wc = (cl % 128) / 32; c0 = j.head_c0 + 64 * (4 * T + wc) + 32 * bj; }
    else { const int t = p0 - j.head_rows; c0 = j.tail_c0 + t; nvalid = j.ntail - t; if (nvalid > 32) nvalid = 32; if (nvalid < 0) nvalid = 0; }
    wconv_item(j.W, j.Ns, j.gain, j.dst, j.K, p0, kb * 64, c0, nvalid, scr, lane);
}
struct Ctx {
    const __attribute__((address_space(4))) OptP& p;
    __device__ __forceinline__ bf16* w_retin() const { return (bf16*)(p.ws + OW_WRETIN); }
    __device__ __forceinline__ bf16* w_retout() const { return (bf16*)(p.ws + OW_WRETOUT); }
    __device__ __forceinline__ bf16* w_ffnin() const { return (bf16*)(p.ws + OW_WFFNIN); }
    __device__ __forceinline__ bf16* w_ffnout() const { return (bf16*)(p.ws + OW_WFFNOUT); }
    __device__ __forceinline__ bf16* w_kvqg() const { return (bf16*)(p.ws + OW_WKVQG); }
    __device__ __forceinline__ bf16* w_qg1() const { return (bf16*)(p.ws + OW_WQG1); }
    __device__ __forceinline__ bf16* w_wo() const { return (bf16*)(p.ws + OW_WWO); }
    __device__ __forceinline__ bf16* w_cmp1() const { return (bf16*)(p.ws + OW_WCMP1); }
    __device__ __forceinline__ f32x2* tabr() const { return (f32x2*)(p.ws + OW_TABR); }
    __device__ __forceinline__ f32x2* tabn() const { return (f32x2*)(p.ws + OW_TABN); }
    __device__ __forceinline__ bf16* xb() const { return (bf16*)(p.ws + OW_XB); }
    __device__ __forceinline__ float* ssq() const { return (float*)(p.ws + OW_SSQ); }
    __device__ __forceinline__ float* posb() const { return (float*)(p.ws + OW_POSB); }
    __device__ __forceinline__ float* rstd() const { return (float*)(p.ws + OW_POSB + 65536); }
    __device__ __forceinline__ bf16* cmpk() const { return (bf16*)(p.ws + OW_CMPK); }
    __device__ __forceinline__ bf16* cmpvt() const { return (bf16*)(p.ws + OW_CMPVT); }
    __device__ __forceinline__ bf16* qc() const { return (bf16*)(p.ws + OW_QC); }
    __device__ __forceinline__ bf16* qr() const { return (bf16*)(p.ws + OW_QR); }
    __device__ __forceinline__ bf16* ao() const { return (bf16*)(p.ws + OW_AO); }
    __device__ __forceinline__ float* gates() const { return (float*)(p.ws + OW_GATES); }
    __device__ __forceinline__ bf16* sk() const { return (bf16*)(p.ws + OW_SK); }
    __device__ __forceinline__ bf16* svt() const { return (bf16*)(p.ws + OW_SVT); }
    __device__ __forceinline__ bf16* wk() const { return (bf16*)(p.ws + OW_WK); }
    __device__ __forceinline__ bf16* wvt() const { return (bf16*)(p.ws + OW_WVT); }
    __device__ __forceinline__ bf16* wks() const { return (bf16*)(p.ws + OW_WKS); }
    __device__ __forceinline__ bf16* wvts() const { return (bf16*)(p.ws + OW_WVTS); }
    __device__ __forceinline__ bf16* qp() const { return (bf16*)(p.ws + OW_QP); }
    __device__ __forceinline__ bf16* kp() const { return (bf16*)(p.ws + OW_KP); }
    __device__ __forceinline__ bf16* acat() const { return (bf16*)(p.ws + OW_ACAT); }
    __device__ __forceinline__ bf16* bcat() const { return (bf16*)(p.ws + OW_BCAT); }
    __device__ __forceinline__ bf16* kdt() const { return (bf16*)(p.ws + OW_KDT); }
    __device__ __forceinline__ bf16* o() const { return (bf16*)(p.ws + OW_O); }
    __device__ __forceinline__ bf16* sg() const { return (bf16*)(p.ws + OW_SG); }
    __device__ __forceinline__ bf16* g() const { return (bf16*)(p.ws + OW_G); }
    __device__ __forceinline__ float* kvs() const { return (float*)(p.ws + OW_KVS); }
    __device__ __forceinline__ float* sqkv() const { return (float*)(p.ws + OW_SQKV); }
    __device__ __forceinline__ bf16* u() const { return (bf16*)(p.ws + OW_U); }
    __device__ __forceinline__ bf16* gt() const { return (bf16*)(p.ws + OW_GT); }
    __device__ __forceinline__ bf16* act() const { return (bf16*)(p.ws + OW_ACT); }
    __device__ __forceinline__ bf16* asub() const { return (bf16*)(p.ws + OW_ASUB); }
    __device__ __forceinline__ bf16* part() const { return (bf16*)(p.ws + OW_PART); }
    __device__ __forceinline__ bf16* sks() const { return (bf16*)(p.ws + OW_SKS); }
    __device__ __forceinline__ bf16* svts() const { return (bf16*)(p.ws + OW_SVTS); }
    __device__ __forceinline__ float* x() const { return p.out + O_YP; }
};
__device__ __forceinline__ const __attribute__((address_space(4))) OptP* kargs() { unsigned long long v = (unsigned long long)__builtin_amdgcn_kernarg_segment_ptr(); asm volatile("" : "+s"(v)); return (const __attribute__((address_space(4))) OptP*)v; }
__device__ __forceinline__ int row_pos(int r) { return r < NP ? (r % SEQ) : PAST_LEN + ((r - NP) % DEC_SEQ); }

constexpr int NWJOBS = 21;
__device__ __forceinline__ void make_wjob(const Ctx& c, int j, WJob& w) {
    const auto& p = c.p; w.gain = nullptr; w.mode = 0; w.head_rows = 0; w.head_c0 = 0; w.tail_c0 = 0; w.ntail = 0;
    if (j < 2) { w.W = p.ret_w_in + (size_t)j * D_MODEL * 6 * D_MODEL; w.gain = p.norm_mix + j * D_MODEL; w.dst = c.w_retin() + (size_t)j * 6 * D_MODEL * D_MODEL; w.K = D_MODEL; w.Ns = 6 * D_MODEL; w.Nd = 6 * D_MODEL; }
    else if (j < 4) { const int l = j - 2; w.W = p.ret_w_out + (size_t)l * 2 * D_MODEL * D_MODEL; w.dst = c.w_retout() + (size_t)l * 2 * D_MODEL * D_MODEL; w.K = 2 * D_MODEL; w.Ns = D_MODEL; w.Nd = D_MODEL; }
    else if (j < 8) { const int l = j - 4; w.W = p.ffn_w_in + (size_t)l * D_MODEL * 2 * D_FF; w.gain = p.norm_ffn + l * D_MODEL; w.dst = c.w_ffnin() + (size_t)l * 2 * D_FF * D_MODEL; w.K = D_MODEL; w.Ns = 2 * D_FF; w.Nd = 2 * D_FF; w.mode = 2; w.tail_c0 = D_FF; }
    else if (j < 12) { const int l = j - 8; w.W = p.ffn_w_out + (size_t)l * D_FF * D_MODEL; w.dst = c.w_ffnout() + (size_t)l * D_FF * D_MODEL; w.K = D_FF; w.Ns = D_MODEL; w.Nd = D_MODEL; }
    else if (j == 12) { w.W = p.kv_w; w.gain = p.kv_norm; w.dst = c.w_kvqg(); w.K = D_MODEL; w.Ns = D_KV; w.Nd = D_KV; w.mode = 1; w.head_rows = D_KV; }
    else if (j < 15) { const int q = j - 13; w.W = p.nsa_w_qg + (size_t)q * D_MODEL * D_QG; w.gain = p.norm_mix + (2 + q) * D_MODEL; w.dst = q == 0 ? c.w_kvqg() + (size_t)D_KV * D_MODEL : c.w_qg1(); w.K = D_MODEL; w.Ns = D_QG; w.Nd = N_QG1;
        w.mode = 1; w.head_rows = D_Q; w.tail_c0 = D_Q; w.ntail = 3 * N_HEADS; }
    else if (j < 17) { const int q = j - 15; w.W = p.nsa_w_o + (size_t)q * D_Q * D_MODEL; w.dst = c.w_wo() + (size_t)q * D_Q * D_MODEL; w.K = D_Q; w.Ns = D_MODEL; w.Nd = D_MODEL; }
    else { const int q = j - 17, cc = q >> 1, r = q & 1; w.W = p.cmp_w1 + ((size_t)cc * 2048 + (size_t)r * 1024) * CMP_HID; w.dst = c.w_cmp1() + ((size_t)cc * 256 + r * 128) * 1024; w.K = 1024; w.Ns = CMP_HID; w.Nd = CMP_HID; }
}
__device__ __forceinline__ void p0_prologue(const Ctx& c, Frame F) { F.tid = opq((int)threadIdx.x); F.lane = F.tid & 63;
    __attribute__((address_space(3))) float* scr = (__attribute__((address_space(3))) float*)(F.lds + F.wave * 16384);
    int base = 0;
    for (int j = 0; j < NWJOBS; ++j) { WJob w; make_wjob(c, j, w); const int n = wjob_items(w);
        int it = F.gw - (base % F.ngw); if (it < 0) it += F.ngw;
        for (; it < n; it += F.ngw) wjob_run(w, it, scr, F.lane);
        base += n; }
    for (long i = (long)opq_s(F.gw) * 64 + opq(F.lane); i < (long)ROPE_NPOS * 160; i += (long)F.ngw * 64) { const int pos = (int)(i / 160), k = (int)(i % 160);
        if (k < 128) { const float inv = expf(-9.210340371976184f * (float)k / 128.f); const float ang = (float)pos * inv; c.tabr()[(size_t)pos * 128 + k] = (f32x2){cosf(ang), sinf(ang)}; }
        else { const int kk = k - 128; const float inv = expf(-9.210340371976184f * (float)kk / 32.f); const float ang = (float)pos * inv; c.tabn()[(size_t)pos * 32 + kk] = (f32x2){cosf(ang), sinf(ang)}; } }
    for (int r = opq_s(F.gw); r < NT; r += F.ngw) { const float* src = r < NP ? c.p.x_prompt + (size_t)r * D_MODEL : c.p.x_sample + (size_t)(r - NP) * D_MODEL;
        float s = 0.f;
#pragma unroll
        for (int j = 0; j < 4; ++j) { const f32x4 v = ((const f32x4*)src)[F.lane + 64 * j]; s += (v.x * v.x + v.y * v.y) + (v.z * v.z + v.w * v.w);
            u32x2 w; w.x = pk2(v.x, v.y); w.y = pk2(v.z, v.w); ((u32x2*)(c.xb() + (size_t)r * D_MODEL))[F.lane + 64 * j] = w; }
        s = wave_sum(s); if (F.lane < 16) c.ssq()[(size_t)r * 16 + F.lane] = F.lane == 0 ? s : 0.f; if (F.lane == 0) c.rstd()[r] = 1.f / sqrtf(s * (1.f / D_MODEL) + EPS); }
    for (int i = opq_s(F.gw); i < 2 * 32; i += F.ngw) { const int cc = i >> 5, j = i & 31; float a0 = 0.f, a1 = 0.f; const float* pp = c.p.cmp_pos + (size_t)cc * CMP_LEN * HEAD_DIM + j * 64; const float* w = c.p.cmp_w1 + ((size_t)cc * CMP_LEN * HEAD_DIM + j * 64) * CMP_HID + F.lane;
#pragma unroll 8
        for (int ld = 0; ld < 64; ++ld) { const float pv = pp[ld]; a0 += pv * w[(size_t)ld * CMP_HID]; a1 += pv * w[(size_t)ld * CMP_HID + 64]; }
        c.posb()[(size_t)i * CMP_HID + F.lane] = a0; c.posb()[(size_t)i * CMP_HID + 64 + F.lane] = a1; }
}

__device__ __forceinline__ int xcd_slot(int c, int G) { return (G & 7) ? c : (c & 7) * (G >> 3) + (c >> 3); }
__device__ __forceinline__ long xcd_unit(int i, int c, int G, long total) { const int q = xcd_slot(c, G), nfull = (int)(total / G);
    if ((G & 7) == 0 && i < nfull) { const int per = G >> 3, x = q / per, s = q % per; return ((long)x * nfull + i) * per + s; }
    return (long)i * G + q; }
struct SchedDense {
    const char* A; const char* B; int lda, ldb, nM, nN, nt, G, c;
    __device__ __forceinline__ bool next(int i, pg8::Unit& u) const { const long L = xcd_unit(i, c, G, (long)nM * nN); if (L >= (long)nM * nN) return false;
        const int grp = 4 * nN, gid = (int)(L / grp), fm = gid * 4, gsz = (nM - fm) < 4 ? (nM - fm) : 4, w = (int)(L % grp);
        u.pm = fm + w % gsz; u.pn = w / gsz; u.nt = nt; u.aux = 0; u.A = A + (size_t)u.pm * 256 * lda * 2; u.B = B + (size_t)u.pn * 256 * ldb * 2; return true; }
};
typedef const f32x4 (&AccRef)[2][2][4][2];
#define EPI_ROWS(ai, m) _Pragma("unroll") for (int ai = 0; ai < 2; ++ai) _Pragma("unroll") for (int m = 0; m < 4; ++m)
#ifdef EPI_NT
#define ST16(p_, v_) __builtin_nontemporal_store((v_), (u32x4*)(p_))
#else
#define ST16(p_, v_) (*(u32x4*)(p_) = (v_))
#endif
__device__ __forceinline__ u32x4 pack8(const f32x4 a, const f32x4 b) { u32x4 w; w.x = pg8::cvt_pk_bf16(a.x, a.y); w.y = pg8::cvt_pk_bf16(a.z, a.w); w.z = pg8::cvt_pk_bf16(b.x, b.y); w.w = pg8::cvt_pk_bf16(b.z, b.w); return w; }
__device__ __forceinline__ void store_t4(bf16* base, size_t pitch, const f32x4 v) { base[0] = (bf16)f2bf(v.x); base[pitch] = (bf16)f2bf(v.y); base[2 * pitch] = (bf16)f2bf(v.z); base[3 * pitch] = (bf16)f2bf(v.w); }

typedef __attribute__((address_space(3))) unsigned char lds_b;
__device__ __forceinline__ void tr_store32(lds_b* scr, const f32x4 (&v)[2][2], bf16* dst, size_t pitch, int fr, int fq) {
#pragma unroll
    for (int mh = 0; mh < 2; ++mh)
#pragma unroll
        for (int n = 0; n < 2; ++n) { lds_b* p = scr + (8 * fq + 4 * n) * 72 + (16 * mh + fr) * 2;
            *(__attribute__((address_space(3))) unsigned short*)(p) = (unsigned short)f2bf(v[mh][n].x); *(__attribute__((address_space(3))) unsigned short*)(p + 72) = (unsigned short)f2bf(v[mh][n].y);
            *(__attribute__((address_space(3))) unsigned short*)(p + 144) = (unsigned short)f2bf(v[mh][n].z); *(__attribute__((address_space(3))) unsigned short*)(p + 216) = (unsigned short)f2bf(v[mh][n].w); }
    asm volatile("s_waitcnt lgkmcnt(0)" ::: "memory");
    const int lane = fr + 16 * fq;
#pragma unroll
    for (int t = 0; t < 2; ++t) { const int q = lane + 64 * t, col = q >> 2, tc = q & 3; const lds_b* p = scr + col * 72 + tc * 16;
        const u32x2 a = *(const __attribute__((address_space(3))) u32x2*)p, b = *(const __attribute__((address_space(3))) u32x2*)(p + 8);
        *(u32x4*)(dst + (size_t)col * pitch + tc * 8) = (u32x4){a.x, a.y, b.x, b.y}; }
    asm volatile("s_waitcnt lgkmcnt(0)" ::: "memory");
}
struct EpiRetIn { const Ctx* c; lds_b* scr0; bool dry;
    __device__ __forceinline__ void operator()(AccRef acc, const pg8::Unit& u, int wr, int wc, int fr, int fq) const { asm volatile("" : "+v"(fr), "+v"(fq));
        if (dry) return;
        const Ctx& C = *c; const int pn = u.pn; f32x4 kt1[2][2], kt2[2][2], vt[2][2][2];
        EPI_ROWS(ai, m) { const int row = u.pm * 256 + ai * 128 + wr * 64 + m * 16 + fr; const float rs = C.rstd()[row]; const bool prompt = row < NP;
            const int s = prompt ? row / SEQ : 0, t = prompt ? row % SEQ : (row - NP) % DEC_SEQ, pos = prompt ? t : PAST_LEN + t, j = t / SCH, il = t % SCH, srow = row - NP;
            if (pn < 8) {
                const int head = pn & 3; const bool isk = pn >= 4; const float sc = isk ? 0.0625f : 1.f; const float l2g = log2gamma(head);
                const float dec = prompt ? (isk ? exp2f((float)(SCH - 1 - il) * l2g) : exp2f((float)(il + 1) * l2g)) : 1.f;
                f32x4 o1[2], o2[2];
#pragma unroll
                for (int n = 0; n < 2; ++n) { const int i0 = 32 * wc + 8 * fq + 4 * n; const f32x4* tp = (const f32x4*)(C.tabr() + (size_t)pos * 128 + i0); const f32x4 t01 = tp[0], t23 = tp[1];
                    const f32x4 x1 = acc[ai][0][m][n] * (rs * sc), x2 = acc[ai][1][m][n] * (rs * sc);
                    o1[n] = (f32x4){x1.x * t01.x - x2.x * t01.y, x1.y * t01.z - x2.y * t01.w, x1.z * t23.x - x2.z * t23.y, x1.w * t23.z - x2.w * t23.w};
                    o2[n] = (f32x4){x2.x * t01.x + x1.x * t01.y, x2.y * t01.z + x1.y * t01.w, x2.z * t23.x + x1.z * t23.y, x2.w * t23.z + x1.w * t23.w}; }
                const int i8 = 32 * wc + 8 * fq;
                if (prompt) {
                    if (isk) { bf16* dst = C.kp() + (size_t)row * 1024 + head * 256 + i8; *(u32x4*)dst = pack8(o1[0], o1[1]); *(u32x4*)(dst + 128) = pack8(o2[0], o2[1]); }
                    if (!isk) { bf16* d2 = C.acat() + ((size_t)row * 4 + head) * CATK + i8; *(u32x4*)d2 = pack8(o1[0] * dec, o1[1] * dec); *(u32x4*)(d2 + 128) = pack8(o2[0] * dec, o2[1] * dec); }
                    else {
#pragma unroll
                        for (int n = 0; n < 2; ++n) { kt1[m & 1][n] = o1[n] * dec; kt2[m & 1][n] = o2[n] * dec; }
                        if (m & 1) { lds_b* scr = scr0 + (wr * 4 + wc) * 2304; const int t0 = (u.pm * 256 + ai * 128 + wr * 64 + (m - 1) * 16) % SEQ;
                            bf16* d2 = C.kdt() + ((size_t)(s * 4 + head) * 256 + 32 * wc) * SEQ + t0; tr_store32(scr, kt1, d2, SEQ, fr, fq); tr_store32(scr, kt2, d2 + (size_t)128 * SEQ, SEQ, fr, fq); } }
                } else { float* d = C.sqkv() + (size_t)srow * 4096 + (isk ? 1024 : 0) + head * 256 + i8; *(f32x4*)d = o1[0]; *(f32x4*)(d + 4) = o1[1]; *(f32x4*)(d + 128) = o2[0]; *(f32x4*)(d + 132) = o2[1]; }
            } else if (pn < 16) {
                const int head = (pn - 8) >> 1, e0 = ((pn - 8) & 1) * 256;
#pragma unroll
                for (int bj = 0; bj < 2; ++bj) { const int e = e0 + 128 * bj + 32 * wc + 8 * fq; const f32x4 v0 = acc[ai][bj][m][0] * rs, v1 = acc[ai][bj][m][1] * rs;
                    if (prompt) { vt[bj][m & 1][0] = v0; vt[bj][m & 1][1] = v1; }
                    else { float* d = C.sqkv() + (size_t)srow * 4096 + 2048 + head * 512 + e; *(f32x4*)d = v0; *(f32x4*)(d + 4) = v1; } }
                if (prompt && (m & 1)) { lds_b* scr = scr0 + (wr * 4 + wc) * 2304; const int t0 = (u.pm * 256 + ai * 128 + wr * 64 + (m - 1) * 16) % SEQ, j0 = t0 / SCH, il0 = t0 % SCH;
#pragma unroll
                    for (int bj = 0; bj < 2; ++bj) tr_store32(scr, vt[bj], C.bcat() + ((size_t)((s * 4 + head) * NSCH + j0) * 512 + e0 + 128 * bj + 32 * wc) * CATK + RET_DK + il0, CATK, fr, fq); }
            } else {
#pragma unroll
                for (int bj = 0; bj < 2; ++bj) { f32x4 v0 = acc[ai][bj][m][0] * rs, v1 = acc[ai][bj][m][1] * rs;
                    v0 = (f32x4){silu_f(v0.x), silu_f(v0.y), silu_f(v0.z), silu_f(v0.w)}; v1 = (f32x4){silu_f(v1.x), silu_f(v1.y), silu_f(v1.z), silu_f(v1.w)};
                    ST16(C.sg() + (size_t)row * 2048 + (pn - 16) * 256 + 128 * bj + 32 * wc + 8 * fq, pack8(v0, v1)); }
            } }
    }
};
struct EpiRes { const Ctx* c; bool dry, last;
    __device__ __forceinline__ void operator()(AccRef acc, const pg8::Unit& u, int wr, int wc, int fr, int fq) const { asm volatile("" : "+v"(fr), "+v"(fq));
        const Ctx& C = *c;
        if (u.aux >= 16) {
            if (!dry) { float* P = (float*)(C.p.ws + OW_SPLITK) + (size_t)(u.aux - 16) * 256 * D_MODEL;
                EPI_ROWS(ai, m) { const int rl = ai * 128 + wr * 64 + m * 16 + fr;
#pragma unroll
                    for (int bj = 0; bj < 2; ++bj) { float* d = P + (size_t)rl * D_MODEL + u.pn * 256 + 128 * bj + 32 * wc + 8 * fq; *(f32x4*)d = acc[ai][bj][m][0]; *(f32x4*)(d + 4) = acc[ai][bj][m][1]; } } }
            return; }
        EPI_ROWS(ai, m) { const int row = u.pm * 256 + ai * 128 + wr * 64 + m * 16 + fr; float ss = 0.f;
#pragma unroll
            for (int bj = 0; bj < 2; ++bj) { const size_t off = (size_t)row * D_MODEL + u.pn * 256 + 128 * bj + 32 * wc + 8 * fq; const u32x4 xo = *(const u32x4*)(C.xb() + off);
                const f32x4 a = (f32x4){bflo(xo.x), bfhi(xo.x), bflo(xo.y), bfhi(xo.y)} + acc[ai][bj][m][0], b = (f32x4){bflo(xo.z), bfhi(xo.z), bflo(xo.w), bfhi(xo.w)} + acc[ai][bj][m][1];
                if (!dry) { *(u32x4*)(C.xb() + off) = pack8(a, b); if (last) { f32x4* xp = (f32x4*)(C.x() + off); xp[0] = a; xp[1] = b; } }
                ss += ((a.x * a.x + a.y * a.y) + (a.z * a.z + a.w * a.w)) + ((b.x * b.x + b.y * b.y) + (b.z * b.z + b.w * b.w)); }
            ss += __shfl_xor(ss, 16); ss += __shfl_xor(ss, 32);
            if (fq == 0 && !dry) C.ssq()[(size_t)row * 16 + u.pn * 4 + wc] = ss; }
    }
};
#ifndef ROR_CTRL1
#define ROR_CTRL1 0x121
#define ROR_CTRL2 0x122
#endif
#ifdef ROR_BPERMUTE
__device__ __forceinline__ f32x4 dpp_ror1(const f32x4 v) { const int src = (__lane_id() & ~15) | ((__lane_id() - 1) & 15); return (f32x4){__shfl(v.x, src), __shfl(v.y, src), __shfl(v.z, src), __shfl(v.w, src)}; }
__device__ __forceinline__ f32x4 dpp_ror2(const f32x4 v) { const int src = (__lane_id() & ~15) | ((__lane_id() - 2) & 15); return (f32x4){__shfl(v.x, src), __shfl(v.y, src), __shfl(v.z, src), __shfl(v.w, src)}; }
#else
__device__ __forceinline__ f32x4 dpp_ror1(const f32x4 v) { f32x4 r; r.x = __builtin_bit_cast(float, __builtin_amdgcn_update_dpp(0, __builtin_bit_cast(int, v.x), ROR_CTRL1, 0xF, 0xF, false)); r.y = __builtin_bit_cast(float, __builtin_amdgcn_update_dpp(0, __builtin_bit_cast(int, v.y), ROR_CTRL1, 0xF, 0xF, false));
    r.z = __builtin_bit_cast(float, __builtin_amdgcn_update_dpp(0, __builtin_bit_cast(int, v.z), ROR_CTRL1, 0xF, 0xF, false)); r.w = __builtin_bit_cast(float, __builtin_amdgcn_update_dpp(0, __builtin_bit_cast(int, v.w), ROR_CTRL1, 0xF, 0xF, false)); return r; }
__device__ __forceinline__ f32x4 dpp_ror2(const f32x4 v) { f32x4 r; r.x = __builtin_bit_cast(float, __builtin_amdgcn_update_dpp(0, __builtin_bit_cast(int, v.x), ROR_CTRL2, 0xF, 0xF, false)); r.y = __builtin_bit_cast(float, __builtin_amdgcn_update_dpp(0, __builtin_bit_cast(int, v.y), ROR_CTRL2, 0xF, 0xF, false));
    r.z = __builtin_bit_cast(float, __builtin_amdgcn_update_dpp(0, __builtin_bit_cast(int, v.z), ROR_CTRL2, 0xF, 0xF, false)); r.w = __builtin_bit_cast(float, __builtin_amdgcn_update_dpp(0, __builtin_bit_cast(int, v.w), ROR_CTRL2, 0xF, 0xF, false)); return r; }
#endif
__device__ __forceinline__ f32x4 gelu4(const f32x4 v) { return (f32x4){gelu_tanh(v.x), gelu_tanh(v.y), gelu_tanh(v.z), gelu_tanh(v.w)}; }
struct EpiFfnIn { const Ctx* c; int layer; lds_b* scr0;
    __device__ __forceinline__ void operator()(AccRef acc, const pg8::Unit& u, int wr, int wc, int fr, int fq) const { asm volatile("" : "+v"(fr), "+v"(fq));
        const Ctx& C = *c; const bool sample = u.aux == 1; const int rbase = sample ? NP : 254 * u.pm - 2, fb = 128 * u.pn + 32 * wc + 8 * fq;
        __attribute__((address_space(3))) float* halo = (__attribute__((address_space(3))) float*)scr0;
        if (!sample && fr >= 14) {
#pragma unroll
            for (int ai = 0; ai < 2; ++ai) { const int rg = rbase + ai * 128 + wr * 64 + 48 + fr; const float rs = (rg >= 0) ? C.rstd()[rg] : 0.f;
#pragma unroll
                for (int n = 0; n < 2; ++n) *(__attribute__((address_space(3))) f32x4*)(halo + ((ai * 2 + wr) * 2 + (fr - 14)) * 128 + 32 * wc + 8 * fq + 4 * n) = acc[ai][0][3][n] * rs; } }
        asm volatile("s_waitcnt lgkmcnt(0)" ::: "memory"); __builtin_amdgcn_s_barrier();
        f32x4 w0[2], w1[2], w2[2], cb[2];
        { const float* cw = C.p.ffn_conv_w + (size_t)layer * 3 * D_FF + fb; const float* cbp = C.p.ffn_conv_b + (size_t)layer * D_FF + fb;
#pragma unroll
          for (int n = 0; n < 2; ++n) { w0[n] = *(const f32x4*)(cw + 4 * n); w1[n] = *(const f32x4*)(cw + D_FF + 4 * n); w2[n] = *(const f32x4*)(cw + 2 * D_FF + 4 * n); cb[n] = *(const f32x4*)(cbp + 4 * n); } }
#pragma unroll
        for (int ai = 0; ai < 2; ++ai) {
            f32x4 pr1[2], pr2[2];
            { const int ps = ai * 2 + wr - 1;
#pragma unroll
              for (int n = 0; n < 2; ++n) { const __attribute__((address_space(3))) float* hp = halo + (ps * 2) * 128 + 32 * wc + 8 * fq + 4 * n; const bool use = !sample && ps >= 0 && fr < 2;
                  const f32x4 h63 = use ? *(const __attribute__((address_space(3))) f32x4*)(hp + 128) : (f32x4){0.f, 0.f, 0.f, 0.f}, h62 = (use && fr == 0) ? *(const __attribute__((address_space(3))) f32x4*)hp : (f32x4){0.f, 0.f, 0.f, 0.f};
                  pr1[n] = h63; pr2[n] = fr == 0 ? h62 : h63; } }
#pragma unroll
            for (int m = 0; m < 4; ++m) { const int rl = ai * 128 + wr * 64 + m * 16 + fr, rg = rbase + rl; const bool inb = rg >= 0 && rg < NT; const float rs = inb ? C.rstd()[rg] : 0.f;
                const bool prompt = !sample; const int t = prompt ? (rg >= 0 ? rg % SEQ : 0) : (rg - NP) % DEC_SEQ, T = prompt ? SEQ : DEC_SEQ;
                const bool outrow = sample ? true : (rl >= 2 && rg < NP);
                const float* buf = sample ? C.p.state_conv + ((size_t)(layer * DEC_BATCH + (rg - NP) / DEC_SEQ) * 2) * D_FF + fb : nullptr;
                u32x4 wq = {0u, 0u, 0u, 0u};
#pragma unroll
                for (int n = 0; n < 2; ++n) { const f32x4 cur = acc[ai][0][m][n] * rs, gt = acc[ai][1][m][n] * rs;
                    const f32x4 c1r = dpp_ror1(cur), c2r = dpp_ror2(cur);
                    f32x4 um1 = fr >= 1 ? c1r : pr1[n], um2 = fr >= 2 ? c2r : pr2[n];
                    if (sample) { if (t == 0) { um1 = *(const f32x4*)(buf + D_FF + 4 * n); um2 = *(const f32x4*)(buf + 4 * n); } else if (t == 1) um2 = *(const f32x4*)(buf + D_FF + 4 * n); }
                    else { if (t == 0) { um1 = (f32x4){0.f, 0.f, 0.f, 0.f}; um2 = um1; } else if (t == 1) um2 = (f32x4){0.f, 0.f, 0.f, 0.f}; }
                    const f32x4 cc = cb[n] + w0[n] * um2 + w1[n] * um1 + w2[n] * cur; const f32x4 av = gelu4(cc) * gt;
                    pr1[n] = c1r; pr2[n] = c2r;
                    if (outrow) { if (n == 0) { wq.x = pg8::cvt_pk_bf16(av.x, av.y); wq.y = pg8::cvt_pk_bf16(av.z, av.w); } else { wq.z = pg8::cvt_pk_bf16(av.x, av.y); wq.w = pg8::cvt_pk_bf16(av.z, av.w); *(u32x4*)(C.act() + (size_t)rg * D_FF + fb) = wq; }
                        if (t >= T - 2) { const int jr = t - (T - 2);
                            float* d = C.p.out + (prompt ? O_CONVP + ((size_t)(layer * BATCH + rg / SEQ) * 2 + jr) * D_FF : O_CONVS + ((size_t)(layer * DEC_BATCH + (rg - NP) / DEC_SEQ) * 2 + jr) * D_FF) + fb + 4 * n;
                            *(f32x4*)d = cur; } } } } }
    }
};
struct SchedFfnIn {
    const char* A; const char* B; int G, c;
    __device__ __forceinline__ bool next(int i, pg8::Unit& u) const { constexpr int nM = 66, nN = 22; const long L = xcd_unit(i, c, G, (long)nM * nN); if (L >= (long)nM * nN) return false;
        const int grp = 4 * nN, gid = (int)(L / grp), fm = gid * 4, gsz = (nM - fm) < 4 ? (nM - fm) : 4, w = (int)(L % grp);
        u.pm = fm + w % gsz; u.pn = w / gsz; u.nt = 16; u.aux = u.pm == 65 ? 1 : 0;
        const long row0 = u.pm == 65 ? (long)NP : 254L * u.pm - 2; u.A = A + row0 * D_MODEL * 2; u.B = B + (size_t)u.pn * 256 * D_MODEL * 2; return true; }
};
constexpr float QSC = 0.125f * 1.4426950408889634f;
struct EpiKvqg { const Ctx* c; int tile0, jq;
    __device__ __forceinline__ void operator()(AccRef acc, const pg8::Unit& u, int wr, int wc, int fr, int fq) const { asm volatile("" : "+v"(fr), "+v"(fq));
        const Ctx& C = *c; const int T = u.pn + tile0;
        EPI_ROWS(ai, m) { const int row = u.pm * 256 + ai * 128 + wr * 64 + m * 16 + fr; const float rs0 = C.rstd()[row]; const bool prompt = row < NP;
            const int s = prompt ? row / SEQ : 0, t = prompt ? row % SEQ : (row - NP) % DEC_SEQ, pos = prompt ? t : PAST_LEN + t, b = prompt ? 0 : (row - NP) / DEC_SEQ, srow = row - NP;
            f32x4 x[2][2];
#pragma unroll
            for (int bj = 0; bj < 2; ++bj)
#pragma unroll
                for (int n = 0; n < 2; ++n) x[bj][n] = acc[ai][bj][m][n] * rs0;
            if (T == 10) {
                if (wc < 2) {
#pragma unroll
                    for (int n = 0; n < 2; ++n) { const int col = 32 * wc + 8 * fq + 4 * n; if (col < 3 * N_HEADS) { const f32x4 v = x[0][n]; *(f32x4*)(C.gates() + (size_t)row * 48 + col) = (f32x4){sigmoid_f(v.x), sigmoid_f(v.y), sigmoid_f(v.z), sigmoid_f(v.w)}; } } }
                continue; }
            const bool normed = (T == 2 || T == 4 || T >= 6);
            f32x4 y[2][2];
            if (normed) {
                float ss = 0.f;
#pragma unroll
                for (int bj = 0; bj < 2; ++bj)
#pragma unroll
                    for (int n = 0; n < 2; ++n) { const f32x4 v = x[bj][n]; ss += (v.x * v.x + v.y * v.y) + (v.z * v.z + v.w * v.w); }
                ss += __shfl_xor(ss, 16); ss += __shfl_xor(ss, 32);
                const float rs = 1.f / sqrtf(ss * (1.f / HEAD_DIM) + EPS);
                const float* gn = T == 2 ? C.p.kv_knorm + HEAD_DIM : T == 4 ? C.p.kv_knorm + 2 * HEAD_DIM : C.p.nsa_qnorm + jq * HEAD_DIM;
#pragma unroll
                for (int bj = 0; bj < 2; ++bj)
#pragma unroll
                    for (int n = 0; n < 2; ++n) { const f32x4 g = *(const f32x4*)(gn + 32 * bj + 8 * fq + 4 * n); x[bj][n] = x[bj][n] * rs * g; }
#pragma unroll
                for (int n = 0; n < 2; ++n) { const f32x4* tp = (const f32x4*)(C.tabn() + (size_t)pos * 32 + 8 * fq + 4 * n); const f32x4 t01 = tp[0], t23 = tp[1]; const f32x4 x1 = x[0][n], x2 = x[1][n];
                    y[0][n] = (f32x4){x1.x * t01.x - x2.x * t01.y, x1.y * t01.z - x2.y * t01.w, x1.z * t23.x - x2.z * t23.y, x1.w * t23.z - x2.w * t23.w};
                    y[1][n] = (f32x4){x2.x * t01.x + x1.x * t01.y, x2.y * t01.z + x1.y * t01.w, x2.z * t23.x + x1.z * t23.y, x2.w * t23.z + x1.w * t23.w}; }
            }
            if (T >= 6) {
                const int head = 4 * (T - 6) + wc;
#pragma unroll
                for (int bj = 0; bj < 2; ++bj) { const size_t off = ((size_t)row * N_HEADS + head) * HEAD_DIM + 32 * bj + 8 * fq; *(u32x4*)(C.qc() + off) = pack8(x[bj][0] * QSC, x[bj][1] * QSC); *(u32x4*)(C.qr() + off) = pack8(y[bj][0] * QSC, y[bj][1] * QSC); }
                continue; }
            const int kvh = wc, br = T >> 1, cc = T & 1;
            float* od = nullptr;
            if (br == 0) od = C.p.out + (prompt ? O_CMPP + (size_t)row * KVROW : O_CMPS + (size_t)srow * KVROW);
            else if (br == 1) od = C.p.out + (prompt ? O_SELP + (size_t)row * KVROW : O_SELS + (size_t)srow * KVROW);
            else { if (prompt) { if (t >= SEQ - WIN_P) od = C.p.out + O_WINP + ((size_t)s * WIN_P + (t - (SEQ - WIN_P))) * KVROW; } else od = C.p.out + O_WINS + ((size_t)b * WIN_S + (WIN_S - DEC_SEQ + t)) * KVROW; }
#pragma unroll
            for (int bj = 0; bj < 2; ++bj)
#pragma unroll
                for (int n = 0; n < 2; ++n) { const f32x4 v = (normed ? y[bj][n] : x[bj][n]); const int d = 32 * bj + 8 * fq + 4 * n;
                    if (od) *(f32x4*)(od + cc * KVH + kvh * HEAD_DIM + d) = v;
                    u32x2 w; w.x = pg8::cvt_pk_bf16(v.x, v.y); w.y = pg8::cvt_pk_bf16(v.z, v.w);
                    if (br == 0) { if (prompt) *(u32x2*)(C.asub() + ((size_t)((cc * N_KV + kvh) * NSEQ + s) * 512 + t / 16) * 1024 + (t % 16) * 64 + d) = w; }
                    else if (cc == 0) {
                        bf16* kd = br == 1 ? (prompt ? C.sk() + ((size_t)(s * N_KV + kvh) * SEQ + t) * 64 : C.sks() + ((size_t)(b * N_KV + kvh) * SELP + PAST_LEN + t) * 64)
                                           : (prompt ? C.wk() + ((size_t)(s * N_KV + kvh) * SEQ + t) * 64 : C.wks() + ((size_t)(b * N_KV + kvh) * WINS + WIN_BUF + t) * 64);
                        *(u32x2*)(kd + d) = w; }
                    else {
                        if (br == 1) { if (prompt) store_t4(C.svt() + (size_t)(s * N_KV + kvh) * 64 * SEQ + vtt_off(t, d), 32, v); else store_t4(C.svts() + (size_t)(b * N_KV + kvh) * 64 * SELP + vtt_off(PAST_LEN + t, d), 32, v); }
                        else { if (prompt) store_t4(C.wvt() + (size_t)(s * N_KV + kvh) * 64 * SEQ + vtt_off(t, d), 32, v); else store_t4(C.wvts() + (size_t)(b * N_KV + kvh) * 64 * WINS + vtt_off(WIN_BUF + t, d), 32, v); } } } }
    }
};
struct EpiP { const Ctx* c;
    __device__ __forceinline__ void operator()(AccRef acc, const pg8::Unit& u, int wr, int wc, int fr, int fq) const { asm volatile("" : "+v"(fr), "+v"(fq));
        const Ctx& C = *c; const int head = u.aux & 3, sj = u.aux >> 2;
        const float l2g = log2gamma(head);
        EPI_ROWS(ai, m) { const int iq = u.pm * 256 + ai * 128 + wr * 64 + m * 16 + fr; const size_t row = (size_t)sj * SCH + iq;
#pragma unroll
            for (int bj = 0; bj < 2; ++bj) { const int ik = u.pn * 256 + 128 * bj + 32 * wc + 8 * fq; f32x4 v0 = acc[ai][bj][m][0], v1 = acc[ai][bj][m][1]; const float dk = -(float)(ik + 1) * l2g;
                v0 = (f32x4){ik <= iq ? v0.x * exp2f(dk) : 0.f, ik + 1 <= iq ? v0.y * exp2f(dk - l2g) : 0.f, ik + 2 <= iq ? v0.z * exp2f(dk - 2.f * l2g) : 0.f, ik + 3 <= iq ? v0.w * exp2f(dk - 3.f * l2g) : 0.f};
                v1 = (f32x4){ik + 4 <= iq ? v1.x * exp2f(dk - 4.f * l2g) : 0.f, ik + 5 <= iq ? v1.y * exp2f(dk - 5.f * l2g) : 0.f, ik + 6 <= iq ? v1.z * exp2f(dk - 6.f * l2g) : 0.f, ik + 7 <= iq ? v1.w * exp2f(dk - 7.f * l2g) : 0.f};
                *(u32x4*)(C.acat() + (row * 4 + head) * CATK + RET_DK + ik) = pack8(v0, v1); } }
    }
};
struct EpiKV { const Ctx* c;
    __device__ __forceinline__ void operator()(AccRef acc, const pg8::Unit& u, int wr, int wc, int fr, int fq) const { asm volatile("" : "+v"(fr), "+v"(fq));
        const Ctx& C = *c;
        EPI_ROWS(ai, m) { const int e = u.pm * 256 + ai * 128 + wr * 64 + m * 16 + fr;
#pragma unroll
            for (int bj = 0; bj < 2; ++bj) *(u32x4*)((bf16*)C.kvs() + ((size_t)u.aux * 512 + e) * 256 + 128 * bj + 32 * wc + 8 * fq) = pack8(acc[ai][bj][m][0], acc[ai][bj][m][1]); }
    }
};
struct EpiOut { const Ctx* c;
    __device__ __forceinline__ void operator()(AccRef acc, const pg8::Unit& u, int wr, int wc, int fr, int fq) const { asm volatile("" : "+v"(fr), "+v"(fq));
        const Ctx& C = *c; const int head = u.aux & 3, sj = u.aux >> 2;
        EPI_ROWS(ai, m) { const size_t row = (size_t)sj * SCH + u.pm * 256 + ai * 128 + wr * 64 + m * 16 + fr;
#pragma unroll
            for (int bj = 0; bj < 2; ++bj) ST16(C.o() + row * 2048 + head * 512 + u.pn * 256 + 128 * bj + 32 * wc + 8 * fq, pack8(acc[ai][bj][m][0], acc[ai][bj][m][1])); }
    }
};
struct EpiCmp1 { const Ctx* c;
    __device__ __forceinline__ void operator()(AccRef acc, const pg8::Unit& u, int wr, int wc, int fr, int fq) const { asm volatile("" : "+v"(fr), "+v"(fq));
        const Ctx& C = *c;
        EPI_ROWS(ai, m) { const size_t row = (size_t)u.pm * 256 + ai * 128 + wr * 64 + m * 16 + fr;
#pragma unroll
            for (int bj = 0; bj < 2; ++bj) ST16(C.part() + row * 256 + 128 * bj + 32 * wc + 8 * fq, pack8(acc[ai][bj][m][0], acc[ai][bj][m][1])); }
    }
};
struct SchedPKV {
    const Ctx* c; int G, cu, which;
    __device__ __forceinline__ bool next(int i, pg8::Unit& u) const { const Ctx& C = *c; const long L = (long)i * G + xcd_slot(cu, G);
        if (which == 0) { if (L >= (long)BATCH * 4 * NSCH * 3) return false; const int k = (int)(L % 3), shj = (int)(L / 3), head = shj % 4, sj = shj / 4;
            u.pm = k == 0 ? 0 : 1; u.pn = k == 2 ? 1 : 0; u.nt = 4; u.aux = sj * 4 + head;
            u.A = (const char*)(C.acat() + (((size_t)sj * SCH + u.pm * 256) * 4 + head) * CATK); u.B = (const char*)(C.kp() + ((size_t)sj * SCH + u.pn * 256) * 1024 + head * 256); return true; }
        else { if (L >= (long)BATCH * 4 * NSCH * 2) return false; const int eh = (int)(L % 2), q = (int)(L / 2), j = q % NSCH, sh = q / NSCH;
            u.pm = eh; u.pn = 0; u.nt = 8; u.aux = sh * NSCH + j;
            u.A = (const char*)(C.bcat() + ((size_t)(sh * NSCH + j) * 512 + eh * 256) * CATK + RET_DK); u.B = (const char*)(C.kdt() + (size_t)sh * 256 * SEQ + j * SCH); return true; } }
};
struct SchedOut { const Ctx* c; int G, cu;
    __device__ __forceinline__ bool next(int i, pg8::Unit& u) const { const Ctx& C = *c; const long pr = (long)(i >> 1) * G + xcd_slot(cu, G); if (pr >= (long)BATCH * 4 * NSCH * 2) return false;
        const int shj = (int)(pr >> 1), head = shj % 4, sj = shj / 4, s = sj / NSCH, j = sj % NSCH;
        u.pm = (int)(pr & 1); u.pn = i & 1; u.nt = u.pm == 0 ? 8 : 12; u.aux = sj * 4 + head;
        u.A = (const char*)(C.acat() + (((size_t)sj * SCH + u.pm * 256) * 4 + head) * CATK); u.B = (const char*)(C.bcat() + ((size_t)((s * 4 + head) * NSCH + j) * 512 + u.pn * 256) * CATK); return true; }
};
typedef __attribute__((address_space(3))) float lds_f32;
__device__ __forceinline__ void bf8_to_f32(const u32x4 w, float (&v)[8]) { v[0] = bflo(w.x); v[1] = bfhi(w.x); v[2] = bflo(w.y); v[3] = bfhi(w.y); v[4] = bflo(w.z); v[5] = bfhi(w.z); v[6] = bflo(w.w); v[7] = bfhi(w.w); }
__device__ __forceinline__ void ph_ret_scan(const Ctx& c, Frame F, int layer) { F.tid = opq((int)threadIdx.x); F.lane = F.tid & 63;
    for (long idx = (long)opq_s(blockIdx.x) * MK_THREADS + opq(F.tid); idx < (long)BATCH * 4 * 512 * 32; idx += (long)gridDim.x * MK_THREADS) {
        const int dch = (int)(idx % 32), e = (int)((idx / 32) % 512), sh = (int)(idx / (32 * 512)), head = sh % 4, s = sh / 4; const float dec = exp2f((float)SCH * log2gamma(head));
        float S[8];
#pragma unroll
        for (int k = 0; k < 8; ++k) S[k] = 0.f;
        for (int j = 0; j < NSCH; ++j) { const size_t rowi = (size_t)(sh * NSCH + j) * 512 + e;
            u32x4 w; w.x = pk2(S[0], S[1]); w.y = pk2(S[2], S[3]); w.z = pk2(S[4], S[5]); w.w = pk2(S[6], S[7]); *(u32x4*)(c.bcat() + rowi * CATK + dch * 8) = w;
            const u32x4 kw = *(const u32x4*)((const bf16*)c.kvs() + rowi * 256 + dch * 8); const f32x4 a = (f32x4){bflo(kw.x), bfhi(kw.x), bflo(kw.y), bfhi(kw.y)}, b = (f32x4){bflo(kw.z), bfhi(kw.z), bflo(kw.w), bfhi(kw.w)};
            S[0] = S[0] * dec + a.x; S[1] = S[1] * dec + a.y; S[2] = S[2] * dec + a.z; S[3] = S[3] * dec + a.w; S[4] = S[4] * dec + b.x; S[5] = S[5] * dec + b.y; S[6] = S[6] * dec + b.z; S[7] = S[7] * dec + b.w; }
        float* o = c.p.out + O_RETP + ((size_t)(layer * BATCH + s) * RET_HEADS + head) * RET_DK * RET_DV + (size_t)(dch * 8) * RET_DV + e;
#pragma unroll
        for (int k = 0; k < 8; ++k) o[(size_t)k * RET_DV] = S[k]; }
}
__device__ __forceinline__ void ph_ret_sample(const Ctx& c, Frame F, int layer) { F.tid = opq((int)threadIdx.x); F.lane = F.tid & 63;
    lds_f32* qd = (lds_f32*)(F.lds); lds_f32* kd = qd + 8 * 256; lds_f32* vv = kd + 8 * 256; lds_f32* sc = vv + 8 * 256; lds_f32* part = sc + 64;
    for (int item = blockIdx.x; item < DEC_BATCH * 4 * 2; item += gridDim.x) { const int eh = item & 1, head = (item >> 1) & 3, b = item >> 3; const float l2g = log2gamma(head);
        __syncthreads();
        for (int i = F.tid; i < 8 * 256; i += MK_THREADS) { const int t = i >> 8, d = i & 255; const float* r = c.sqkv() + (size_t)(b * 8 + t) * 4096;
            qd[i] = r[head * 256 + d]; kd[i] = r[1024 + head * 256 + d]; vv[i] = r[2048 + head * 512 + eh * 256 + d]; }
        __syncthreads();
        if (F.tid < 64) { const int t = F.tid >> 3, m = F.tid & 7; float a = 0.f; if (m <= t) { for (int d = 0; d < 256; ++d) a += qd[t * 256 + d] * kd[m * 256 + d]; a *= exp2f((float)(t - m) * l2g); } sc[F.tid] = a; }
        __syncthreads();
        const int el = F.tid & 255, dh = F.tid >> 8, e = eh * 256 + el; const size_t sbase = ((size_t)(layer * DEC_BATCH + b) * RET_HEADS + head) * RET_DK * RET_DV;
        float o[8], vloc[8], qdec[8], kdec[8];
#pragma unroll
        for (int t = 0; t < 8; ++t) { o[t] = 0.f; vloc[t] = vv[t * 256 + el]; qdec[t] = exp2f((float)(t + 1) * l2g); kdec[t] = exp2f((float)(7 - t) * l2g); }
        const float dec8 = exp2f(8.f * l2g);
        float kv8[8];
#pragma unroll
        for (int t = 0; t < 8; ++t) kv8[t] = kdec[t] * vloc[t];
#pragma unroll 1
        for (int d0 = dh * 128; d0 < dh * 128 + 128; d0 += 8) { float s0[8];
#pragma unroll
            for (int k = 0; k < 8; ++k) s0[k] = c.p.state_ret[sbase + (size_t)(d0 + k) * RET_DV + e];
#pragma unroll
            for (int k = 0; k < 8; ++k) { const int d = d0 + k; float sn = s0[k] * dec8;
#pragma unroll
                for (int t = 0; t < 8; ++t) { o[t] += qd[t * 256 + d] * s0[k]; sn += kd[t * 256 + d] * kv8[t]; }
                c.p.out[O_RETS + sbase + (size_t)d * RET_DV + e] = sn; } }
        if (dh == 1) {
#pragma unroll
            for (int t = 0; t < 8; ++t) part[t * 256 + el] = o[t]; }
        __syncthreads();
        if (dh == 0) {
#pragma unroll
            for (int t = 0; t < 8; ++t) { float a = (o[t] + part[t * 256 + el]) * qdec[t];
#pragma unroll
                for (int m = 0; m < 8; ++m) if (m <= t) a += sc[t * 8 + m] * vloc[m];
                c.o()[(size_t)(NP + b * 8 + t) * 2048 + head * 512 + e] = (bf16)f2bf(a); } }
    }
    __syncthreads();
}
__device__ __forceinline__ void gate_rows4(const Ctx& c, const size_t (&off)[4], int lane) { u32x4 ow[4], gw[4];
#pragma unroll
    for (int k = 0; k < 4; ++k) { ow[k] = *(const u32x4*)(c.o() + off[k] + lane * 8); gw[k] = *(const u32x4*)(c.sg() + off[k] + lane * 8); }
#pragma unroll
    for (int k = 0; k < 4; ++k) { float o[8], g[8]; bf8_to_f32(ow[k], o); bf8_to_f32(gw[k], g); float ss = 0.f;
#pragma unroll
        for (int q = 0; q < 8; ++q) ss += o[q] * o[q];
        ss = wave_sum(ss); const float rs = 1.f / sqrtf(ss * (1.f / RET_DV) + EPS);
        u32x4 w; w.x = pk2(o[0] * rs * g[0], o[1] * rs * g[1]); w.y = pk2(o[2] * rs * g[2], o[3] * rs * g[3]); w.z = pk2(o[4] * rs * g[4], o[5] * rs * g[5]); w.w = pk2(o[6] * rs * g[6], o[7] * rs * g[7]);
        *(u32x4*)(c.g() + off[k] + lane * 8) = w; } }
__device__ __forceinline__ void ph_gate_own(const Ctx& c, Frame F) { F.tid = opq((int)threadIdx.x); F.lane = F.tid & 63;
    for (long pr = opq_s(xcd_slot((int)blockIdx.x, (int)gridDim.x)); pr < (long)BATCH * 4 * NSCH * 2; pr += gridDim.x) { const int shj = (int)(pr >> 1), head = shj % 4, sj = shj / 4, pm = (int)(pr & 1); const size_t row0 = (size_t)sj * SCH + pm * 256;
        for (int r4 = F.wave * 4; r4 < 256; r4 += NWAVES * 4) { size_t off[4];
#pragma unroll
            for (int k = 0; k < 4; ++k) off[k] = (row0 + r4 + k) * 2048 + head * 512;
            gate_rows4(c, off, F.lane); } }
}
__device__ __forceinline__ void ph_gate_sample(const Ctx& c, Frame F) { F.tid = opq((int)threadIdx.x); F.lane = F.tid & 63;
    for (long i4 = (long)opq_s(F.gw) * 4; i4 < (long)NS * RET_HEADS; i4 += (long)F.ngw * 4) { size_t off[4];
#pragma unroll
        for (int k = 0; k < 4; ++k) off[k] = ((size_t)NP * RET_HEADS + i4 + k) * RET_DV;
        gate_rows4(c, off, F.lane); }
}
__device__ __forceinline__ void ph_conv(const Ctx& c, Frame F, int layer) { F.tid = opq((int)threadIdx.x); F.lane = F.tid & 63;
    constexpr int NCHK = D_FF / 8, NSEG = NT / 64; const float* cw = c.p.ffn_conv_w + (size_t)layer * 3 * D_FF; const float* cb = c.p.ffn_conv_b + (size_t)layer * D_FF;
    for (long it = (long)opq_s(blockIdx.x) * MK_THREADS + opq(F.tid); it < (long)NSEG * NCHK; it += (long)gridDim.x * MK_THREADS) { const int ch = (int)(it % NCHK), seg = (int)(it / NCHK), f = ch * 8, row0 = seg * 64; const bool prompt = row0 < NP;
        float w0[8], w1[8], w2[8], bb[8];
#pragma unroll
        for (int k = 0; k < 2; ++k) { const f32x4 a = *(const f32x4*)(cw + f + 4 * k), b = *(const f32x4*)(cw + D_FF + f + 4 * k), d = *(const f32x4*)(cw + 2 * D_FF + f + 4 * k), e = *(const f32x4*)(cb + f + 4 * k);
            w0[4 * k] = a.x; w0[4 * k + 1] = a.y; w0[4 * k + 2] = a.z; w0[4 * k + 3] = a.w; w1[4 * k] = b.x; w1[4 * k + 1] = b.y; w1[4 * k + 2] = b.z; w1[4 * k + 3] = b.w;
            w2[4 * k] = d.x; w2[4 * k + 1] = d.y; w2[4 * k + 2] = d.z; w2[4 * k + 3] = d.w; bb[4 * k] = e.x; bb[4 * k + 1] = e.y; bb[4 * k + 2] = e.z; bb[4 * k + 3] = e.w; }
        float u1[8], u2[8];
#pragma unroll
        for (int k = 0; k < 8; ++k) { u1[k] = 0.f; u2[k] = 0.f; }
        if (prompt && (row0 % SEQ) != 0) { bf8_to_f32(*(const u32x4*)(c.u() + (size_t)(row0 - 1) * D_FF + f), u1); bf8_to_f32(*(const u32x4*)(c.u() + (size_t)(row0 - 2) * D_FF + f), u2); }
#pragma unroll 1
        for (int r4 = 0; r4 < 64; r4 += 4) { u32x4 uu[4], gg[4];
#pragma unroll
            for (int j = 0; j < 4; ++j) { const size_t off = (size_t)(row0 + r4 + j) * D_FF + f; uu[j] = *(const u32x4*)(c.u() + off); gg[j] = *(const u32x4*)(c.gt() + off); }
#pragma unroll
            for (int j = 0; j < 4; ++j) { const int row = row0 + r4 + j;
                if (!prompt && ((row - NP) % DEC_SEQ) == 0) { const float* buf = c.p.state_conv + ((size_t)(layer * DEC_BATCH + (row - NP) / DEC_SEQ) * 2) * D_FF + f;
#pragma unroll
                    for (int k = 0; k < 8; ++k) { u2[k] = buf[k]; u1[k] = buf[D_FF + k]; } }
                float u0[8], gt[8], rr[8]; bf8_to_f32(uu[j], u0); bf8_to_f32(gg[j], gt);
#pragma unroll
                for (int k = 0; k < 8; ++k) { const float cc = bb[k] + w0[k] * u2[k] + w1[k] * u1[k] + w2[k] * u0[k]; rr[k] = gelu_tanh(cc) * gt[k]; u2[k] = u1[k]; u1[k] = u0[k]; }
                u32x4 w; w.x = pk2(rr[0], rr[1]); w.y = pk2(rr[2], rr[3]); w.z = pk2(rr[4], rr[5]); w.w = pk2(rr[6], rr[7]); *(u32x4*)(c.act() + (size_t)row * D_FF + f) = w; } } }
}

struct SchedResSplit { const char* A; const char* B; int ld, nt, G, c;
    __device__ __forceinline__ bool next(int i, pg8::Unit& u) const { const long L = (long)i * G + c;
        if (L < 256) { const int w = (int)(L % 32), gid = (int)(L / 32); u.pm = gid * 8 + w % 8; u.pn = w / 8; u.nt = nt; u.aux = 0; u.A = A + (size_t)u.pm * 256 * ld * 2; u.B = B + (size_t)u.pn * 256 * ld * 2; return true; }
        const int j = (int)(L - 256); if (j >= 32) return false;
        const int pn = j >> 3, sl = j & 7, pairs = nt / 2, q = pairs / 8, rm = pairs % 8, t0 = 2 * (sl * q + (sl < rm ? sl : rm)), np = q + (sl < rm ? 1 : 0);
        u.pm = 64; u.pn = pn; u.nt = 2 * np; u.aux = 16 + sl; u.A = A + (size_t)64 * 256 * ld * 2 + (size_t)t0 * 128; u.B = B + (size_t)pn * 256 * ld * 2 + (size_t)t0 * 128; return true; }
};
__device__ __forceinline__ void ph_fix_sample(const Ctx& c, Frame F, bool dry, bool last) { F.tid = opq((int)threadIdx.x); F.lane = F.tid & 63;
    const float* P = (const float*)(c.p.ws + OW_SPLITK);
    for (int rl = opq_s(F.gw); rl < NS; rl += F.ngw) { const int r = NP + rl; float s = 0.f;
#pragma unroll
        for (int j = 0; j < 4; ++j) { const u32x2 xo = ((const u32x2*)(c.xb() + (size_t)r * D_MODEL))[F.lane + 64 * j]; f32x4 v = (f32x4){bflo(xo.x), bfhi(xo.x), bflo(xo.y), bfhi(xo.y)};
#pragma unroll
            for (int sl = 0; sl < 8; ++sl) v = v + ((const f32x4*)(P + ((size_t)sl * 256 + rl) * D_MODEL))[F.lane + 64 * j];
            s += (v.x * v.x + v.y * v.y) + (v.z * v.z + v.w * v.w);
            if (!dry) { if (last) ((f32x4*)(c.x() + (size_t)r * D_MODEL))[F.lane + 64 * j] = v; u32x2 w; w.x = pk2(v.x, v.y); w.y = pk2(v.z, v.w); ((u32x2*)(c.xb() + (size_t)r * D_MODEL))[F.lane + 64 * j] = w; } }
        s = wave_sum(s); if (F.lane < 16 && !dry) c.ssq()[(size_t)r * 16 + F.lane] = F.lane == 0 ? s : 0.f; if (F.lane == 0 && !dry) c.rstd()[r] = 1.f / sqrtf(s * (1.f / D_MODEL) + EPS); }
    if (!dry) for (int r = opq_s((int)blockIdx.x) * MK_THREADS + F.tid; r < NP; r += gridDim.x * MK_THREADS) c.rstd()[r] = row_rstd(c.ssq(), r);
}
__device__ __forceinline__ const float* paged_row_f(const float* cache, const int* pt, int b, int p) { const int page = pt[b * N_PAGES + p / PAGE_SIZE]; return cache + ((size_t)page * PAGE_SIZE + p % PAGE_SIZE) * KVROW; }
__device__ __forceinline__ void ph_cmp_convert(const Ctx& c, Frame F) { F.tid = opq((int)threadIdx.x); F.lane = F.tid & 63;
    const int cc = F.lane >> 5, kvh = (F.lane >> 3) & 3, d = (F.lane & 7) * 8;
    for (long i0 = (long)opq_s(F.gw) * 8; i0 < (long)DEC_BATCH * PAST_LEN; i0 += (long)F.ngw * 8) { const int b = (int)(i0 / PAST_LEN), p = (int)(i0 % PAST_LEN);
        const float* src = paged_row_f(c.p.cache_cmp, c.p.page_table, b, p) + F.lane * 8; f32x4 a[8], bb[8];
#pragma unroll
        for (int k = 0; k < 8; ++k) { a[k] = ((const f32x4*)(src + (size_t)k * KVROW))[0]; bb[k] = ((const f32x4*)(src + (size_t)k * KVROW))[1]; }
        bf16* dst = c.asub() + ((size_t)((cc * N_KV + kvh) * NSEQ + BATCH + b) * 512 + p / 16) * 1024 + (p % 16) * 64 + d;
#pragma unroll
        for (int k = 0; k < 8; ++k) *(u32x4*)(dst + k * 64) = pack8(a[k], bb[k]); }
}
struct SchedCmp { const Ctx* c; int G, cu;
    __device__ __forceinline__ bool next(int i, pg8::Unit& u) const { const long L = (long)i * G + cu; constexpr int NU = 8 * NSEQ * 512 / 256; if (L >= NU) return false;
        u.pm = (int)L; u.pn = 0; u.nt = 16; u.aux = 0; u.A = (const char*)(c->asub() + (size_t)L * 256 * 1024); u.B = (const char*)(c->w_cmp1() + (size_t)(L / (NU / 2)) * 256 * 1024); return true; }
};
__device__ __forceinline__ void ph_cmp_stage2(const Ctx& c, Frame F) { F.tid = opq((int)threadIdx.x); F.lane = F.tid & 63;
    lds_f32* hid = (lds_f32*)(F.lds + F.wave * 1024);
    constexpr long PER_C = (long)4 * NSEQ * 512;
#pragma unroll 1
    for (int cc = 0; cc < 2; ++cc) {
        float w2r[CMP_HID];
#pragma unroll
        for (int hh = 0; hh < CMP_HID; ++hh) w2r[hh] = c.p.cmp_w2[((size_t)cc * CMP_HID + hh) * HEAD_DIM + F.lane];
        float pb0 = 0.f, pb1 = 0.f;
#pragma unroll 8
        for (int j = 0; j < 32; ++j) { pb0 += c.posb()[(size_t)(cc * 32 + j) * CMP_HID + F.lane]; pb1 += c.posb()[(size_t)(cc * 32 + j) * CMP_HID + 64 + F.lane]; }
        const float kg = c.p.kv_knorm[F.lane];
        for (long ii0 = (long)opq_s(F.gw) * 4; ii0 < PER_C; ii0 += (long)F.ngw * 4) { float a0[4], a1[4];
#pragma unroll
            for (int k = 0; k < 4; ++k) { const bf16* p0 = c.part() + (size_t)(cc * PER_C + ii0 + k) * 256; const bf16* p1 = p0 + 256 + 128; const bool real = ((ii0 + k) % 512) < NCMP;
                a0[k] = real ? bf2f(p0[F.lane]) + bf2f(p1[F.lane]) : 0.f; a1[k] = real ? bf2f(p0[F.lane + 64]) + bf2f(p1[F.lane + 64]) : 0.f; }
#pragma unroll
            for (int k = 0; k < 4; ++k) { const long ii = ii0 + k; const int n = (int)(ii % 512), s = (int)((ii / 512) % NSEQ), kvh = (int)(ii / (512 * NSEQ));
                if (n >= NCMP) {
                    if (cc == 0) c.cmpk()[((size_t)(s * N_KV + kvh) * 512 + n) * 64 + F.lane] = 0; else c.cmpvt()[(size_t)(s * N_KV + kvh) * 64 * 512 + vtt_off(n, F.lane)] = 0; continue; }
                hid[F.lane] = gelu_tanh(a0[k] + pb0); hid[F.lane + 64] = gelu_tanh(a1[k] + pb1);
                asm volatile("s_waitcnt lgkmcnt(0)" ::: "memory");
                float o0 = 0.f, o1 = 0.f;
#pragma unroll
                for (int h4 = 0; h4 < CMP_HID / 4; ++h4) { const f32x4 hv = *(const __attribute__((address_space(3))) f32x4*)(hid + 4 * h4); o0 += hv.x * w2r[4 * h4] + hv.z * w2r[4 * h4 + 2]; o1 += hv.y * w2r[4 * h4 + 1] + hv.w * w2r[4 * h4 + 3]; }
                const float o = o0 + o1;
                asm volatile("s_waitcnt lgkmcnt(0)" ::: "memory");
                if (cc == 0) { const float ss = wave_sum(o * o); const float rs = 1.f / sqrtf(ss * (1.f / HEAD_DIM) + EPS); c.cmpk()[((size_t)(s * N_KV + kvh) * 512 + n) * 64 + F.lane] = (bf16)f2bf(o * rs * kg); }
                else c.cmpvt()[(size_t)(s * N_KV + kvh) * 64 * 512 + vtt_off(n, F.lane)] = (bf16)f2bf(o); } } }
}
__device__ __forceinline__ void kvt_item(const float* srck, const float* srcv, int pitch, bf16* dstk, bf16* dstv, int ldt, lds_f32* scr, int lane) {
#pragma unroll
    for (int i = 0; i < 8; ++i) { const int tok = i * 8 + (lane >> 3), d8 = (lane & 7) * 8; const f32x4* sp = (const f32x4*)(srck + (size_t)tok * pitch + d8); *(u32x4*)(dstk + (size_t)tok * 64 + d8) = pack8(sp[0], sp[1]); }
#pragma unroll
    for (int half = 0; half < 2; ++half) {
        { const int col4 = (lane & 7) * 4; f32x4 v[8];
#pragma unroll
          for (int i = 0; i < 8; ++i) { const int tok = i * 8 + (lane >> 3); v[i] = *(const f32x4*)(srcv + (size_t)tok * pitch + half * 32 + col4); }
#pragma unroll
          for (int i = 0; i < 8; ++i) { const int tok = i * 8 + (lane >> 3); scr[tok * 33 + col4] = v[i].x; scr[tok * 33 + col4 + 1] = v[i].y; scr[tok * 33 + col4 + 2] = v[i].z; scr[tok * 33 + col4 + 3] = v[i].w; } }
        asm volatile("s_waitcnt lgkmcnt(0)" ::: "memory");
        const int cch = lane & 7;
#pragma unroll
        for (int j = 0; j < 4; ++j) { const int n = (lane >> 3) + 8 * j; const lds_f32* s = scr + (8 * cch) * 33 + n;
            u32x4 o; o.x = pk2(s[0 * 33], s[1 * 33]); o.y = pk2(s[2 * 33], s[3 * 33]); o.z = pk2(s[4 * 33], s[5 * 33]); o.w = pk2(s[6 * 33], s[7 * 33]);
            *(u32x4*)(dstv + (size_t)(cch >> 2) * 2048 + (size_t)(half * 32 + n) * 32 + ((8 * cch) & 31)) = o; }
        asm volatile("s_waitcnt lgkmcnt(0)" ::: "memory"); }
}
#ifndef SEL_EARLY
#define SEL_EARLY 2400
#endif
constexpr int SEL_ITEMS = DEC_BATCH * N_KV * (PAST_LEN / 64 + WIN_BUF / 64);
__device__ __forceinline__ void sel_convert_items(const Ctx& c, Frame F, int lo, int hi, int widx, int nw) { F.tid = opq((int)threadIdx.x); F.lane = F.tid & 63;
    lds_f32* scr = (lds_f32*)(F.lds + 8192 + F.wave * 16384);
    constexpr int NB_SEL = PAST_LEN / 64, NB_WIN = WIN_BUF / 64;
    for (long i = (long)lo + opq_s(widx); i < (long)hi; i += nw) { const int blk = (int)(i % (NB_SEL + NB_WIN)), bk = (int)(i / (NB_SEL + NB_WIN)), kvh = bk % N_KV, b = bk / N_KV;
        if (blk < NB_SEL) { const float* src = paged_row_f(c.p.cache_sel, c.p.page_table, b, blk * 64) + kvh * 64;
            kvt_item(src, src + KVH, KVROW, c.sks() + ((size_t)bk * SELP + blk * 64) * 64, c.svts() + (size_t)bk * 64 * SELP + (size_t)blk * 4096, SELP, scr, F.lane); }
        else { const int wb = blk - NB_SEL; const float* src = c.p.cache_win + ((size_t)b * WIN_BUF + wb * 64) * KVROW + kvh * 64;
            kvt_item(src, src + KVH, KVROW, c.wks() + ((size_t)bk * WINS + wb * 64) * 64, c.wvts() + (size_t)bk * 64 * WINS + (size_t)wb * 4096, WINS, scr, F.lane); } }
}
__device__ __forceinline__ void ph_sel_convert(const Ctx& c, Frame F) { F.tid = opq((int)threadIdx.x); F.lane = F.tid & 63;
    sel_convert_items(c, F, 2 * SEL_EARLY, SEL_ITEMS, F.gw, F.ngw);
    for (long i = (long)opq_s(blockIdx.x) * MK_THREADS + opq(F.tid); i < (long)DEC_BATCH * N_KV * 64 * (SELP - PAST_LEN - DEC_SEQ); i += (long)gridDim.x * MK_THREADS) { const int pt = (int)(i % (SELP - PAST_LEN - DEC_SEQ)) + PAST_LEN + DEC_SEQ, d = (int)((i / (SELP - PAST_LEN - DEC_SEQ)) % 64); const long bk = i / ((SELP - PAST_LEN - DEC_SEQ) * 64);
        c.sks()[((size_t)bk * SELP + pt) * 64 + d] = 0; c.svts()[(size_t)bk * 64 * SELP + vtt_off(pt, d)] = 0; }
    for (long i = (long)opq_s(blockIdx.x) * MK_THREADS + opq(F.tid); i < (long)DEC_BATCH * N_KV * 64 * (WINS - WIN_BUF - DEC_SEQ); i += (long)gridDim.x * MK_THREADS) { const int pt = (int)(i % (WINS - WIN_BUF - DEC_SEQ)) + WIN_BUF + DEC_SEQ, d = (int)((i / (WINS - WIN_BUF - DEC_SEQ)) % 64); const long bk = i / ((WINS - WIN_BUF - DEC_SEQ) * 64);
        c.wks()[((size_t)bk * WINS + pt) * 64 + d] = 0; c.wvts()[(size_t)bk * 64 * WINS + vtt_off(pt, d)] = 0; }
    for (long i = (long)opq_s(blockIdx.x) * MK_THREADS + opq(F.tid); i < (long)DEC_BATCH * (WIN_S - DEC_SEQ) * (KVROW / 4); i += (long)gridDim.x * MK_THREADS) { const int q4 = (int)(i % (KVROW / 4)), j = (int)((i / (KVROW / 4)) % (WIN_S - DEC_SEQ)), b = (int)(i / ((long)(KVROW / 4) * (WIN_S - DEC_SEQ)));
        ((f32x4*)(c.p.out + O_WINS + ((size_t)b * WIN_S + j) * KVROW))[q4] = ((const f32x4*)(c.p.cache_win + ((size_t)b * WIN_BUF + (WIN_BUF - (WIN_S - DEC_SEQ) + j)) * KVROW))[q4]; }
}
typedef float f32x16 __attribute__((ext_vector_type(16)));
typedef short s16x8 __attribute__((ext_vector_type(8)));
typedef short s16x4 __attribute__((ext_vector_type(4)));
typedef __bf16 bf16x2_t __attribute__((ext_vector_type(2)));
typedef __attribute__((address_space(3))) unsigned lds_u32;
#define MFMA32(a, b, c) __builtin_amdgcn_mfma_f32_32x32x16_bf16((a), (b), (c), 0, 0, 0)
__device__ __forceinline__ unsigned cvtpk(float lo, float hi) { const f32x2 v = {lo, hi}; const bf16x2_t b = __builtin_convertvector(v, bf16x2_t); return __builtin_bit_cast(unsigned, b); }
__device__ __forceinline__ int crow16(int i, int h) { return (i & 3) + 8 * (i >> 2) + 4 * h; }
#define CROWK(k_) (((k_) & 3) + 4 * (((k_) >> 2) & 1) + 16 * ((k_) >> 3))
constexpr float LOG2E = 1.4426950408889634f;
template <int O> __device__ __forceinline__ int xshf_i(int v) {
    if constexpr (O == 1) return __builtin_amdgcn_update_dpp(0, v, 0xB1, 0xF, 0xF, false);
    else if constexpr (O == 2) return __builtin_amdgcn_update_dpp(0, v, 0x4E, 0xF, 0xF, false);
    else if constexpr (O == 32) return __shfl_xor(v, 32);
    else return __builtin_amdgcn_ds_swizzle(v, (O << 10) | 0x1f); }
template <int O> __device__ __forceinline__ float xshf(float v) { return __builtin_bit_cast(float, xshf_i<O>(__builtin_bit_cast(int, v))); }
typedef __attribute__((address_space(3))) unsigned char lds_u8;
__device__ __forceinline__ void att_dma_offsets(int (&ko)[4], int (&vo)[4], int lane) {
#pragma unroll
    for (int j = 0; j < 4; ++j) { const int p = 64 * j + lane; { const int row = p >> 3, ch = (p & 7) ^ ((row >> 1) & 7), key = (row & ~12) | ((row & 4) << 1) | ((row & 8) >> 1); ko[j] = key * 64 + ch * 8; }
        { const int row = p >> 2, ch = (p & 3) ^ ((row >> 2) & 3); vo[j] = row * 32 + ch * 8; } } }
__device__ __forceinline__ void att_dma(const bf16* src, const int (&off)[4], lds_u8* dst) {
#pragma unroll
    for (int j = 0; j < 4; ++j) __builtin_amdgcn_global_load_lds((const unsigned*)(src + off[j]), (__attribute__((address_space(3))) unsigned*)(dst + j * 1024), 16, 0, 0); }
__device__ __forceinline__ f32x16 att_qk_lds(const lds_u8* kb, const s16x8 (&q)[4], int r, int h, float init) { f32x16 s;
#pragma unroll
    for (int i = 0; i < 16; ++i) s[i] = init;
    const lds_u8* rowp = kb + r * 128; const int kx = (r >> 1) & 7;
#pragma unroll
    for (int ks = 0; ks < 4; ++ks) { const s16x8 kf = *(const __attribute__((address_space(3))) s16x8*)(rowp + (((2 * ks + h) ^ kx) << 4)); s = MFMA32(kf, q[ks], s); }
    return s; }
__device__ __forceinline__ void att_pv_lds(const lds_u8* vb, const float (&e)[16], f32x16 (&o)[2], int r, int h) { const int vx = (r >> 2) & 3;
#pragma unroll
    for (int s2 = 0; s2 < 2; ++s2) { u32x4 pw; pw.x = cvtpk(e[8 * s2], e[8 * s2 + 1]); pw.y = cvtpk(e[8 * s2 + 2], e[8 * s2 + 3]); pw.z = cvtpk(e[8 * s2 + 4], e[8 * s2 + 5]); pw.w = cvtpk(e[8 * s2 + 6], e[8 * s2 + 7]);
        const s16x8 pb = __builtin_bit_cast(s16x8, pw);
#pragma unroll
        for (int dt = 0; dt < 2; ++dt) { const s16x8 vf = *(const __attribute__((address_space(3))) s16x8*)(vb + (32 * dt + r) * 64 + (((2 * s2 + h) ^ vx) << 4)); o[dt] = MFMA32(vf, pb, o[dt]); } } }
#define ATT_WALK(NT_, ...) do { const int nt_ = (NT_); \
    asm volatile("s_waitcnt vmcnt(0) lgkmcnt(0)" ::: "memory"); \
    if (nt_ > 0) { att_dma(KT__(0), ko, kbuf0); if (PV__) att_dma(VT__(0), vo, vbuf0); } \
    _Pragma("unroll 1") for (int i = 0; i < nt_; ++i) { lds_u8* const kb_ = (i & 1) ? kbuf1 : kbuf0; lds_u8* const vbuf = (i & 1) ? vbuf1 : vbuf0; (void)vbuf; \
        if (i + 1 < nt_) { if (abl != 9) { att_dma(KT__(i + 1), ko, (i & 1) ? kbuf0 : kbuf1); if (PV__) att_dma(VT__(i + 1), vo, (i & 1) ? vbuf0 : vbuf1); } \
            if (abl == 9) asm volatile("s_waitcnt vmcnt(0)" ::: "memory"); else if (PV__) asm volatile("s_waitcnt vmcnt(8)" ::: "memory"); else asm volatile("s_waitcnt vmcnt(4)" ::: "memory"); } \
        else asm volatile("s_waitcnt vmcnt(0)" ::: "memory"); \
        const f32x16 sc = att_qk_lds(kb_, q, r, h, (INIT__)); __VA_ARGS__ \
        asm volatile("s_waitcnt lgkmcnt(0)" ::: "memory"); } } while (0)
__device__ __forceinline__ void ph_attention(const Ctx& c, Frame F, int jq, int rep) { F.tid = opq((int)threadIdx.x); F.lane = F.tid & 63;
#ifndef ABL_MODE
#define ABL_MODE 0
#endif
    const int abl = rep ? ABL_MODE : 0;
    const int lane = F.lane, r = lane & 31, h = lane >> 5, qi = r >> 2, g = r & 3;
    lds_u8* const wl = (lds_u8*)(F.lds + F.wave * 17920);
    lds_u32* selm = (lds_u32*)wl; __attribute__((address_space(3))) int* tl = (__attribute__((address_space(3))) int*)(wl + 256);
    lds_u8* const kbuf0 = wl + 1536; lds_u8* const kbuf1 = wl + 5632; lds_u8* const vbuf0 = wl + 9728; lds_u8* const vbuf1 = wl + 13824; lds_f32* imp = (lds_f32*)vbuf1; lds_f32* impv = (lds_f32*)vbuf0;
    int ko[4], vo[4]; att_dma_offsets(ko, vo, lane);
    unsigned* ctr0 = (unsigned*)(c.p.ws + OW_CTL) + 8192 + (jq * 2 + rep) * 512;
    const unsigned x0 = xb_xcc_id() & 7u;
    float gq = fabsf(c.p.nsa_qnorm[jq * HEAD_DIM + lane]), gk0 = fabsf(c.p.kv_knorm[lane]), gk1 = fabsf(c.p.kv_knorm[HEAD_DIM + lane]), gk2 = fabsf(c.p.kv_knorm[2 * HEAD_DIM + lane]);
#define GMAX_(O_) do { gq = fmaxf(gq, xshf<O_>(gq)); gk0 = fmaxf(gk0, xshf<O_>(gk0)); gk1 = fmaxf(gk1, xshf<O_>(gk1)); gk2 = fmaxf(gk2, xshf<O_>(gk2)); } while (0)
    GMAX_(1); GMAX_(2); GMAX_(4); GMAX_(8); GMAX_(16); GMAX_(32);
#undef GMAX_
    const float c1 = 0.125f * LOG2E, c2c = 8.1f * gq * gk0 * LOG2E, c2s = 8.1f * gq * gk1 * LOG2E, c2w = 8.1f * gq * gk2 * LOG2E;
    constexpr int NQ_S = DEC_BATCH * N_KV / 8, NQ_P = SEQ / 8;
    for (int kx = 0; kx < 8; ++kx) { const int xq = (int)((x0 + kx) & 7u); unsigned* ctr = ctr0 + 64 * xq;
    for (;;) {
        unsigned ui = 0; if (lane == 0) ui = __hip_atomic_fetch_add(ctr, 1u, __ATOMIC_RELAXED, __HIP_MEMORY_SCOPE_AGENT); ui = __builtin_amdgcn_readfirstlane(ui);
        if (ui >= (unsigned)(NQ_S + NQ_P)) break;
        int s, kvh, row0, pos0; bool prompt;
        if (ui < (unsigned)NQ_S) { prompt = false; const int v = xq * NQ_S + (int)ui, b = v / N_KV; kvh = v % N_KV; s = BATCH + b; row0 = NP + b * DEC_SEQ; pos0 = PAST_LEN; }
        else { prompt = true; const int tg = (SEQ / 8 - 1) - ((int)ui - NQ_S); s = xq / N_KV; kvh = xq % N_KV; row0 = s * SEQ + tg * 8; pos0 = tg * 8; }
        const int pos = pos0 + qi, posmax = pos0 + 7, cur = pos0 >> 6; const int head = kvh * GROUP + g, row = row0 + qi;
        const bf16* ck = c.cmpk() + (size_t)(s * N_KV + kvh) * 512 * 64; const bf16* cvt = c.cmpvt() + (size_t)(s * N_KV + kvh) * 64 * 512;
        const bf16 *sk, *svt, *wk, *wvt; size_t svp, wvp; int wbase;
        if (prompt) { sk = c.sk() + (size_t)(s * N_KV + kvh) * SEQ * 64; svt = c.svt() + (size_t)(s * N_KV + kvh) * 64 * SEQ; svp = SEQ; wk = c.wk() + (size_t)(s * N_KV + kvh) * SEQ * 64; wvt = c.wvt() + (size_t)(s * N_KV + kvh) * 64 * SEQ; wvp = SEQ; wbase = 0; }
        else { const int bk = (s - BATCH) * N_KV + kvh; sk = c.sks() + (size_t)bk * SELP * 64; svt = c.svts() + (size_t)bk * 64 * SELP; svp = SELP; wk = c.wks() + (size_t)bk * WINS * 64; wvt = c.wvts() + (size_t)bk * 64 * WINS; wvp = WINS; wbase = PAST_LEN - WIN_BUF; }
        f32x16 ob[2];
#pragma unroll
        for (int i = 0; i < 16; ++i) { ob[0][i] = 0.f; ob[1][i] = 0.f; }
        const float gate0 = c.gates()[(size_t)row * 48 + head * 3 + 0], gate1 = c.gates()[(size_t)row * 48 + head * 3 + 1], gate2 = c.gates()[(size_t)row * 48 + head * 3 + 2];
        bf16* const od = c.ao() + (size_t)row * D_Q + head * 64;
#define ATT_OSTORE() do { _Pragma("unroll") for (int dt = 0; dt < 2; ++dt) _Pragma("unroll") for (int a = 0; a < 4; ++a) { u32x2 w; w.x = cvtpk(ob[dt][4 * a], ob[dt][4 * a + 1]); w.y = cvtpk(ob[dt][4 * a + 2], ob[dt][4 * a + 3]); *(u32x2*)(od + 32 * dt + 8 * a + 4 * h) = w; } } while (0)
#define ATT_OADD() do { _Pragma("unroll") for (int dt = 0; dt < 2; ++dt) _Pragma("unroll") for (int a = 0; a < 4; ++a) { const u32x2 w = *(const u32x2*)(od + 32 * dt + 8 * a + 4 * h); ob[dt][4 * a] += bflo(w.x); ob[dt][4 * a + 1] += bfhi(w.x); ob[dt][4 * a + 2] += bflo(w.y); ob[dt][4 * a + 3] += bfhi(w.y); } } while (0)
        s16x8 q[4];
        {   const bf16* qb = c.qc() + ((size_t)row * N_HEADS + head) * 64 + 8 * h;
#pragma unroll
            for (int ks = 0; ks < 4; ++ks) q[ks] = *(const s16x8*)(qb + 16 * ks);
            int nc = pos - (CMP_LEN - 1); nc = nc < 0 ? 0 : nc / CMP_STRIDE + 1; nc = nc < NCMP ? nc : NCMP;
            int ncmin = pos0 - (CMP_LEN - 1); ncmin = ncmin < 0 ? 0 : ncmin / CMP_STRIDE + 1; ncmin = ncmin < NCMP ? ncmin : NCMP;
            int ncmax = posmax - (CMP_LEN - 1); ncmax = ncmax < 0 ? 0 : ncmax / CMP_STRIDE + 1; ncmax = ncmax < NCMP ? ncmax : NCMP;
            float l = 0.f; f32x2 l2 = {0.f, 0.f};
#define KP_(i_) (ck + (size_t)(i_) * 32 * 64)
#define VP_(i_) (cvt + (size_t)(i_) * 2048)

#define KT__(i_) KP_(i_)
#define VT__(i_) VP_(i_)
#define PV__ 1
#define INIT__ -c2c
            ATT_WALK((ncmax + 31) >> 5, { const int lim = nc - i * 32 - 8 * h; float e[16];
                if (i * 32 + 32 <= ncmin) { _Pragma("unroll") for (int k = 0; k < 16; ++k) e[k] = __builtin_amdgcn_exp2f(sc[k]); }
                else { _Pragma("unroll") for (int k = 0; k < 16; ++k) e[k] = (CROWK(k) < lim) ? __builtin_amdgcn_exp2f(sc[k]) : 0.f; }
                _Pragma("unroll") for (int k = 0; k < 16; k += 2) l2 += (f32x2){e[k], e[k + 1]};
                att_pv_lds(vbuf, e, ob, r, h); });
#undef KT__
#undef VT__
#undef PV__
#undef INIT__

            l = l2.x + l2.y; l += __shfl_xor(l, 32);
            const float invl = 1.f / (l > TINY ? l : TINY), f0 = gate0 * invl;
#pragma unroll
            for (int i = 0; i < 16; ++i) { ob[0][i] *= f0; ob[1][i] *= f0; }
            ATT_OSTORE();
#pragma unroll
            for (int i = 0; i < 16; ++i) { ob[0][i] = 0.f; ob[1][i] = 0.f; }
            for (int i = lane; i < 8 * 128; i += 64) { imp[i] = 0.f; impv[i] = 0.f; }
            if (lane < 64) selm[lane] = 0u;

#define KT__(i_) KP_(i_)
#define VT__(i_) VP_(i_)
#define PV__ 0
#define INIT__ -c2c
            ATT_WALK((ncmax + 31) >> 5, { const int n0 = i * 32, lim = nc - n0 - 8 * h;
                _Pragma("unroll") for (int a = 0; a < 4; ++a) { float e4[4];
                    _Pragma("unroll") for (int k = 0; k < 4; ++k) { const int ii = 4 * a + k; e4[k] = (CROWK(ii) < lim) ? __builtin_amdgcn_exp2f(sc[ii]) * invl : 0.f; }
                    float u = (e4[0] + e4[1]) + (e4[2] + 0.5f * e4[3]), v = 0.5f * e4[3];
                    u += xshf<1>(u); u += xshf<2>(u); v += xshf<1>(v); v += xshf<2>(v);
                    const int sb = (n0 >> 2) + 4 * (a >> 1) + (a & 1) + 2 * h;
                    if (g == 0 && sb < 127) { imp[qi * 128 + sb] = u; impv[qi * 128 + sb + 1] = v; } } });
#undef KT__
#undef VT__
#undef PV__
#undef INIT__

#undef KP_
#undef VP_
        }
        {   const int tq = lane >> 3, sub = lane & 7; const int nforced = cur == 0 ? 1 : (cur == 1 ? 2 : 3), kx = SEL_TOPK - nforced, ncand = cur - 2 > 0 ? cur - 2 : 0;
            if (c.p.dbg_topi) {
                if (sub == 0) { const int* ti = c.p.dbg_topi + ((size_t)(row0 + tq) * N_KV + kvh) * SEL_TOPK; for (int k = 0; k < SEL_TOPK; ++k) { const int sb = ti[k]; if (sb >= 0) selm[tq * 8 + (sb >> 5)] |= 1u << (sb & 31); } }
            } else {
            if (sub == 0) { selm[tq * 8 + 0] |= 1u; selm[tq * 8 + (cur >> 5)] |= 1u << (cur & 31); if (cur >= 1) selm[tq * 8 + ((cur - 1) >> 5)] |= 1u << ((cur - 1) & 31); }
            if (ncand <= kx) { if (sub == 0) for (int sb = 1; sb <= cur - 2; ++sb) selm[tq * 8 + (sb >> 5)] |= 1u << (sb & 31); }
            else for (int it = 0; it < kx; ++it) { float best = -3e38f; int bi = 0x7fffffff;
                for (int sb = 1 + sub; sb <= cur - 2; sb += 8) { const float v = imp[tq * 128 + sb] + impv[tq * 128 + sb]; if (v > best) { best = v; bi = sb; } }
#define TK_(O_) do { const float ob2 = xshf<O_>(best); const int oi = xshf_i<O_>(bi); if (ob2 > best || (ob2 == best && oi < bi)) { best = ob2; bi = oi; } } while (0)
                TK_(1); TK_(2); TK_(4);
#undef TK_
                if (bi != 0x7fffffff) { if (sub == ((bi - 1) & 7)) imp[tq * 128 + bi] = -3.4e38f; if (sub == 0) selm[tq * 8 + (bi >> 5)] |= 1u << (bi & 31); } }
            }
        }
        {   const bf16* qb = c.qr() + ((size_t)row * N_HEADS + head) * 64 + 8 * h;
#pragma unroll
            for (int ks = 0; ks < 4; ++ks) q[ks] = *(const s16x8*)(qb + 16 * ks);
            float l = 0.f; f32x2 l2 = {0.f, 0.f};
            int ntl = 0;
            for (int sb = 0; sb <= cur; ++sb) { const unsigned mw = selm[qi * 8 + (sb >> 5)]; const bool bit = (mw >> (sb & 31)) & 1u; if (!__any(bit)) continue;
                const bool two = sb * 64 + 32 <= posmax; if (lane == 0) { tl[ntl] = sb * 64; if (two) tl[ntl + 1] = sb * 64 + 32; } ntl += two ? 2 : 1; }
#define KP_(i_) (sk + (size_t)tl[(i_)] * 64)
#define VP_(i_) (svt + (size_t)(tl[(i_)] >> 5) * 2048)

#define KT__(i_) KP_(i_)
#define VT__(i_) VP_(i_)
#define PV__ 1
#define INIT__ (((selm[qi * 8 + (tl[i] >> 11)] >> ((tl[i] >> 6) & 31)) & 1u) ? -c2s : -1e30f)
            ATT_WALK(ntl, { const int tok0 = tl[i], sb = tok0 >> 6; const bool bit = (selm[qi * 8 + (sb >> 5)] >> (sb & 31)) & 1u; const int lim = bit ? pos - tok0 - 8 * h : -1; float e[16];
                if (tok0 + 31 <= pos0) { _Pragma("unroll") for (int k = 0; k < 16; ++k) e[k] = __builtin_amdgcn_exp2f(sc[k]); }
                else { _Pragma("unroll") for (int k = 0; k < 16; ++k) e[k] = (CROWK(k) <= lim) ? __builtin_amdgcn_exp2f(sc[k]) : 0.f; }
                _Pragma("unroll") for (int k = 0; k < 16; k += 2) l2 += (f32x2){e[k], e[k + 1]};
                att_pv_lds(vbuf, e, ob, r, h); });
#undef KT__
#undef VT__
#undef PV__
#undef INIT__

#undef KP_
#undef VP_
            l = l2.x + l2.y; l += __shfl_xor(l, 32);
            { const float f1 = gate1 / (l > TINY ? l : TINY);
#pragma unroll
              for (int i = 0; i < 16; ++i) { ob[0][i] *= f1; ob[1][i] *= f1; }
              ATT_OADD(); ATT_OSTORE();
#pragma unroll
              for (int i = 0; i < 16; ++i) { ob[0][i] = 0.f; ob[1][i] = 0.f; } }
            l = 0.f; l2 = (f32x2){0.f, 0.f};
            int lo = pos0 - (WINDOW - 1); if (lo < wbase) lo = wbase; if (lo < 0) lo = 0; const int i0 = (lo - wbase) & ~31;
#define KP_(i_) (wk + (size_t)(i0 + 32 * (i_)) * 64)
#define VP_(i_) (wvt + (size_t)((i0 >> 5) + (i_)) * 2048)

#define KT__(i_) KP_(i_)
#define VT__(i_) VP_(i_)
#define PV__ 1
#define INIT__ -c2w
            ATT_WALK(((posmax - wbase - i0) >> 5) + 1, { const int tok0 = i0 + 32 * i + wbase; const int hi_ = pos - tok0 - 8 * h, lo_ = hi_ - WINDOW; float e[16];
                if (tok0 + 31 <= pos0 && tok0 > posmax - WINDOW) { _Pragma("unroll") for (int k = 0; k < 16; ++k) e[k] = __builtin_amdgcn_exp2f(sc[k]); }
                else { _Pragma("unroll") for (int k = 0; k < 16; ++k) e[k] = (CROWK(k) <= hi_ && CROWK(k) > lo_) ? __builtin_amdgcn_exp2f(sc[k]) : 0.f; }
                _Pragma("unroll") for (int k = 0; k < 16; k += 2) l2 += (f32x2){e[k], e[k + 1]};
                att_pv_lds(vbuf, e, ob, r, h); });
#undef KT__
#undef VT__
#undef PV__
#undef INIT__

#undef KP_
#undef VP_
            l = l2.x + l2.y; l += __shfl_xor(l, 32);
            { const float f2 = gate2 / (l > TINY ? l : TINY);
#pragma unroll
              for (int i = 0; i < 16; ++i) { ob[0][i] *= f2; ob[1][i] *= f2; }
              ATT_OADD(); }
        }
        ATT_OSTORE();
#undef ATT_OSTORE
#undef ATT_OADD
    }
    }
}
#ifndef GEMM_ALIGN
#define GEMM_ALIGN true
#endif
constexpr int PH_KVQG = 19, PH_CMPG = 20, PH_CMP2 = 21, PH_ATT0 = 22, PH_QG1 = 27, PH_ATT1 = 28, NPH = 33;
__device__ __forceinline__ void gemm_dense(const Ctx& c, const Frame& F, const bf16* A, int lda, const bf16* B, int ldb, int nM, int nN, int K) { (void)c; (void)F; (void)A; (void)lda; (void)B; (void)ldb; (void)nM; (void)nN; (void)K; }
#ifndef OPT_ATTN
__device__ __forceinline__ void ph_attention(const Ctx& c, const Frame& F, int jq, int rep) { (void)c; (void)F; (void)jq; (void)rep; }
#endif
__global__ void __launch_bounds__(MK_THREADS, 2) fwd(OptP p) {
    extern __shared__ __attribute__((aligned(16))) unsigned char lds_raw[];
    Frame F; F.lds = (__attribute__((address_space(3))) unsigned char*)lds_raw; F.tid = threadIdx.x; F.lane = F.tid & 63; F.wave = __builtin_amdgcn_readfirstlane(F.tid >> 6);
    F.gw = blockIdx.x * NWAVES + F.wave; F.ngw = gridDim.x * NWAVES;
    volatile LAS unsigned* misc = (volatile LAS unsigned*)(F.lds + MK_LDS - 64);
    if (F.tid < 4) misc[F.tid] = 0u;
    __syncthreads();
    XcdBarrier bar = xcd_barrier_post((unsigned*)(p.ws + OW_CTL) + 4096, misc);
    unsigned long long bar_ticks = 0; (void)bar_ticks;
    const int lo = (int)p.ph_lo, hi = (int)p.ph_hi, G = gridDim.x, cu = blockIdx.x; const unsigned long long dupm = (unsigned long long)p.dup;
#ifdef ONLY_PHASE
#define IN(k) ((k) == ONLY_PHASE)
#else
#define IN(k) (lo <= (k) && (k) < hi)
#endif
#ifdef BAR_PROBE
#define SEAM(k) do { if (IN(k) && IN((k) + 1)) { const unsigned long long t0_ = __builtin_amdgcn_s_memrealtime(); xcd_barrier(bar); bar_ticks += __builtin_amdgcn_s_memrealtime() - t0_; } } while (0)
#elif defined(DOUBLE_BARRIER)
#define SEAM(k) do { if (IN(k) && IN((k) + 1)) { xcd_barrier(bar); xcd_barrier(bar); } } while (0)
#else
#define SEAM(k) do { if (IN(k) && IN((k) + 1)) xcd_barrier(bar); } while (0)
#endif
    PG8_LAS unsigned char* gl = (PG8_LAS unsigned char*)F.lds;
    if (IN(0)) for (int rep = (int)((dupm >> (0)) & 1ull); rep >= 0; --rep) { const Ctx c{*kargs()}; p0_prologue(c, F); } SEAM(0);
    { constexpr int l = 0; constexpr int b0 = 1 + 9 * l;
        if (IN(b0)) for (int rep = (int)((dupm >> (b0)) & 1ull); rep >= 0; --rep) { const Ctx c{*kargs()}; SchedDense S{(const char*)c.xb(), (const char*)(c.w_retin() + (size_t)l * 6 * D_MODEL * D_MODEL), D_MODEL, D_MODEL, NPAN, 24, 16, opq_s(G), opq_s(cu)}; EpiRetIn E{&c, (lds_b*)(F.lds + 131072), rep != 0 && (p.dup >> 40) != 0}; pg8::gemm_phase<EpiRetIn, SchedDense, GEMM_ALIGN>(gl, D_MODEL, D_MODEL, S, E); { const int tl = (NPAN * 24) % G, q = xcd_slot(cu, G); if (q >= tl) sel_convert_items(c, F, l * SEL_EARLY, (l + 1) * SEL_EARLY, (q - tl) * NWAVES + F.wave, (G - tl) * NWAVES); } } SEAM(b0);
        if (IN(b0 + 1)) for (int rep = (int)((dupm >> (b0 + 1)) & 1ull); rep >= 0; --rep) { const Ctx c{*kargs()}; { SchedPKV S{&c, opq_s(G), opq_s(cu), 0}; EpiP E{&c}; pg8::gemm_phase(gl, 4 * CATK, 1024, S, E); }
                          { SchedPKV S{&c, opq_s(G), opq_s(cu), 1}; EpiKV E{&c}; pg8::gemm_phase(gl, CATK, SEQ, S, E); }
                          ph_ret_sample(c, F, l); } SEAM(b0 + 1);
        if (IN(b0 + 2)) for (int rep = (int)((dupm >> (b0 + 2)) & 1ull); rep >= 0; --rep) { const Ctx c{*kargs()}; ph_ret_scan(c, F, l); ph_gate_sample(c, F); } SEAM(b0 + 2);
        if (IN(b0 + 3)) for (int rep = (int)((dupm >> (b0 + 3)) & 1ull); rep >= 0; --rep) { const Ctx c{*kargs()}; SchedOut S{&c, opq_s(G), opq_s(cu)}; EpiOut E{&c}; pg8::gemm_phase(gl, 4 * CATK, CATK, S, E); ph_gate_own(c, F); } SEAM(b0 + 3);
        if (IN(b0 + 5)) for (int rep = (int)((dupm >> (b0 + 5)) & 1ull); rep >= 0; --rep) { const Ctx c{*kargs()}; SchedResSplit S{(const char*)c.g(), (const char*)(c.w_retout() + (size_t)l * 2 * D_MODEL * D_MODEL), 2 * D_MODEL, 32, opq_s(G), opq_s(cu)}; EpiRes E{&c, rep != 0, false}; pg8::gemm_phase(gl, 2 * D_MODEL, 2 * D_MODEL, S, E); xcd_barrier(bar); ph_fix_sample(c, F, rep != 0, false); } SEAM(b0 + 5);
        if (IN(b0 + 6)) for (int rep = (int)((dupm >> (b0 + 6)) & 1ull); rep >= 0; --rep) { const Ctx c{*kargs()}; SchedFfnIn S{(const char*)c.xb(), (const char*)(c.w_ffnin() + (size_t)l * 2 * D_FF * D_MODEL), opq_s(G), opq_s(cu)}; EpiFfnIn E{&c, l, (lds_b*)(F.lds + 131072)}; pg8::gemm_phase<EpiFfnIn, SchedFfnIn, true>(gl, D_MODEL, D_MODEL, S, E); } SEAM(b0 + 6);
        if (IN(b0 + 8)) for (int rep = (int)((dupm >> (b0 + 8)) & 1ull); rep >= 0; --rep) { const Ctx c{*kargs()}; SchedResSplit S{(const char*)c.act(), (const char*)(c.w_ffnout() + (size_t)l * D_FF * D_MODEL), D_FF, D_FF / 64, opq_s(G), opq_s(cu)}; EpiRes E{&c, rep != 0, l == DEPTH - 1}; pg8::gemm_phase(gl, D_FF, D_FF, S, E); xcd_barrier(bar); ph_fix_sample(c, F, rep != 0, l == DEPTH - 1); } SEAM(b0 + 8);
        }
    { constexpr int l = 1; constexpr int b0 = 1 + 9 * l;
        if (IN(b0)) for (int rep = (int)((dupm >> (b0)) & 1ull); rep >= 0; --rep) { const Ctx c{*kargs()}; SchedDense S{(const char*)c.xb(), (const char*)(c.w_retin() + (size_t)l * 6 * D_MODEL * D_MODEL), D_MODEL, D_MODEL, NPAN, 24, 16, opq_s(G), opq_s(cu)}; EpiRetIn E{&c, (lds_b*)(F.lds + 131072), rep != 0 && (p.dup >> 40) != 0}; pg8::gemm_phase<EpiRetIn, SchedDense, GEMM_ALIGN>(gl, D_MODEL, D_MODEL, S, E); { const int tl = (NPAN * 24) % G, q = xcd_slot(cu, G); if (q >= tl) sel_convert_items(c, F, l * SEL_EARLY, (l + 1) * SEL_EARLY, (q - tl) * NWAVES + F.wave, (G - tl) * NWAVES); } } SEAM(b0);
        if (IN(b0 + 1)) for (int rep = (int)((dupm >> (b0 + 1)) & 1ull); rep >= 0; --rep) { const Ctx c{*kargs()}; { SchedPKV S{&c, opq_s(G), opq_s(cu), 0}; EpiP E{&c}; pg8::gemm_phase(gl, 4 * CATK, 1024, S, E); }
                          { SchedPKV S{&c, opq_s(G), opq_s(cu), 1}; EpiKV E{&c}; pg8::gemm_phase(gl, CATK, SEQ, S, E); }
                          ph_ret_sample(c, F, l); } SEAM(b0 + 1);
        if (IN(b0 + 2)) for (int rep = (int)((dupm >> (b0 + 2)) & 1ull); rep >= 0; --rep) { const Ctx c{*kargs()}; ph_ret_scan(c, F, l); ph_gate_sample(c, F); } SEAM(b0 + 2);
        if (IN(b0 + 3)) for (int rep = (int)((dupm >> (b0 + 3)) & 1ull); rep >= 0; --rep) { const Ctx c{*kargs()}; SchedOut S{&c, opq_s(G), opq_s(cu)}; EpiOut E{&c}; pg8::gemm_phase(gl, 4 * CATK, CATK, S, E); ph_gate_own(c, F); } SEAM(b0 + 3);
        if (IN(b0 + 5)) for (int rep = (int)((dupm >> (b0 + 5)) & 1ull); rep >= 0; --rep) { const Ctx c{*kargs()}; SchedResSplit S{(const char*)c.g(), (const char*)(c.w_retout() + (size_t)l * 2 * D_MODEL * D_MODEL), 2 * D_MODEL, 32, opq_s(G), opq_s(cu)}; EpiRes E{&c, rep != 0, false}; pg8::gemm_phase(gl, 2 * D_MODEL, 2 * D_MODEL, S, E); xcd_barrier(bar); ph_fix_sample(c, F, rep != 0, false); } SEAM(b0 + 5);
        if (IN(b0 + 6)) for (int rep = (int)((dupm >> (b0 + 6)) & 1ull); rep >= 0; --rep) { const Ctx c{*kargs()}; SchedFfnIn S{(const char*)c.xb(), (const char*)(c.w_ffnin() + (size_t)l * 2 * D_FF * D_MODEL), opq_s(G), opq_s(cu)}; EpiFfnIn E{&c, l, (lds_b*)(F.lds + 131072)}; pg8::gemm_phase<EpiFfnIn, SchedFfnIn, true>(gl, D_MODEL, D_MODEL, S, E); } SEAM(b0 + 6);
        if (IN(b0 + 8)) for (int rep = (int)((dupm >> (b0 + 8)) & 1ull); rep >= 0; --rep) { const Ctx c{*kargs()}; SchedResSplit S{(const char*)c.act(), (const char*)(c.w_ffnout() + (size_t)l * D_FF * D_MODEL), D_FF, D_FF / 64, opq_s(G), opq_s(cu)}; EpiRes E{&c, rep != 0, l == DEPTH - 1}; pg8::gemm_phase(gl, D_FF, D_FF, S, E); xcd_barrier(bar); ph_fix_sample(c, F, rep != 0, l == DEPTH - 1); } SEAM(b0 + 8);
        }
    if (IN(PH_KVQG)) for (int rep = (int)((dupm >> (PH_KVQG)) & 1ull); rep >= 0; --rep) { const Ctx c{*kargs()}; { SchedDense S{(const char*)c.xb(), (const char*)c.w_kvqg(), D_MODEL, D_MODEL, NPAN, N_KVQG / 256, 16, opq_s(G), opq_s(cu)}; EpiKvqg E{&c, 0, 0}; pg8::gemm_phase(gl, D_MODEL, D_MODEL, S, E); }
                       ph_cmp_convert(c, F); } SEAM(PH_KVQG);
    if (IN(PH_CMPG)) for (int rep = (int)((dupm >> (PH_CMPG)) & 1ull); rep >= 0; --rep) { const Ctx c{*kargs()}; SchedCmp S{&c, opq_s(G), opq_s(cu)}; EpiCmp1 E{&c}; pg8::gemm_phase(gl, 1024, 1024, S, E); } SEAM(PH_CMPG);
    if (IN(PH_CMP2)) for (int rep = (int)((dupm >> (PH_CMP2)) & 1ull); rep >= 0; --rep) { const Ctx c{*kargs()};
#ifdef ABL21
        if (!(rep && ABL21 == 1)) ph_cmp_stage2(c, F); if (!(rep && ABL21 == 2)) ph_sel_convert(c, F);
#else
        ph_cmp_stage2(c, F); ph_sel_convert(c, F);
#endif
    } SEAM(PH_CMP2);
    { constexpr int jq = 0; constexpr int l = N_A + jq, a0 = jq == 0 ? PH_ATT0 : PH_ATT1;
        if (jq == 1) { if (IN(PH_QG1)) for (int rep = (int)((dupm >> (PH_QG1)) & 1ull); rep >= 0; --rep) { const Ctx c{*kargs()}; SchedDense S{(const char*)c.xb(), (const char*)c.w_qg1(), D_MODEL, D_MODEL, NPAN, N_QG1 / 256, 16, opq_s(G), opq_s(cu)}; EpiKvqg E{&c, 6, 1}; pg8::gemm_phase(gl, D_MODEL, D_MODEL, S, E); } SEAM(PH_QG1); }
        if (IN(a0)) for (int rep = (int)((dupm >> (a0)) & 1ull); rep >= 0; --rep) { const Ctx c{*kargs()}; ph_attention(c, F, jq, rep); } SEAM(a0);
        if (IN(a0 + 1)) for (int rep = (int)((dupm >> (a0 + 1)) & 1ull); rep >= 0; --rep) { const Ctx c{*kargs()}; SchedResSplit S{(const char*)c.ao(), (const char*)(c.w_wo() + (size_t)jq * D_Q * D_MODEL), D_Q, 16, opq_s(G), opq_s(cu)}; EpiRes E{&c, rep != 0, false}; pg8::gemm_phase(gl, D_Q, D_Q, S, E); xcd_barrier(bar); ph_fix_sample(c, F, rep != 0, false); } SEAM(a0 + 1);
        if (IN(a0 + 2)) for (int rep = (int)((dupm >> (a0 + 2)) & 1ull); rep >= 0; --rep) { const Ctx c{*kargs()}; SchedFfnIn S{(const char*)c.xb(), (const char*)(c.w_ffnin() + (size_t)l * 2 * D_FF * D_MODEL), opq_s(G), opq_s(cu)}; EpiFfnIn E{&c, l, (lds_b*)(F.lds + 131072)}; pg8::gemm_phase<EpiFfnIn, SchedFfnIn, true>(gl, D_MODEL, D_MODEL, S, E); } SEAM(a0 + 2);
        if (IN(a0 + 4)) for (int rep = (int)((dupm >> (a0 + 4)) & 1ull); rep >= 0; --rep) { const Ctx c{*kargs()}; SchedResSplit S{(const char*)c.act(), (const char*)(c.w_ffnout() + (size_t)l * D_FF * D_MODEL), D_FF, D_FF / 64, opq_s(G), opq_s(cu)}; EpiRes E{&c, rep != 0, l == DEPTH - 1}; pg8::gemm_phase(gl, D_FF, D_FF, S, E); xcd_barrier(bar); ph_fix_sample(c, F, rep != 0, l == DEPTH - 1); } SEAM(a0 + 4);
        }
    { constexpr int jq = 1; constexpr int l = N_A + jq, a0 = jq == 0 ? PH_ATT0 : PH_ATT1;
        if (jq == 1) { if (IN(PH_QG1)) for (int rep = (int)((dupm >> (PH_QG1)) & 1ull); rep >= 0; --rep) { const Ctx c{*kargs()}; SchedDense S{(const char*)c.xb(), (const char*)c.w_qg1(), D_MODEL, D_MODEL, NPAN, N_QG1 / 256, 16, opq_s(G), opq_s(cu)}; EpiKvqg E{&c, 6, 1}; pg8::gemm_phase(gl, D_MODEL, D_MODEL, S, E); } SEAM(PH_QG1); }
        if (IN(a0)) for (int rep = (int)((dupm >> (a0)) & 1ull); rep >= 0; --rep) { const Ctx c{*kargs()}; ph_attention(c, F, jq, rep); } SEAM(a0);
        if (IN(a0 + 1)) for (int rep = (int)((dupm >> (a0 + 1)) & 1ull); rep >= 0; --rep) { const Ctx c{*kargs()}; SchedResSplit S{(const char*)c.ao(), (const char*)(c.w_wo() + (size_t)jq * D_Q * D_MODEL), D_Q, 16, opq_s(G), opq_s(cu)}; EpiRes E{&c, rep != 0, false}; pg8::gemm_phase(gl, D_Q, D_Q, S, E); xcd_barrier(bar); ph_fix_sample(c, F, rep != 0, false); } SEAM(a0 + 1);
        if (IN(a0 + 2)) for (int rep = (int)((dupm >> (a0 + 2)) & 1ull); rep >= 0; --rep) { const Ctx c{*kargs()}; SchedFfnIn S{(const char*)c.xb(), (const char*)(c.w_ffnin() + (size_t)l * 2 * D_FF * D_MODEL), opq_s(G), opq_s(cu)}; EpiFfnIn E{&c, l, (lds_b*)(F.lds + 131072)}; pg8::gemm_phase<EpiFfnIn, SchedFfnIn, true>(gl, D_MODEL, D_MODEL, S, E); } SEAM(a0 + 2);
        if (IN(a0 + 4)) for (int rep = (int)((dupm >> (a0 + 4)) & 1ull); rep >= 0; --rep) { const Ctx c{*kargs()}; SchedResSplit S{(const char*)c.act(), (const char*)(c.w_ffnout() + (size_t)l * D_FF * D_MODEL), D_FF, D_FF / 64, opq_s(G), opq_s(cu)}; EpiRes E{&c, rep != 0, l == DEPTH - 1}; pg8::gemm_phase(gl, D_FF, D_FF, S, E); xcd_barrier(bar); ph_fix_sample(c, F, rep != 0, l == DEPTH - 1); } SEAM(a0 + 4);
        }
#ifdef BAR_PROBE
    xcd_barrier(bar); if (blockIdx.x == BAR_PROBE && threadIdx.x == 0) p.out[O_YP] += 100.f * (float)(int)((float)bar_ticks * 0.0001f + 0.5f);
#endif
#undef IN
#undef SEAM
}
static_assert(PH_ATT0 + 5 == PH_QG1 && PH_ATT1 + 5 == NPH && 1 + 9 * N_A == PH_KVQG, "phase numbering");
static void opt_fill(OptP& p, void* const* d_in, float* out, unsigned char* ws) {
    p.x_prompt = (const float*)d_in[0]; p.x_sample = (const float*)d_in[1]; p.cache_cmp = (const float*)d_in[2]; p.cache_sel = (const float*)d_in[3]; p.cache_win = (const float*)d_in[4];
    p.state_ret = (const float*)d_in[5]; p.state_conv = (const float*)d_in[6]; p.page_table = (const int*)d_in[7]; p.norm_mix = (const float*)d_in[8]; p.norm_ffn = (const float*)d_in[9];
    p.ret_w_in = (const float*)d_in[10]; p.ret_w_out = (const float*)d_in[11]; p.ffn_w_in = (const float*)d_in[12]; p.ffn_conv_w = (const float*)d_in[13]; p.ffn_conv_b = (const float*)d_in[14];
    p.ffn_w_out = (const float*)d_in[15]; p.kv_norm = (const float*)d_in[16]; p.kv_w = (const float*)d_in[17]; p.kv_knorm = (const float*)d_in[18]; p.cmp_pos = (const float*)d_in[19];
    p.cmp_w1 = (const float*)d_in[20]; p.cmp_w2 = (const float*)d_in[21]; p.nsa_w_qg = (const float*)d_in[22]; p.nsa_qnorm = (const float*)d_in[23]; p.nsa_w_o = (const float*)d_in[24];
    p.out = out; p.ws = ws; p.ph_lo = 0; p.ph_hi = NPH;
}
static int opt_grid() {
    static int grid = 0;
    if (grid == 0) { int dev = 0, cus = 0, per_cu = 0;
        if (hipGetDevice(&dev) != hipSuccess || hipDeviceGetAttribute(&cus, hipDeviceAttributeMultiprocessorCount, dev) != hipSuccess) { grid = -1; return grid; }
        if (hipFuncSetAttribute((const void*)fwd, hipFuncAttributeMaxDynamicSharedMemorySize, MK_LDS) != hipSuccess) { fprintf(stderr, "hipFuncSetAttribute failed\n"); grid = -1; return grid; }
        if (hipOccupancyMaxActiveBlocksPerMultiprocessor(&per_cu, (const void*)fwd, MK_THREADS, MK_LDS) != hipSuccess || per_cu < 1) { fprintf(stderr, "occupancy query says %d\n", per_cu); grid = -1; return grid; }
        (void)hipGetLastError(); grid = cus; }
    return grid;
}
extern "C" void kernel_launch(void* const* d_in, const int* in_sizes, int n_in, void* d_out, int out_size, void* d_ws, size_t ws_size, hipStream_t stream) {
    const int grid = opt_grid();
    if (n_in != 25 || out_size != (int)O_END || ws_size < OW_END || grid < 0) { fprintf(stderr, "kernel_launch: sizes n_in %d out %d ws %zu need %zu grid %d\n", n_in, out_size, ws_size, (size_t)OW_END, grid); return; }
    OptP op; memset(&op, 0, sizeof(op)); opt_fill(op, d_in, (float*)d_out, (unsigned char*)d_ws);
#ifdef DUP_MASK
    op.dup = (long)(DUP_MASK);
#endif
    hipMemsetAsync((unsigned char*)d_ws + OW_CTL, 0, OW_CTL_BYTES, stream);
    hipLaunchKernelGGL(fwd, dim3(grid), dim3(MK_THREADS), MK_LDS, stream, op);
}
```

```cpp
#define OPT_ATTN
#define ROR_BPERMUTE 1
#include <hip/hip_runtime.h>
#include <cstdio>
#include <cstring>
#include <cmath>
#ifdef SMALL_CFG
constexpr int D_MODEL = 64, BATCH = 2, SEQ = 2048, DEC_BATCH = 3, DEC_SEQ = 8, PAST_LEN = 2048, N_HEADS = 8, N_KV = 2, HEAD_DIM = 32, CMP_HID = 16, D_FF = 96;
#else
constexpr int D_MODEL = 1024, BATCH = 2, SEQ = 8192, DEC_BATCH = 32, DEC_SEQ = 8, PAST_LEN = 8192, N_HEADS = 16, N_KV = 4, HEAD_DIM = 64, CMP_HID = 128, D_FF = 2816;
#endif
constexpr int DEPTH = 4, PAGE_SIZE = 128, N_A = 2, N_B = 2, RET_HEADS = 4, RET_DK = D_MODEL / RET_HEADS, RET_DV = 2 * D_MODEL / RET_HEADS, RET_CHUNK = 128;
constexpr int GROUP = N_HEADS / N_KV, CMP_LEN = 32, CMP_STRIDE = 16, SEL_BLOCK = 64, SEL_TOPK = 16, WINDOW = 512;
constexpr int D_Q = N_HEADS * HEAD_DIM, D_QG = D_Q + 3 * N_HEADS, D_KV = 6 * N_KV * HEAD_DIM, KVROW = 2 * N_KV * HEAD_DIM, KVH = N_KV * HEAD_DIM;
constexpr int NP = BATCH * SEQ, NS = DEC_BATCH * DEC_SEQ, NT = NP + NS, NSEQ = BATCH + DEC_BATCH;
constexpr int NCHP = SEQ / RET_CHUNK, NCH = BATCH * NCHP + DEC_BATCH;
constexpr int N_PAGES = PAST_LEN / PAGE_SIZE, WIN_BUF = (WINDOW < PAST_LEN ? WINDOW : PAST_LEN);
constexpr int NCMP = SEQ / CMP_STRIDE - 1;
static_assert((PAST_LEN + DEC_SEQ) / CMP_STRIDE - 1 == NCMP && PAST_LEN == SEQ, "both groups have the same compressed-block count");
constexpr int NSEL_P = SEQ / SEL_BLOCK, NSEL_S = (PAST_LEN + DEC_SEQ + SEL_BLOCK - 1) / SEL_BLOCK, NSEL_MAX = NSEL_S;
constexpr int WIN_P = (WINDOW < SEQ ? WINDOW : SEQ), WIN_S = (WINDOW < PAST_LEN + DEC_SEQ ? WINDOW : PAST_LEN + DEC_SEQ);
constexpr float EPS = 1e-6f, NEG_INF = -1e30f, TINY = 1e-30f, SEL_FORCE = 1e6f, SEL_NEG = -1e6f;
constexpr long O_YP = 0, O_YS = O_YP + (long)NP * D_MODEL, O_RETP = O_YS + (long)NS * D_MODEL, O_RETS = O_RETP + (long)N_A * BATCH * RET_HEADS * RET_DK * RET_DV,
    O_CONVP = O_RETS + (long)N_A * DEC_BATCH * RET_HEADS * RET_DK * RET_DV, O_CONVS = O_CONVP + (long)DEPTH * BATCH * 2 * D_FF, O_CMPP = O_CONVS + (long)DEPTH * DEC_BATCH * 2 * D_FF,
    O_CMPS = O_CMPP + (long)NP * KVROW, O_SELP = O_CMPS + (long)NS * KVROW, O_SELS = O_SELP + (long)NP * KVROW, O_WINP = O_SELS + (long)NS * KVROW,
    O_WINS = O_WINP + (long)BATCH * WIN_P * KVROW, O_END = O_WINS + (long)DEC_BATCH * WIN_S * KVROW;

struct NvP {
    const float *x_prompt, *x_sample, *cache_cmp, *cache_sel, *cache_win, *state_ret, *state_conv; const int* page_table;
    const float *norm_mix, *norm_ffn, *ret_w_in, *ret_w_out, *ffn_w_in, *ffn_conv_w, *ffn_conv_b, *ffn_w_out, *kv_norm, *kv_w, *kv_knorm, *cmp_pos, *cmp_w1, *cmp_w2, *nsa_w_qg, *nsa_qnorm, *nsa_w_o;
    float* out;
    float *x, *rstd, *h, *proj, *SB, *SC, *RO, *G, *act, *kv, *winbuf, *posb, *hid, *cmpk, *cmpv, *qc, *qr, *gates, *oc, *mc, *lc, *imp, *os, *ao; int* topi;
};
constexpr long cmax(long a, long b) { return a > b ? a : b; }
constexpr long NW_RSTD = 0, NW_H = NW_RSTD + NT, NW_PROJ = NW_H + (long)NT * D_MODEL, NW_ACT = NW_PROJ + (long)NT * cmax(6 * D_MODEL, 2 * D_FF), NW_UNION = NW_ACT + (long)NT * D_FF,
    NW_SB = NW_UNION, NW_SC = NW_SB + (long)NCH * RET_HEADS * RET_DK * RET_DV, NW_RO = NW_SC + (long)NCH * RET_HEADS * RET_CHUNK * RET_CHUNK, NW_G = NW_RO + (long)NT * 2 * D_MODEL, NW_A_END = NW_G + (long)NT * 2 * D_MODEL,
    NW_KV = NW_UNION, NW_WIN = NW_KV + (long)NT * D_KV, NW_POSB = NW_WIN + (long)NT * KVROW,
    NW_HID = NW_POSB + 2 * CMP_HID, NW_CMPK = NW_HID + (long)NSEQ * NCMP * 2 * N_KV * CMP_HID, NW_CMPV = NW_CMPK + (long)NSEQ * NCMP * KVH, NW_QC = NW_CMPV + (long)NSEQ * NCMP * KVH,
    NW_QR = NW_QC + (long)NT * D_Q, NW_GATES = NW_QR + (long)NT * D_Q, NW_OC = NW_GATES + (long)NT * 3 * N_HEADS, NW_MC = NW_OC + (long)NT * D_Q, NW_LC = NW_MC + (long)NT * N_HEADS,
    NW_IMP = NW_LC + (long)NT * N_HEADS, NW_OS = NW_IMP + (long)NT * N_KV * NSEL_MAX, NW_AO = NW_OS + (long)NT * D_Q, NW_TOPI = NW_AO + (long)NT * D_Q, NW_B_END = NW_TOPI + (long)NT * N_KV * SEL_TOPK,
    NW_END = ((cmax(NW_A_END, NW_B_END) + 1023) / 1024) * 1024;

struct Tok { int s, t, T, past, pos; };
__device__ __forceinline__ Tok tok_of(int r) {
    Tok k; if (r < NP) { k.s = r / SEQ; k.t = r % SEQ; k.T = SEQ; k.past = 0; k.pos = k.t; }
    else { int q = r - NP; k.s = BATCH + q / DEC_SEQ; k.t = q % DEC_SEQ; k.T = DEC_SEQ; k.past = PAST_LEN; k.pos = PAST_LEN + k.t; } return k; }
__device__ __forceinline__ int seq_row0(int s) { return s < BATCH ? s * SEQ : NP + (s - BATCH) * DEC_SEQ; }
__device__ __forceinline__ float nv_gelu(float x) { return 0.5f * x * (1.f + tanhf(0.7978845608028654f * (x + 0.044715f * x * x * x))); }
__device__ __forceinline__ float nv_silu(float x) { return x / (1.f + expf(-x)); }
__device__ __forceinline__ float nv_loggamma(int h) { return log1pf(-exp2f(-5.f - (float)h)); }
__device__ __forceinline__ float nv_ropefreq(int i, int half) { return expf(-9.210340371976184f * (float)i / (float)half); }
__device__ __forceinline__ void chunk_of(int c, int& s, int& row0, int& L) { if (c < BATCH * NCHP) { s = c / NCHP; row0 = s * SEQ + (c % NCHP) * RET_CHUNK; L = RET_CHUNK; } else { s = BATCH + (c - BATCH * NCHP); row0 = NP + (s - BATCH) * DEC_SEQ; L = DEC_SEQ; } }
__device__ __forceinline__ int chunk_of_row(int r) { return r < NP ? (r / SEQ) * NCHP + (r % SEQ) / RET_CHUNK : BATCH * NCHP + (r - NP) / DEC_SEQ; }
__device__ __forceinline__ const float* paged_row(const float* cache, const int* pt, int b, int p) { const int page = pt[b * N_PAGES + p / PAGE_SIZE]; return cache + ((long)page * PAGE_SIZE + p % PAGE_SIZE) * KVROW; }
__device__ __forceinline__ const float* cmp_row(const NvP& p, int s, int tok) { if (s < BATCH) return p.out + O_CMPP + ((long)s * SEQ + tok) * KVROW; const int b = s - BATCH; if (tok < PAST_LEN) return paged_row(p.cache_cmp, p.page_table, b, tok); return p.out + O_CMPS + ((long)b * DEC_SEQ + tok - PAST_LEN) * KVROW; }
__device__ __forceinline__ const float* sel_row(const NvP& p, int s, int tok) { if (s < BATCH) return p.out + O_SELP + ((long)s * SEQ + tok) * KVROW; const int b = s - BATCH; if (tok < PAST_LEN) return paged_row(p.cache_sel, p.page_table, b, tok); return p.out + O_SELS + ((long)b * DEC_SEQ + tok - PAST_LEN) * KVROW; }
__device__ __forceinline__ const float* win_row(const NvP& p, int s, int tok) { if (s < BATCH) return p.winbuf + ((long)s * SEQ + tok) * KVROW; const int b = s - BATCH; if (tok < PAST_LEN) return p.cache_win + ((long)b * WIN_BUF + (tok - (PAST_LEN - WIN_BUF))) * KVROW; return p.winbuf + ((long)NP + (long)b * DEC_SEQ + tok - PAST_LEN) * KVROW; }

#define GSL(i, n) for (long i = gtid; i < (long)(n); i += gsz)

__device__ void nv_init_x(const NvP& p, long gtid, long gsz) { GSL(i, (long)NT * D_MODEL) p.x[i] = i < (long)NP * D_MODEL ? p.x_prompt[i] : p.x_sample[i - (long)NP * D_MODEL]; }
__device__ void nv_rowstat(const NvP& p, long gtid, long gsz) { GSL(r, NT) { float ss = 0.f; for (int c = 0; c < D_MODEL; ++c) { float v = p.x[r * D_MODEL + c]; ss += v * v; } p.rstd[r] = 1.f / sqrtf(ss / D_MODEL + EPS); } }
__device__ void nv_norm(const NvP& p, const float* g, long gtid, long gsz) { GSL(i, (long)NT * D_MODEL) { long r = i / D_MODEL; int c = (int)(i % D_MODEL); p.h[i] = p.x[i] * p.rstd[r] * g[c]; } }
__device__ void nv_gemm(const float* A, const float* W, float* C, int M, int N, int K, bool accum, long gtid, long gsz) {
    const int nt = N / 8, mt = (M + 7) / 8;
    GSL(ti, (long)nt * mt) { const int m0 = (int)(ti / nt) * 8, n0 = (int)(ti % nt) * 8;
        float acc[8][8];
#pragma unroll
        for (int i = 0; i < 8; ++i)
#pragma unroll
            for (int j = 0; j < 8; ++j) acc[i][j] = 0.f;
        for (int k = 0; k < K; ++k) { float w[8];
#pragma unroll
            for (int j = 0; j < 8; ++j) w[j] = W[(long)k * N + n0 + j];
#pragma unroll
            for (int i = 0; i < 8; ++i) { const int m = m0 + i < M ? m0 + i : M - 1; const float a = A[(long)m * K + k];
#pragma unroll
                for (int j = 0; j < 8; ++j) acc[i][j] += a * w[j]; } }
#pragma unroll
        for (int i = 0; i < 8; ++i) if (m0 + i < M)
#pragma unroll
            for (int j = 0; j < 8; ++j) { float* c = C + (long)(m0 + i) * N + n0 + j; *c = accum ? *c + acc[i][j] : acc[i][j]; } }
}
__device__ void nv_ret_rope(const NvP& p, long gtid, long gsz) { constexpr int half = RET_DK / 2;
    GSL(i, (long)NT * 2 * RET_HEADS * half) { int ii = (int)(i % half); long q = i / half; int hh = (int)(q % RET_HEADS); q /= RET_HEADS; int which = (int)(q % 2); int r = (int)(q / 2);
        Tok tk = tok_of(r); float ang = (float)tk.pos * nv_ropefreq(ii, half), cs = cosf(ang), sn = sinf(ang);
        float* b = p.proj + (long)r * 6 * D_MODEL + which * D_MODEL + hh * RET_DK; float x1 = b[ii], x2 = b[ii + half]; float sc = which ? 1.f / sqrtf((float)RET_DK) : 1.f;
        b[ii] = (x1 * cs - x2 * sn) * sc; b[ii + half] = (x2 * cs + x1 * sn) * sc; } }
__device__ void nv_ret_kv(const NvP& p, long gtid, long gsz) {
    GSL(i, (long)NCH * RET_HEADS * RET_DK * RET_DV) { int e = (int)(i % RET_DV); long q = i / RET_DV; int d = (int)(q % RET_DK); q /= RET_DK; int hh = (int)(q % RET_HEADS); int c = (int)(q / RET_HEADS);
        int s, row0, L; chunk_of(c, s, row0, L); const float lg = nv_loggamma(hh); float acc = 0.f;
        for (int m = 0; m < L; ++m) { const float* pr = p.proj + (long)(row0 + m) * 6 * D_MODEL; acc += pr[D_MODEL + hh * RET_DK + d] * expf((float)(L - 1 - m) * lg) * pr[2 * D_MODEL + hh * RET_DV + e]; }
        p.SB[i] = acc; } }
__device__ void nv_ret_scan(const NvP& p, int layer, long gtid, long gsz) { constexpr long HS = (long)RET_HEADS * RET_DK * RET_DV;
    GSL(i, (long)NSEQ * HS) { int s = (int)(i / HS); long j = i % HS; int hh = (int)(j / ((long)RET_DK * RET_DV)); const float lg = nv_loggamma(hh);
        float S = s < BATCH ? 0.f : p.state_ret[((long)layer * DEC_BATCH + (s - BATCH)) * HS + j];
        int c0 = s < BATCH ? s * NCHP : BATCH * NCHP + (s - BATCH), nc = s < BATCH ? NCHP : 1, L = s < BATCH ? RET_CHUNK : DEC_SEQ; const float dec = expf((float)L * lg);
        for (int c = 0; c < nc; ++c) { float* sb = p.SB + (long)(c0 + c) * HS + j; float kvv = *sb; *sb = S; S = S * dec + kvv; }
        if (s < BATCH) p.out[O_RETP + ((long)layer * BATCH + s) * HS + j] = S; else p.out[O_RETS + ((long)layer * DEC_BATCH + (s - BATCH)) * HS + j] = S; } }
__device__ void nv_ret_scores(const NvP& p, long gtid, long gsz) {
    GSL(i, (long)NCH * RET_HEADS * RET_CHUNK * RET_CHUNK) { int m = (int)(i % RET_CHUNK); long q = i / RET_CHUNK; int l = (int)(q % RET_CHUNK); q /= RET_CHUNK; int hh = (int)(q % RET_HEADS); int c = (int)(q / RET_HEADS);
        int s, row0, L; chunk_of(c, s, row0, L); float v = 0.f;
        if (l < L && m <= l) { const float* ql = p.proj + (long)(row0 + l) * 6 * D_MODEL + hh * RET_DK; const float* km = p.proj + (long)(row0 + m) * 6 * D_MODEL + D_MODEL + hh * RET_DK;
            float acc = 0.f; for (int d = 0; d < RET_DK; ++d) acc += ql[d] * km[d]; v = acc * expf((float)(l - m) * nv_loggamma(hh)); }
        p.SC[i] = v; } }
__device__ void nv_ret_out(const NvP& p, long gtid, long gsz) {
    GSL(i, (long)NT * RET_HEADS * RET_DV) { int e = (int)(i % RET_DV); long q = i / RET_DV; int hh = (int)(q % RET_HEADS); int r = (int)(q / RET_HEADS);
        int c = chunk_of_row(r), s, row0, L; chunk_of(c, s, row0, L); int l = r - row0; const float lg = nv_loggamma(hh);
        const float* sc = p.SC + (((long)c * RET_HEADS + hh) * RET_CHUNK + l) * RET_CHUNK; float acc = 0.f;
        for (int m = 0; m <= l; ++m) acc += sc[m] * p.proj[(long)(row0 + m) * 6 * D_MODEL + 2 * D_MODEL + hh * RET_DV + e];
        const float* ql = p.proj + (long)r * 6 * D_MODEL + hh * RET_DK; const float* sb = p.SB + ((long)c * RET_HEADS + hh) * RET_DK * RET_DV + e; float a2 = 0.f;
        for (int d = 0; d < RET_DK; ++d) a2 += ql[d] * sb[(long)d * RET_DV];
        p.RO[i] = acc + a2 * expf((float)(l + 1) * lg); } }
__device__ void nv_ret_gate(const NvP& p, long gtid, long gsz) {
    GSL(i, (long)NT * RET_HEADS) { int hh = (int)(i % RET_HEADS); long r = i / RET_HEADS; const float* ro = p.RO + i * RET_DV; float ss = 0.f; for (int e = 0; e < RET_DV; ++e) ss += ro[e] * ro[e];
        const float rs = 1.f / sqrtf(ss / RET_DV + EPS); const float* g = p.proj + r * 6 * D_MODEL + 4 * D_MODEL + hh * RET_DV;
        for (int e = 0; e < RET_DV; ++e) p.G[i * RET_DV + e] = ro[e] * rs * nv_silu(g[e]); } }
__device__ void nv_conv(const NvP& p, int layer, long gtid, long gsz) {
    const float* cw = p.ffn_conv_w + (long)layer * 3 * D_FF; const float* cb = p.ffn_conv_b + (long)layer * D_FF;
    GSL(i, (long)NT * D_FF) { int f = (int)(i % D_FF); int r = (int)(i / D_FF); Tok tk = tok_of(r);
        const float* pr = p.proj + (long)r * 2 * D_FF; float u0 = pr[f];
        float um1, um2;
        const float* buf = tk.s < BATCH ? nullptr : p.state_conv + (((long)layer * DEC_BATCH + (tk.s - BATCH)) * 2) * D_FF;
        um1 = tk.t >= 1 ? pr[f - 2 * D_FF] : (buf ? buf[D_FF + f] : 0.f);
        um2 = tk.t >= 2 ? pr[f - 4 * D_FF] : (buf ? buf[(long)tk.t * D_FF + f] : 0.f);
        float c = cb[f] + cw[f] * um2 + cw[D_FF + f] * um1 + cw[2 * D_FF + f] * u0;
        p.act[i] = nv_gelu(c) * pr[D_FF + f];
        if (tk.t >= tk.T - 2) { int j = tk.t - (tk.T - 2); if (tk.s < BATCH) p.out[O_CONVP + (((long)layer * BATCH + tk.s) * 2 + j) * D_FF + f] = u0; else p.out[O_CONVS + (((long)layer * DEC_BATCH + (tk.s - BATCH)) * 2 + j) * D_FF + f] = u0; } } }
__device__ void nv_kv_post(const NvP& p, long gtid, long gsz) { constexpr int half = HEAD_DIM / 2;
    GSL(i, (long)NT * 3 * N_KV) { int kh = (int)(i % N_KV); long q = i / N_KV; int br = (int)(q % 3); int r = (int)(q / 3); Tok tk = tok_of(r);
        const float* kk = p.kv + (long)r * D_KV + (2 * br) * KVH + kh * HEAD_DIM; const float* vv = kk + KVH;
        float* dst; float* dst2 = nullptr;
        if (br == 0) dst = p.out + (r < NP ? O_CMPP + (long)r * KVROW : O_CMPS + (long)(r - NP) * KVROW);
        else if (br == 1) dst = p.out + (r < NP ? O_SELP + (long)r * KVROW : O_SELS + (long)(r - NP) * KVROW);
        else { dst = p.winbuf + (long)r * KVROW;
            if (tk.s < BATCH) { if (tk.t >= SEQ - WIN_P) dst2 = p.out + O_WINP + ((long)tk.s * WIN_P + (tk.t - (SEQ - WIN_P))) * KVROW; }
            else dst2 = p.out + O_WINS + ((long)(tk.s - BATCH) * WIN_S + (WIN_S - DEC_SEQ + tk.t)) * KVROW; }
        float rs = 1.f; if (br != 0) { float ss = 0.f; _Pragma("unroll") for (int d = 0; d < HEAD_DIM; ++d) ss += kk[d] * kk[d]; rs = 1.f / sqrtf(ss / HEAD_DIM + EPS); }
        const float* gn = p.kv_knorm + br * HEAD_DIM;
        for (int d = 0; d < half; ++d) { float k1, k2;
            if (br == 0) { k1 = kk[d]; k2 = kk[d + half]; }
            else { float x1 = kk[d] * rs * gn[d], x2 = kk[d + half] * rs * gn[d + half]; float ang = (float)tk.pos * nv_ropefreq(d, half), cs = cosf(ang), sn = sinf(ang); k1 = x1 * cs - x2 * sn; k2 = x2 * cs + x1 * sn; }
            dst[kh * HEAD_DIM + d] = k1; dst[kh * HEAD_DIM + d + half] = k2; dst[KVH + kh * HEAD_DIM + d] = vv[d]; dst[KVH + kh * HEAD_DIM + d + half] = vv[d + half];
            if (dst2) { dst2[kh * HEAD_DIM + d] = k1; dst2[kh * HEAD_DIM + d + half] = k2; dst2[KVH + kh * HEAD_DIM + d] = vv[d]; dst2[KVH + kh * HEAD_DIM + d + half] = vv[d + half]; } } } }
__device__ void nv_win_copy(const NvP& p, long gtid, long gsz) { constexpr int keep = WIN_S - DEC_SEQ;
    GSL(i, (long)DEC_BATCH * keep * KVROW) { int c = (int)(i % KVROW); long q = i / KVROW; int j = (int)(q % keep); int b = (int)(q / keep);
        p.out[O_WINS + ((long)b * WIN_S + j) * KVROW + c] = p.cache_win[((long)b * WIN_BUF + (WIN_BUF - keep + j)) * KVROW + c]; } }
__device__ void nv_cmp_posb(const NvP& p, long gtid, long gsz) { GSL(i, 2 * CMP_HID) { int hh = (int)(i % CMP_HID), c = (int)(i / CMP_HID); float acc = 0.f;
        for (int ld = 0; ld < CMP_LEN * HEAD_DIM; ++ld) acc += p.cmp_pos[(long)c * CMP_LEN * HEAD_DIM + ld] * p.cmp_w1[((long)c * CMP_LEN * HEAD_DIM + ld) * CMP_HID + hh]; p.posb[i] = acc; } }
__device__ void nv_cmp_hid(const NvP& p, long gtid, long gsz) {
    GSL(i, (long)NSEQ * NCMP * 2 * N_KV * CMP_HID) { int hh = (int)(i % CMP_HID); long q = i / CMP_HID; int kh = (int)(q % N_KV); q /= N_KV; int c = (int)(q % 2); q /= 2; int n = (int)(q % NCMP); int s = (int)(q / NCMP);
        float acc = p.posb[c * CMP_HID + hh];
        for (int l = 0; l < CMP_LEN; ++l) { const float* row = cmp_row(p, s, n * CMP_STRIDE + l) + c * KVH + kh * HEAD_DIM; const float* w = p.cmp_w1 + ((long)c * CMP_LEN * HEAD_DIM + (long)l * HEAD_DIM) * CMP_HID + hh;
            _Pragma("unroll") for (int d = 0; d < HEAD_DIM; ++d) acc += row[d] * w[(long)d * CMP_HID]; }
        p.hid[i] = nv_gelu(acc); } }
__device__ void nv_cmp_out(const NvP& p, long gtid, long gsz) {
    GSL(i, (long)NSEQ * NCMP * 2 * N_KV) { int kh = (int)(i % N_KV); long q = i / N_KV; int c = (int)(q % 2); long sn = q / 2; const float* hd = p.hid + i * CMP_HID; float o[HEAD_DIM];
        _Pragma("unroll") for (int d = 0; d < HEAD_DIM; ++d) o[d] = 0.f;
        for (int hh = 0; hh < CMP_HID; ++hh) { const float hv = hd[hh]; const float* w = p.cmp_w2 + ((long)c * CMP_HID + hh) * HEAD_DIM; _Pragma("unroll") for (int d = 0; d < HEAD_DIM; ++d) o[d] += hv * w[d]; }
        if (c == 0) { float ss = 0.f; _Pragma("unroll") for (int d = 0; d < HEAD_DIM; ++d) ss += o[d] * o[d]; const float rs = 1.f / sqrtf(ss / HEAD_DIM + EPS); _Pragma("unroll") for (int d = 0; d < HEAD_DIM; ++d) p.cmpk[(sn * N_KV + kh) * HEAD_DIM + d] = o[d] * rs * p.kv_knorm[d]; }
        else _Pragma("unroll") for (int d = 0; d < HEAD_DIM; ++d) p.cmpv[(sn * N_KV + kh) * HEAD_DIM + d] = o[d]; } }
__device__ void nv_q_post(const NvP& p, int j, long gtid, long gsz) { constexpr int half = HEAD_DIM / 2; const float* gn = p.nsa_qnorm + (long)j * HEAD_DIM;
    GSL(i, (long)NT * N_HEADS) { int hd = (int)(i % N_HEADS); int r = (int)(i / N_HEADS); Tok tk = tok_of(r); const float* qq = p.proj + (long)r * D_QG + hd * HEAD_DIM;
        float ss = 0.f; _Pragma("unroll") for (int d = 0; d < HEAD_DIM; ++d) ss += qq[d] * qq[d]; const float rs = 1.f / sqrtf(ss / HEAD_DIM + EPS);
        for (int d = 0; d < half; ++d) { float x1 = qq[d] * rs * gn[d], x2 = qq[d + half] * rs * gn[d + half]; float ang = (float)tk.pos * nv_ropefreq(d, half), cs = cosf(ang), sn = sinf(ang);
            p.qc[i * HEAD_DIM + d] = x1; p.qc[i * HEAD_DIM + d + half] = x2; p.qr[i * HEAD_DIM + d] = x1 * cs - x2 * sn; p.qr[i * HEAD_DIM + d + half] = x2 * cs + x1 * sn; }
        for (int g = 0; g < 3; ++g) p.gates[i * 3 + g] = 1.f / (1.f + expf(-p.proj[(long)r * D_QG + D_Q + hd * 3 + g])); } }
__device__ __forceinline__ int n_cmp_valid(int pos) { int n = pos - (CMP_LEN - 1); if (n < 0) return 0; n = n / CMP_STRIDE + 1; return n < NCMP ? n : NCMP; }
__device__ void nv_nsa_cmp(const NvP& p, long gtid, long gsz) { const float scale = 1.f / sqrtf((float)HEAD_DIM);
    GSL(i, (long)NT * N_HEADS) { int hd = (int)(i % N_HEADS); int r = (int)(i / N_HEADS); Tok tk = tok_of(r); const int kh = hd / GROUP, nc = n_cmp_valid(tk.pos);
        const float* q = p.qc + i * HEAD_DIM; const float* K = p.cmpk + ((long)tk.s * NCMP * N_KV + kh) * HEAD_DIM; const float* V = p.cmpv + ((long)tk.s * NCMP * N_KV + kh) * HEAD_DIM;
        float m = NEG_INF; for (int n = 0; n < nc; ++n) { float a = 0.f; _Pragma("unroll") for (int d = 0; d < HEAD_DIM; ++d) a += q[d] * K[(long)n * KVH + d]; a *= scale; m = a > m ? a : m; }
        float l = 0.f, o[HEAD_DIM]; _Pragma("unroll") for (int d = 0; d < HEAD_DIM; ++d) o[d] = 0.f;
        for (int n = 0; n < nc; ++n) { float a = 0.f; _Pragma("unroll") for (int d = 0; d < HEAD_DIM; ++d) a += q[d] * K[(long)n * KVH + d]; const float e = expf(a * scale - m); l += e; _Pragma("unroll") for (int d = 0; d < HEAD_DIM; ++d) o[d] += e * V[(long)n * KVH + d]; }
        const float inv = 1.f / (l > TINY ? l : TINY); _Pragma("unroll") for (int d = 0; d < HEAD_DIM; ++d) p.oc[i * HEAD_DIM + d] = o[d] * inv; p.mc[i] = m; p.lc[i] = l; } }
__device__ void nv_nsa_imp(const NvP& p, long gtid, long gsz) { const float scale = 1.f / sqrtf((float)HEAD_DIM);
    GSL(i, (long)NT * N_KV * NSEL_MAX) { int sb = (int)(i % NSEL_MAX); long q = i / NSEL_MAX; int kh = (int)(q % N_KV); int r = (int)(q / N_KV); Tok tk = tok_of(r); const int nc = n_cmp_valid(tk.pos);
        const int nsel = tk.s < BATCH ? NSEL_P : NSEL_S; float v;
        if (sb >= nsel) v = -3e6f;
        else { const int cur = tk.pos / SEL_BLOCK;
            if (sb == 0 || sb == cur || sb == cur - 1) v = SEL_FORCE; else if (sb * SEL_BLOCK > tk.pos) v = SEL_NEG;
            else { float acc = 0.f; const float* K = p.cmpk + ((long)tk.s * NCMP * N_KV + kh) * HEAD_DIM;
                for (int n = 4 * sb - 1; n <= 4 * sb + 3; ++n) { if (n < 0 || n >= nc) continue;
                    int lo = n * CMP_STRIDE > sb * SEL_BLOCK ? n * CMP_STRIDE : sb * SEL_BLOCK, hi = n * CMP_STRIDE + CMP_LEN < (sb + 1) * SEL_BLOCK ? n * CMP_STRIDE + CMP_LEN : (sb + 1) * SEL_BLOCK; if (hi <= lo) continue; const float w = (float)(hi - lo) / CMP_LEN;
                    for (int g = 0; g < GROUP; ++g) { const int hd = kh * GROUP + g; const float* qq = p.qc + ((long)r * N_HEADS + hd) * HEAD_DIM; float a = 0.f; _Pragma("unroll") for (int d = 0; d < HEAD_DIM; ++d) a += qq[d] * K[(long)n * KVH + d];
                        const float l = p.lc[(long)r * N_HEADS + hd]; acc += w * expf(a * scale - p.mc[(long)r * N_HEADS + hd]) / (l > TINY ? l : TINY); } }
                v = acc; } }
        p.imp[i] = v; } }
__device__ void nv_nsa_topk(const NvP& p, long gtid, long gsz) {
    GSL(i, (long)NT * N_KV) { int r = (int)(i / N_KV); Tok tk = tok_of(r); const int nsel = tk.s < BATCH ? NSEL_P : NSEL_S; const float* im = p.imp + i * NSEL_MAX; unsigned long long t0 = 0, t1 = 0, t2 = 0;
        for (int k = 0; k < SEL_TOPK; ++k) { float best = -4e6f; int bi = -1;
            for (int sb = 0; sb < nsel; ++sb) { const bool taken = sb < 64 ? (t0 >> sb) & 1 : sb < 128 ? (t1 >> (sb - 64)) & 1 : (t2 >> (sb - 128)) & 1; if (!taken && im[sb] > best) { best = im[sb]; bi = sb; } }
            if (bi >= 0) { if (bi < 64) t0 |= 1ull << bi; else if (bi < 128) t1 |= 1ull << (bi - 64); else t2 |= 1ull << (bi - 128); }
            p.topi[i * SEL_TOPK + k] = (bi >= 0 && best > 0.5f * SEL_NEG) ? bi : -1; } } }
__device__ void nv_nsa_sel(const NvP& p, long gtid, long gsz) { const float scale = 1.f / sqrtf((float)HEAD_DIM);
    GSL(i, (long)NT * N_HEADS) { int hd = (int)(i % N_HEADS); int r = (int)(i / N_HEADS); Tok tk = tok_of(r); const int kh = hd / GROUP; const float* q = p.qr + i * HEAD_DIM; const int* ti = p.topi + ((long)r * N_KV + kh) * SEL_TOPK;
        float m = NEG_INF;
        for (int k = 0; k < SEL_TOPK; ++k) { const int sb = ti[k]; if (sb < 0) continue; for (int j = 0; j < SEL_BLOCK; ++j) { const int tok = sb * SEL_BLOCK + j; if (tok > tk.pos) break; const float* kr = sel_row(p, tk.s, tok) + kh * HEAD_DIM; float a = 0.f; _Pragma("unroll") for (int d = 0; d < HEAD_DIM; ++d) a += q[d] * kr[d]; a *= scale; m = a > m ? a : m; } }
        float l = 0.f, o[HEAD_DIM]; _Pragma("unroll") for (int d = 0; d < HEAD_DIM; ++d) o[d] = 0.f;
        for (int k = 0; k < SEL_TOPK; ++k) { const int sb = ti[k]; if (sb < 0) continue; for (int j = 0; j < SEL_BLOCK; ++j) { const int tok = sb * SEL_BLOCK + j; if (tok > tk.pos) break; const float* kr = sel_row(p, tk.s, tok) + kh * HEAD_DIM; float a = 0.f; _Pragma("unroll") for (int d = 0; d < HEAD_DIM; ++d) a += q[d] * kr[d];
                const float e = expf(a * scale - m); l += e; const float* vr = kr + KVH; _Pragma("unroll") for (int d = 0; d < HEAD_DIM; ++d) o[d] += e * vr[d]; } }
        const float inv = 1.f / (l > TINY ? l : TINY); _Pragma("unroll") for (int d = 0; d < HEAD_DIM; ++d) p.os[i * HEAD_DIM + d] = o[d] * inv; } }
__device__ void nv_nsa_win(const NvP& p, long gtid, long gsz) { const float scale = 1.f / sqrtf((float)HEAD_DIM);
    GSL(i, (long)NT * N_HEADS) { int hd = (int)(i % N_HEADS); int r = (int)(i / N_HEADS); Tok tk = tok_of(r); const int kh = hd / GROUP; const float* q = p.qr + i * HEAD_DIM;
        int lo = tk.pos - WINDOW + 1; if (lo < 0) lo = 0; if (lo < tk.past - WIN_BUF) lo = tk.past - WIN_BUF;
        float m = NEG_INF; for (int tok = lo; tok <= tk.pos; ++tok) { const float* kr = win_row(p, tk.s, tok) + kh * HEAD_DIM; float a = 0.f; _Pragma("unroll") for (int d = 0; d < HEAD_DIM; ++d) a += q[d] * kr[d]; a *= scale; m = a > m ? a : m; }
        float l = 0.f, o[HEAD_DIM]; _Pragma("unroll") for (int d = 0; d < HEAD_DIM; ++d) o[d] = 0.f;
        for (int tok = lo; tok <= tk.pos; ++tok) { const float* kr = win_row(p, tk.s, tok) + kh * HEAD_DIM; float a = 0.f; _Pragma("unroll") for (int d = 0; d < HEAD_DIM; ++d) a += q[d] * kr[d]; const float e = expf(a * scale - m); l += e; const float* vr = kr + KVH; _Pragma("unroll") for (int d = 0; d < HEAD_DIM; ++d) o[d] += e * vr[d]; }
        const float inv = 1.f / (l > TINY ? l : TINY); const float* g = p.gates + i * 3;
        _Pragma("unroll") for (int d = 0; d < HEAD_DIM; ++d) p.ao[i * HEAD_DIM + d] = g[0] * p.oc[i * HEAD_DIM + d] + g[1] * p.os[i * HEAD_DIM + d] + g[2] * o[d] * inv; } }
enum NvPhase { NV_INIT, NV_ROWSTAT, NV_NORM_MIX, NV_NORM_FFN, NV_NORM_KV, NV_G_RETIN, NV_RET_ROPE, NV_RET_KV, NV_RET_SCAN, NV_RET_SCORES, NV_RET_OUT, NV_RET_GATE, NV_G_RETOUT, NV_G_FFNIN, NV_CONV, NV_G_FFNOUT,
    NV_G_KV, NV_KV_POST, NV_WIN_COPY, NV_CMP_POSB, NV_CMP_HID, NV_CMP_OUT, NV_G_QG, NV_Q_POST, NV_NSA_CMP, NV_NSA_IMP, NV_NSA_TOPK, NV_NSA_SEL, NV_NSA_WIN, NV_G_WO, NV_NPH };
__device__ void nv_dispatch(const NvP& p, int ph, int a, long gtid, long gsz) {
    switch (ph) {
    case NV_INIT: nv_init_x(p, gtid, gsz); break;
    case NV_ROWSTAT: nv_rowstat(p, gtid, gsz); break;
    case NV_NORM_MIX: nv_norm(p, p.norm_mix + (long)a * D_MODEL, gtid, gsz); break;
    case NV_NORM_FFN: nv_norm(p, p.norm_ffn + (long)a * D_MODEL, gtid, gsz); break;
    case NV_NORM_KV: nv_norm(p, p.kv_norm, gtid, gsz); break;
    case NV_G_RETIN: nv_gemm(p.h, p.ret_w_in + (long)a * D_MODEL * 6 * D_MODEL, p.proj, NT, 6 * D_MODEL, D_MODEL, false, gtid, gsz); break;
    case NV_RET_ROPE: nv_ret_rope(p, gtid, gsz); break;
    case NV_RET_KV: nv_ret_kv(p, gtid, gsz); break;
    case NV_RET_SCAN: nv_ret_scan(p, a, gtid, gsz); break;
    case NV_RET_SCORES: nv_ret_scores(p, gtid, gsz); break;
    case NV_RET_OUT: nv_ret_out(p, gtid, gsz); break;
    case NV_RET_GATE: nv_ret_gate(p, gtid, gsz); break;
    case NV_G_RETOUT: nv_gemm(p.G, p.ret_w_out + (long)a * 2 * D_MODEL * D_MODEL, p.x, NT, D_MODEL, 2 * D_MODEL, true, gtid, gsz); break;
    case NV_G_FFNIN: nv_gemm(p.h, p.ffn_w_in + (long)a * D_MODEL * 2 * D_FF, p.proj, NT, 2 * D_FF, D_MODEL, false, gtid, gsz); break;
    case NV_CONV: nv_conv(p, a, gtid, gsz); break;
    case NV_G_FFNOUT: nv_gemm(p.act, p.ffn_w_out + (long)a * D_FF * D_MODEL, p.x, NT, D_MODEL, D_FF, true, gtid, gsz); break;
    case NV_G_KV: nv_gemm(p.h, p.kv_w, p.kv, NT, D_KV, D_MODEL, false, gtid, gsz); break;
    case NV_KV_POST: nv_kv_post(p, gtid, gsz); break;
    case NV_WIN_COPY: nv_win_copy(p, gtid, gsz); break;
    case NV_CMP_POSB: nv_cmp_posb(p, gtid, gsz); break;
    case NV_CMP_HID: nv_cmp_hid(p, gtid, gsz); break;
    case NV_CMP_OUT: nv_cmp_out(p, gtid, gsz); break;
    case NV_G_QG: nv_gemm(p.h, p.nsa_w_qg + (long)a * D_MODEL * D_QG, p.proj, NT, D_QG, D_MODEL, false, gtid, gsz); break;
    case NV_Q_POST: nv_q_post(p, a, gtid, gsz); break;
    case NV_NSA_CMP: nv_nsa_cmp(p, gtid, gsz); break;
    case NV_NSA_IMP: nv_nsa_imp(p, gtid, gsz); break;
    case NV_NSA_TOPK: nv_nsa_topk(p, gtid, gsz); break;
    case NV_NSA_SEL: nv_nsa_sel(p, gtid, gsz); break;
    case NV_NSA_WIN: nv_nsa_win(p, gtid, gsz); break;
    case NV_G_WO: nv_gemm(p.ao, p.nsa_w_o + (long)a * D_Q * D_MODEL, p.x, NT, D_MODEL, D_Q, true, gtid, gsz); break;
    default: break; }
}
struct NvStep { int ph, a; };
template <class PT> __host__ __device__ inline int nv_program(PT st) { int n = 0;
#define S_(ph_, a_) do { st[n].ph = (ph_); st[n].a = (a_); ++n; } while (0)
    S_(NV_INIT, 0);
    for (int l = 0; l < DEPTH; ++l) {
        if (l == N_A) { S_(NV_ROWSTAT, 0); S_(NV_NORM_KV, 0); S_(NV_G_KV, 0); S_(NV_KV_POST, 0); S_(NV_WIN_COPY, 0); S_(NV_CMP_POSB, 0); S_(NV_CMP_HID, 0); S_(NV_CMP_OUT, 0); }
        S_(NV_ROWSTAT, 0); S_(NV_NORM_MIX, l);
        if (l < N_A) { S_(NV_G_RETIN, l); S_(NV_RET_ROPE, 0); S_(NV_RET_KV, 0); S_(NV_RET_SCAN, l); S_(NV_RET_SCORES, 0); S_(NV_RET_OUT, 0); S_(NV_RET_GATE, 0); S_(NV_G_RETOUT, l); }
        else { const int j = l - N_A; S_(NV_G_QG, j); S_(NV_Q_POST, j); S_(NV_NSA_CMP, 0); S_(NV_NSA_IMP, 0); S_(NV_NSA_TOPK, 0); S_(NV_NSA_SEL, 0); S_(NV_NSA_WIN, 0); S_(NV_G_WO, j); }
        S_(NV_ROWSTAT, 0); S_(NV_NORM_FFN, l); S_(NV_G_FFNIN, l); S_(NV_CONV, l); S_(NV_G_FFNOUT, l);
    }
#undef S_
    return n; }
static void nv_fill_params(NvP& p, void* const* d_in, float* out, float* ws) {
    p.x_prompt = (const float*)d_in[0]; p.x_sample = (const float*)d_in[1]; p.cache_cmp = (const float*)d_in[2]; p.cache_sel = (const float*)d_in[3]; p.cache_win = (const float*)d_in[4];
    p.state_ret = (const float*)d_in[5]; p.state_conv = (const float*)d_in[6]; p.page_table = (const int*)d_in[7]; p.norm_mix = (const float*)d_in[8]; p.norm_ffn = (const float*)d_in[9];
    p.ret_w_in = (const float*)d_in[10]; p.ret_w_out = (const float*)d_in[11]; p.ffn_w_in = (const float*)d_in[12]; p.ffn_conv_w = (const float*)d_in[13]; p.ffn_conv_b = (const float*)d_in[14];
    p.ffn_w_out = (const float*)d_in[15]; p.kv_norm = (const float*)d_in[16]; p.kv_w = (const float*)d_in[17]; p.kv_knorm = (const float*)d_in[18]; p.cmp_pos = (const float*)d_in[19];
    p.cmp_w1 = (const float*)d_in[20]; p.cmp_w2 = (const float*)d_in[21]; p.nsa_w_qg = (const float*)d_in[22]; p.nsa_qnorm = (const float*)d_in[23]; p.nsa_w_o = (const float*)d_in[24];
    p.out = out; p.x = out + O_YP;
    p.rstd = ws + NW_RSTD; p.h = ws + NW_H; p.proj = ws + NW_PROJ; p.SB = ws + NW_SB; p.SC = ws + NW_SC; p.RO = ws + NW_RO; p.G = ws + NW_G; p.act = ws + NW_ACT; p.kv = ws + NW_KV; p.winbuf = ws + NW_WIN;
    p.posb = ws + NW_POSB; p.hid = ws + NW_HID; p.cmpk = ws + NW_CMPK; p.cmpv = ws + NW_CMPV; p.qc = ws + NW_QC; p.qr = ws + NW_QR; p.gates = ws + NW_GATES; p.oc = ws + NW_OC; p.mc = ws + NW_MC; p.lc = ws + NW_LC;
    p.imp = ws + NW_IMP; p.os = ws + NW_OS; p.ao = ws + NW_AO; p.topi = (int*)(ws + NW_TOPI);
}
#define XB_TMO      128
#define XB_XCNT(j)  (256  + 64 * (j))
#define XB_XSUB(j)  (1280 + 64 * (j))
#define XB_XGEN(j)  (2304 + 64 * (j))
#define XB_TOP      3328
#define XB_TOPGEN   3392
#define XCD_BAR_WORDS 3456
#define XB_SPIN_CAP (1u << 18)
#define LAS __attribute__((address_space(3)))

__device__ __forceinline__ unsigned xb_ld(unsigned* p)              { return __hip_atomic_load(p, __ATOMIC_RELAXED, __HIP_MEMORY_SCOPE_AGENT); }
__device__ __forceinline__ unsigned xb_add(unsigned* p, unsigned v) { return __hip_atomic_fetch_add(p, v, __ATOMIC_RELAXED, __HIP_MEMORY_SCOPE_AGENT); }
__device__ __forceinline__ unsigned xb_xcc_id() { return (unsigned)__builtin_amdgcn_s_getreg((3 << 11) | 20) & 0xFu; }
#define XB_SPIN(cond, bar) do { unsigned _sp = 0; while (cond) { __builtin_amdgcn_s_sleep(1); \
    if ((++_sp & 255u) == 0u) { if (xb_ld(&(bar)[XB_TMO])) break; if (_sp > XB_SPIN_CAP) { atomicAdd(&(bar)[XB_TMO], 1u); break; } } } } while (0)

struct XcdBarrier {
    unsigned* bar; unsigned x;
    volatile LAS unsigned* st;
};

__device__ __forceinline__ XcdBarrier xcd_barrier_post(unsigned* bar, volatile LAS unsigned* st) {
    XcdBarrier b; b.bar = bar; b.x = xb_xcc_id(); b.st = st;
    if (threadIdx.x == 0) (void)xb_add(&bar[XB_XCNT(b.x)], 1u);
    return b;
}
__device__ __forceinline__ void xcd_barrier_complete(unsigned* bar, unsigned x, unsigned& nloc, unsigned& nx) {
    const unsigned G = gridDim.x * gridDim.y * gridDim.z;
    unsigned sum, cnt, mine, sp = 0u;
    for (;;) {
        sum = 0u; cnt = 0u; mine = 0u;
#pragma unroll
        for (unsigned j = 0; j < 16; ++j) { const unsigned c = xb_ld(&bar[XB_XCNT(j)]); sum += c; cnt += (c > 0u) ? 1u : 0u; mine = (j == x) ? c : mine; }
        if (sum == G) break;
        __builtin_amdgcn_s_sleep(1);
        if ((++sp & 255u) == 0u) { if (xb_ld(&bar[XB_TMO])) break; if (sp > XB_SPIN_CAP) { atomicAdd(&bar[XB_TMO], 1u); break; } }
    }
    nloc = mine > 0u ? mine : 1u; nx = cnt > 0u ? cnt : 1u;
}

__device__ __forceinline__ void xcd_barrier(const XcdBarrier& b) {
    asm volatile("s_waitcnt vmcnt(0)" ::: "memory");
    __syncthreads();
    if (threadIdx.x == 0) {
        unsigned* bar = b.bar;
        __builtin_amdgcn_s_waitcnt(0);
        unsigned nloc = b.st[0], nx = b.st[1];
        if (nloc == 0u) { xcd_barrier_complete(bar, b.x, nloc, nx); b.st[0] = nloc; b.st[1] = nx; }
        const unsigned old = xb_add(&bar[XB_XSUB(b.x)], 1u);
        const unsigned gen = old / nloc;
        if (old + 1u == (gen + 1u) * nloc) {
            __builtin_amdgcn_fence(__ATOMIC_RELEASE, "agent");
            asm volatile("s_waitcnt vmcnt(0)" ::: "memory");
            const unsigned og = xb_add(&bar[XB_TOP], 1u);
            const unsigned tg = og / nx;
            if (og + 1u == (tg + 1u) * nx) xb_add(&bar[XB_TOPGEN], 1u);
            else XB_SPIN(xb_ld(&bar[XB_TOPGEN]) == tg, bar);
            __builtin_amdgcn_fence(__ATOMIC_ACQUIRE, "agent");
            xb_add(&bar[XB_XGEN(b.x)], 1u);
            asm volatile("s_waitcnt vmcnt(0)" ::: "memory");
        } else {
            XB_SPIN(xb_ld(&bar[XB_XGEN(b.x)]) == gen, bar);
            __builtin_amdgcn_fence(__ATOMIC_ACQUIRE, "agent");
            asm volatile("s_waitcnt vmcnt(0)" ::: "memory");
        }
    }
    __syncthreads();
}
namespace pg8 {
#define PG8_LAS __attribute__((address_space(3)))
typedef unsigned short bf16_t;
typedef short bf16x8 __attribute__((ext_vector_type(8)));
typedef float f32x4 __attribute__((ext_vector_type(4)));
typedef float f32x2 __attribute__((ext_vector_type(2)));
typedef unsigned u32x4 __attribute__((ext_vector_type(4)));
typedef unsigned u32x2 __attribute__((ext_vector_type(2)));
constexpr int BM = 256, BK = 64, HALF = 128, HTB = HALF * BK * 2, STAGE_BYTES = 8 * HTB;
__host__ __device__ __forceinline__ int lds_byte(int r, int c) { const int st = (r >> 4) * 2 + (c >> 5), rr = r & 15, cc = c & 31, ob = rr * 64 + cc * 2; return st * 1024 + (ob ^ (((ob >> 9) & 1) << 5)); }
__host__ __device__ __forceinline__ void stage_rc(int b, int& R, int& C) { const int st = b / 1024, sb = b % 1024, swz = sb ^ (((sb >> 9) & 1) << 5); R = (st >> 1) * 16 + swz / 64; C = (st & 1) * 32 + (swz % 64) / 2; }
__host__ __device__ __forceinline__ int perm32(int rho) { const int n = rho >> 4, i = rho & 15; return 8 * (i >> 2) + 4 * n + (i & 3); }
struct Unit { int pm, pn, nt, aux; const char* A; const char* B; };
__device__ __forceinline__ unsigned cvt_pk_bf16(float lo, float hi) { unsigned r; asm volatile("v_cvt_pk_bf16_f32 %0, %1, %2" : "=v"(r) : "v"(lo), "v"(hi)); return r; }
template <class Epi, class Sched, bool ALIGN_EPI = true>
__device__ __forceinline__ void gemm_phase(PG8_LAS unsigned char* lds, const int lda, const int ldb, const Sched& S, const Epi& E) {
    int tid_ = threadIdx.x; asm volatile("" : "+v"(tid_));
    const int tid = tid_, wid = __builtin_amdgcn_readfirstlane(tid >> 6), lane = tid & 63, wr = wid >> 2, wc = wid & 3, fr = lane & 15, fq = lane >> 4;
    unsigned voffA[2], voffB[2];
#pragma unroll
    for (int i = 0; i < 2; ++i) { int R, C; stage_rc(tid * 16 + i * 8192, R, C); const int Rb = (R & ~31) + perm32(R & 31);
        voffA[i] = (unsigned)(R * lda + C) * 2u; voffB[i] = (unsigned)(Rb * ldb + C) * 2u; }
    const size_t kstep = (size_t)(BK * 2);
    const size_t hstepA = (size_t)HALF * lda * 2, hstepB = (size_t)HALF * ldb * 2;
    const unsigned ldsw = (unsigned)wid * 1024u;
    const int aoff = lds_byte(wr * 64 + fr, fq * 8), boff = lds_byte(wc * 32 + fr, fq * 8);
#define PG8_SA(b, h) (((b) * 2 + (h)) * HTB)
#define PG8_SB(b, h) ((4 + (b) * 2 + (h)) * HTB)
#define PG8_STAGE(bufoff, gbase, voff) do { _Pragma("unroll") for (int _i = 0; _i < 2; ++_i) \
        __builtin_amdgcn_global_load_lds((const unsigned*)((const char*)(gbase) + (voff)[_i]), (PG8_LAS unsigned*)(lds + (bufoff) + ldsw + _i * 8192), 16, 0, 0); } while (0)
#define PG8_LDA(dst, b, h) do { _Pragma("unroll") for (int m = 0; m < 4; ++m) _Pragma("unroll") for (int k = 0; k < 2; ++k) dst[m][k] = *(const PG8_LAS bf16x8*)(lds + PG8_SA(b, h) + aoff + m * 2048 + k * 1024); } while (0)
#define PG8_LDB(dst, b, h) do { _Pragma("unroll") for (int n = 0; n < 2; ++n) _Pragma("unroll") for (int k = 0; k < 2; ++k) dst[n][k] = *(const PG8_LAS bf16x8*)(lds + PG8_SB(b, h) + boff + n * 2048 + k * 1024); } while (0)
#define PG8_MMA(ai, bj, At, Bt) do { __builtin_amdgcn_s_setprio(1); _Pragma("unroll") for (int m = 0; m < 4; ++m) _Pragma("unroll") for (int n = 0; n < 2; ++n) _Pragma("unroll") for (int k = 0; k < 2; ++k) \
        acc[ai][bj][m][n] = __builtin_amdgcn_mfma_f32_16x16x32_bf16(Bt[n][k], At[m][k], acc[ai][bj][m][n], 0, 0, 0); __builtin_amdgcn_s_setprio(0); } while (0)
#define PG8_WAIT_V(n) asm volatile("s_waitcnt vmcnt(" #n ")" ::: "memory")
#define PG8_WAIT_L(n) asm volatile("s_waitcnt lgkmcnt(" #n ")" ::: "memory")
#define PG8_BAR __builtin_amdgcn_s_barrier()
#define PG8_SCHED __builtin_amdgcn_sched_barrier(0)
    Unit cur, nxt; int ui = 0;
    if (!S.next(0, cur)) return;
    f32x4 acc[2][2][4][2];
#pragma unroll
    for (int a = 0; a < 2; ++a)
#pragma unroll
        for (int b = 0; b < 2; ++b)
#pragma unroll
            for (int m = 0; m < 4; ++m)
#pragma unroll
                for (int n = 0; n < 2; ++n) acc[a][b][m][n] = (f32x4){0.f, 0.f, 0.f, 0.f};
    bf16x8 At[4][2], B0[2][2], B1[2][2];
    const char* cA = cur.A; const char* cB = cur.B;
    PG8_STAGE(PG8_SB(0, 0), cB, voffB); PG8_STAGE(PG8_SB(0, 1), cB + hstepB, voffB); PG8_STAGE(PG8_SA(0, 0), cA, voffA); PG8_STAGE(PG8_SA(0, 1), cA + hstepA, voffA);
    if (wr == 1) PG8_BAR;
    PG8_WAIT_V(2); PG8_BAR;
    PG8_STAGE(PG8_SB(1, 0), cB + kstep, voffB); PG8_STAGE(PG8_SA(1, 0), cA + kstep, voffA); PG8_STAGE(PG8_SB(1, 1), cB + hstepB + kstep, voffB);
    PG8_WAIT_V(6); PG8_BAR;
    for (;;) {
        const bool has_next = S.next(ui + 1, nxt);
        const char* nA = has_next ? nxt.A : cA; const char* nB = has_next ? nxt.B : cB;
        const int nt = cur.nt;
        for (int t = 0; t < nt; t += 2) {
            const bool last = (t == nt - 2);
            const char* a1 = cA + (size_t)(t + 1) * kstep;
            const char* a2 = last ? nA : cA + (size_t)(t + 2) * kstep; const char* b2 = last ? nB : cB + (size_t)(t + 2) * kstep;
            const char* a3 = a2 + kstep; const char* b3 = b2 + kstep;
            PG8_LDB(B0, 0, 0); PG8_LDB(B1, 0, 1); PG8_SCHED; PG8_LDA(At, 0, 0); PG8_STAGE(PG8_SA(1, 1), a1 + hstepA, voffA);
            PG8_WAIT_V(8); PG8_WAIT_L(0); PG8_BAR; PG8_MMA(0, 0, At, B0); PG8_MMA(0, 1, At, B1); PG8_BAR; PG8_SCHED;
            PG8_LDA(At, 0, 1); PG8_STAGE(PG8_SB(0, 0), b2, voffB); PG8_STAGE(PG8_SB(0, 1), b2 + hstepB, voffB); PG8_STAGE(PG8_SA(0, 0), a2, voffA);
            PG8_WAIT_V(8); PG8_WAIT_L(0); PG8_BAR; PG8_MMA(1, 0, At, B0); PG8_MMA(1, 1, At, B1); PG8_BAR; PG8_SCHED;
            PG8_LDB(B0, 1, 0); PG8_LDB(B1, 1, 1); PG8_SCHED; PG8_LDA(At, 1, 0); PG8_STAGE(PG8_SA(0, 1), a2 + hstepA, voffA);
            PG8_WAIT_V(8); PG8_WAIT_L(0); PG8_BAR; PG8_MMA(0, 0, At, B0); PG8_MMA(0, 1, At, B1); PG8_BAR; PG8_SCHED;
            PG8_LDA(At, 1, 1); PG8_STAGE(PG8_SB(1, 0), b3, voffB); PG8_STAGE(PG8_SB(1, 1), b3 + hstepB, voffB); PG8_STAGE(PG8_SA(1, 0), a3, voffA);
            PG8_WAIT_V(8); PG8_WAIT_L(0); PG8_BAR; PG8_MMA(1, 0, At, B0); PG8_MMA(1, 1, At, B1); PG8_BAR; PG8_SCHED;
        }
        if constexpr (ALIGN_EPI) { if (wr == 0) PG8_BAR; }
        E(acc, cur, wr, wc, fr, fq);
        if (!has_next) break;
#pragma unroll
        for (int a = 0; a < 2; ++a)
#pragma unroll
            for (int b = 0; b < 2; ++b)
#pragma unroll
                for (int m = 0; m < 4; ++m)
#pragma unroll
                    for (int n = 0; n < 2; ++n) acc[a][b][m][n] = (f32x4){0.f, 0.f, 0.f, 0.f};
        cur = nxt; cA = nA; cB = nB; ++ui;
        if constexpr (ALIGN_EPI) { if (wr == 1) PG8_BAR; }
    }
    PG8_WAIT_V(0);
    if constexpr (!ALIGN_EPI) { if (wr == 0) PG8_BAR; }
    PG8_BAR;
#undef PG8_SA
#undef PG8_SB
#undef PG8_STAGE
#undef PG8_LDA
#undef PG8_LDB
#undef PG8_MMA
#undef PG8_WAIT_V
#undef PG8_WAIT_L
#undef PG8_BAR
#undef PG8_SCHED
}
}
#define GAS __attribute__((address_space(1)))
typedef unsigned short bf16;
typedef float f32x4 __attribute__((ext_vector_type(4)));
typedef float f32x2 __attribute__((ext_vector_type(2)));
typedef unsigned u32x4 __attribute__((ext_vector_type(4)));
typedef unsigned u32x2 __attribute__((ext_vector_type(2)));
constexpr int NWAVES = 8, MK_THREADS = 512, MK_LDS = 151552;
constexpr int NPAN = NT / 256;
static_assert(NT % 256 == 0 && NP % 256 == 0 && NS == 256, "row panels");
constexpr int SCH = 512, NSCH = SEQ / SCH;
constexpr int CATK = RET_DK + SCH;
constexpr int N_KVQG = 2816, N_QG1 = 1280;
constexpr int ROPE_NPOS = PAST_LEN + DEC_SEQ;
constexpr int SELP = 8256;
constexpr int WINS = 544;
constexpr size_t MiB = 1u << 20;
constexpr size_t OW_CTL = 0, OW_CTL_BYTES = 1 * MiB;
constexpr size_t OW_WRETIN = 2 * MiB, OW_WRETOUT = 26 * MiB, OW_WFFNIN = 34 * MiB, OW_WFFNOUT = 78 * MiB, OW_WKVQG = 100 * MiB, OW_WQG1 = 106 * MiB, OW_WWO = 109 * MiB, OW_WCMP1 = 113 * MiB;
constexpr size_t OW_TABR = 114 * MiB, OW_TABN = 123 * MiB, OW_XB = 126 * MiB, OW_SSQ = 159 * MiB, OW_POSB = 161 * MiB;
constexpr size_t OW_CMPK = 162 * MiB, OW_CMPVT = 171 * MiB, OW_QC = 180 * MiB, OW_QR = 213 * MiB, OW_GATES = 246 * MiB, OW_AO = 250 * MiB;
constexpr size_t OW_SK = 283 * MiB, OW_SVT = 291 * MiB, OW_WK = 299 * MiB, OW_WVT = 307 * MiB, OW_WKS = 315 * MiB, OW_WVTS = 324 * MiB, OW_R1 = 334 * MiB;
constexpr size_t OW_QP = OW_R1, OW_KP = OW_QP + 33 * MiB, OW_ACAT = OW_KP + 33 * MiB, OW_BCAT = OW_ACAT + 96 * MiB, OW_KDT = OW_BCAT + 96 * MiB, OW_KVS = OW_KDT + 32 * MiB,
    OW_O = OW_KVS + 64 * MiB, OW_SG = OW_O + 65 * MiB, OW_G = OW_SG + 65 * MiB, OW_SQKV = OW_G + 65 * MiB, OW_RET_END = OW_SQKV + 4 * MiB;
constexpr size_t OW_U = OW_R1, OW_GT = OW_U + 90 * MiB, OW_ACT = OW_GT + 90 * MiB, OW_FFN_END = OW_ACT + 90 * MiB;
constexpr size_t OW_ASUB = OW_R1 + 270 * MiB, OW_PART = OW_ASUB + 272 * MiB, OW_CMP_END = OW_PART + 68 * MiB;
constexpr size_t OW_SPLITK = OW_R1 + 612 * MiB;
constexpr size_t OW_SKS = OW_SPLITK + 8 * MiB, OW_SVTS = OW_SKS + 130 * MiB, OW_SELS_END = OW_SVTS + 130 * MiB;
constexpr size_t OW_END = OW_SELS_END;
static_assert(OW_RET_END <= OW_END && OW_FFN_END <= OW_ASUB && OW_CMP_END <= OW_END && OW_SELS_END <= OW_END, "R1 map");
static_assert((size_t)2 * 6144 * 1024 * 2 <= OW_WRETOUT - OW_WRETIN && (size_t)4 * 5632 * 1024 * 2 <= OW_WFFNOUT - OW_WFFNIN && (size_t)4 * 1024 * 2816 * 2 <= OW_WKVQG - OW_WFFNOUT && (size_t)N_KVQG * 1024 * 2 <= OW_WQG1 - OW_WKVQG, "weight map");
static_assert((size_t)ROPE_NPOS * 128 * 8 <= OW_TABN - OW_TABR && (size_t)ROPE_NPOS * 32 * 8 <= OW_XB - OW_TABN && (size_t)NT * 1024 * 2 <= OW_SSQ - OW_XB && (size_t)NT * 16 * 4 <= OW_POSB - OW_SSQ, "map 2");
static_assert((size_t)NSEQ * 4 * 512 * 64 * 2 <= OW_CMPVT - OW_CMPK && (size_t)NT * 1024 * 2 <= OW_QR - OW_QC && (size_t)NT * 48 * 4 <= OW_AO - OW_GATES && (size_t)NT * 1024 * 2 <= OW_SK - OW_AO, "map 3");
static_assert((size_t)2 * 4 * 8192 * 64 * 2 <= OW_SVT - OW_SK && (size_t)32 * 4 * WINS * 64 * 2 <= OW_WVTS - OW_WKS && (size_t)32 * 4 * 64 * WINS * 2 <= OW_R1 - OW_WVTS, "map 4");
static_assert((size_t)NT * 1024 * 2 <= 33 * MiB && (size_t)NP * 4 * CATK * 2 <= 96 * MiB && (size_t)2 * 4 * 16 * 512 * CATK * 2 <= 96 * MiB && (size_t)NT * 2048 * 2 <= 65 * MiB && (size_t)NT * 2816 * 2 <= 90 * MiB, "map 5");
static_assert((size_t)8 * NSEQ * 512 * 1024 * 2 <= 272 * MiB && (size_t)8 * NSEQ * 512 * 256 * 2 <= 68 * MiB && (size_t)32 * 4 * SELP * 64 * 2 <= 130 * MiB, "map 6");

struct OptP {
    const float *x_prompt, *x_sample, *cache_cmp, *cache_sel, *cache_win, *state_ret, *state_conv; const int* page_table;
    const float *norm_mix, *norm_ffn, *ret_w_in, *ret_w_out, *ffn_w_in, *ffn_conv_w, *ffn_conv_b, *ffn_w_out, *kv_norm, *kv_w, *kv_knorm, *cmp_pos, *cmp_w1, *cmp_w2, *nsa_w_qg, *nsa_qnorm, *nsa_w_o;
    float* out; unsigned char* ws; const int* dbg_topi; long ph_lo, ph_hi, dup;
};
__device__ __forceinline__ int opq(int v) { asm volatile("" : "+v"(v)); return v; }
__device__ __forceinline__ int opq_s(int v) { asm volatile("" : "+s"(v)); return v; }
__device__ __forceinline__ size_t vtt_off(int tok, int d) { return (size_t)(tok >> 5) * 2048 + (size_t)d * 32 + (tok & 31); }
struct Frame { __attribute__((address_space(3))) unsigned char* lds; int tid, lane, wave, gw, ngw; };
__device__ __forceinline__ unsigned f2bf(float f) { unsigned u = __builtin_bit_cast(unsigned, f); return (u + 0x7fffu + ((u >> 16) & 1u)) >> 16; }
__device__ __forceinline__ unsigned pk2(float lo, float hi) { return f2bf(lo) | (f2bf(hi) << 16); }
__device__ __forceinline__ float bf2f(unsigned short b) { return __builtin_bit_cast(float, (unsigned)b << 16); }
__device__ __forceinline__ float bflo(unsigned w) { return __builtin_bit_cast(float, w << 16); }
__device__ __forceinline__ float bfhi(unsigned w) { return __builtin_bit_cast(float, w & 0xffff0000u); }
__device__ __forceinline__ float wave_sum(float v) {
#pragma unroll
    for (int o = 1; o < 64; o <<= 1) v += __shfl_xor(v, o);
    return v; }
__device__ __forceinline__ float gelu_tanh(float x) { const float u = x * (0.7978845608028654f + 0.035677408136300125f * x * x); const float e = __builtin_amdgcn_exp2f(u * 2.8853900817779268f); return x - x * __builtin_amdgcn_rcpf(e + 1.f); }
__device__ __forceinline__ float silu_f(float x) { return x * __builtin_amdgcn_rcpf(1.f + __builtin_amdgcn_exp2f(-1.4426950408889634f * x)); }
__device__ __forceinline__ float sigmoid_f(float x) { return 1.f / (1.f + __expf(-x)); }
__device__ __forceinline__ float log2gamma(int h) { return log2f(1.f - exp2f(-5.f - (float)h)); }
__device__ __forceinline__ float row_rstd(const float* ssq, int row) { const f32x4* p = (const f32x4*)(ssq + (size_t)row * 16); f32x4 a = p[0], b = p[1], c = p[2], d = p[3];
    const float s = ((a.x + a.y) + (a.z + a.w)) + ((b.x + b.y) + (b.z + b.w)) + ((c.x + c.y) + (c.z + c.w)) + ((d.x + d.y) + (d.z + d.w)); return 1.f / sqrtf(s * (1.f / D_MODEL) + EPS); }

__device__ __forceinline__ void wconv_item(const float* W, int N, const float* gain, bf16* dst, int ldk, int p0, int k0, int c0, int nvalid, __attribute__((address_space(3))) float* scr, int lane) {
    { const int col4 = (lane & 7) * 4; f32x4 v[8]; float gv[8];
#pragma unroll
      for (int i = 0; i < 8; ++i) { const int kk = i * 8 + (lane >> 3); v[i] = col4 < nvalid ? *(const f32x4*)(W + (size_t)(k0 + kk) * N + c0 + col4) : (f32x4){0.f, 0.f, 0.f, 0.f}; gv[i] = gain ? gain[k0 + kk] : 1.f; }
#pragma unroll
      for (int i = 0; i < 8; ++i) { const int kk = i * 8 + (lane >> 3); const f32x4 w = v[i] * gv[i]; scr[kk * 33 + col4] = w.x; scr[kk * 33 + col4 + 1] = w.y; scr[kk * 33 + col4 + 2] = w.z; scr[kk * 33 + col4 + 3] = w.w; } }
    asm volatile("s_waitcnt lgkmcnt(0)" ::: "memory");
    const int c = lane & 7;
#pragma unroll
    for (int j = 0; j < 4; ++j) { const int n = (lane >> 3) + 8 * j; const __attribute__((address_space(3))) float* s = scr + (8 * c) * 33 + n;
        u32x4 o; o.x = pk2(s[0 * 33], s[1 * 33]); o.y = pk2(s[2 * 33], s[3 * 33]); o.z = pk2(s[4 * 33], s[5 * 33]); o.w = pk2(s[6 * 33], s[7 * 33]);
        *(u32x4*)(dst + (size_t)(p0 + n) * ldk + k0 + 8 * c) = o; }
    asm volatile("s_waitcnt lgkmcnt(0)" ::: "memory");
}
struct WJob { const float* W; const float* gain; bf16* dst; int K, Ns, Nd, mode, head_rows, head_c0, tail_c0, ntail; };
__device__ __forceinline__ int wjob_items(const WJob& j) { return (j.Nd / 32) * (j.K / 64); }
__device__ __forceinline__ void wjob_run(const WJob& j, int item, __attribute__((address_space(3))) float* scr, int lane) {
    const int nkb = j.K / 64, pb = item / nkb, kb = item % nkb, p0 = pb * 32; int c0, nvalid = 32;
    if (j.mode == 0) c0 = p0;
    else if (j.mode == 2) { const int T = p0 / 256, cl = p0 % 256; c0 = cl < 128 ? 128 * T + cl : j.tail_c0 + 128 * T + (cl - 128); }
    else if (p0 < j.head_rows) { const int T = p0 / 256, cl = p0 % 256, bj = cl / 128, wc = (cl % 128) / 32; c0 = j.head_c0 + 64 * (4 * T + wc) + 32 * bj; }
    else { const int t = p0 - j.head_rows; c0 = j.tail_c0 + t; nvalid = j.ntail - t; if (nvalid > 32) nvalid = 32; if (nvalid < 0) nvalid = 0; }
    wconv_item(j.W, j.Ns, j.gain, j.dst, j.K, p0, kb * 64, c0, nvalid, scr, lane);
}
struct Ctx {
    const __attribute__((address_space(4))) OptP& p;
    __device__ __forceinline__ bf16* w_retin() const { return (bf16*)(p.ws + OW_WRETIN); }
    __device__ __forceinline__ bf16* w_retout() const { return (bf16*)(p.ws + OW_WRETOUT); }
    __device__ __forceinline__ bf16* w_ffnin() const { return (bf16*)(p.ws + OW_WFFNIN); }
    __device__ __forceinline__ bf16* w_ffnout() const { return (bf16*)(p.ws + OW_WFFNOUT); }
    __device__ __forceinline__ bf16* w_kvqg() const { return (bf16*)(p.ws + OW_WKVQG); }
    __device__ __forceinline__ bf16* w_qg1() const { return (bf16*)(p.ws + OW_WQG1); }
    __device__ __forceinline__ bf16* w_wo() const { return (bf16*)(p.ws + OW_WWO); }
    __device__ __forceinline__ bf16* w_cmp1() const { return (bf16*)(p.ws + OW_WCMP1); }
    __device__ __forceinline__ f32x2* tabr() const { return (f32x2*)(p.ws + OW_TABR); }
    __device__ __forceinline__ f32x2* tabn() const { return (f32x2*)(p.ws + OW_TABN); }
    __device__ __forceinline__ bf16* xb() const { return (bf16*)(p.ws + OW_XB); }
    __device__ __forceinline__ float* ssq() const { return (float*)(p.ws + OW_SSQ); }
    __device__ __forceinline__ float* posb() const { return (float*)(p.ws + OW_POSB); }
    __device__ __forceinline__ float* rstd() const { return (float*)(p.ws + OW_POSB + 65536); }
    __device__ __forceinline__ bf16* cmpk() const { return (bf16*)(p.ws + OW_CMPK); }
    __device__ __forceinline__ bf16* cmpvt() const { return (bf16*)(p.ws + OW_CMPVT); }
    __device__ __forceinline__ bf16* qc() const { return (bf16*)(p.ws + OW_QC); }
    __device__ __forceinline__ bf16* qr() const { return (bf16*)(p.ws + OW_QR); }
    __device__ __forceinline__ bf16* ao() const { return (bf16*)(p.ws + OW_AO); }
    __device__ __forceinline__ float* gates() const { return (float*)(p.ws + OW_GATES); }
    __device__ __forceinline__ bf16* sk() const { return (bf16*)(p.ws + OW_SK); }
    __device__ __forceinline__ bf16* svt() const { return (bf16*)(p.ws + OW_SVT); }
    __device__ __forceinline__ bf16* wk() const { return (bf16*)(p.ws + OW_WK); }
    __device__ __forceinline__ bf16* wvt() const { return (bf16*)(p.ws + OW_WVT); }
    __device__ __forceinline__ bf16* wks() const { return (bf16*)(p.ws + OW_WKS); }
    __device__ __forceinline__ bf16* wvts() const { return (bf16*)(p.ws + OW_WVTS); }
    __device__ __forceinline__ bf16* qp() const { return (bf16*)(p.ws + OW_QP); }
    __device__ __forceinline__ bf16* kp() const { return (bf16*)(p.ws + OW_KP); }
    __device__ __forceinline__ bf16* acat() const { return (bf16*)(p.ws + OW_ACAT); }
    __device__ __forceinline__ bf16* bcat() const { return (bf16*)(p.ws + OW_BCAT); }
    __device__ __forceinline__ bf16* kdt() const { return (bf16*)(p.ws + OW_KDT); }
    __device__ __forceinline__ bf16* o() const { return (bf16*)(p.ws + OW_O); }
    __device__ __forceinline__ bf16* sg() const { return (bf16*)(p.ws + OW_SG); }
    __device__ __forceinline__ bf16* g() const { return (bf16*)(p.ws + OW_G); }
    __device__ __forceinline__ float* kvs() const { return (float*)(p.ws + OW_KVS); }
    __device__ __forceinline__ float* sqkv() const { return (float*)(p.ws + OW_SQKV); }
    __device__ __forceinline__ bf16* u() const { return (bf16*)(p.ws + OW_U); }
    __device__ __forceinline__ bf16* gt() const { return (bf16*)(p.ws + OW_GT); }
    __device__ __forceinline__ bf16* act() const { return (bf16*)(p.ws + OW_ACT); }
    __device__ __forceinline__ bf16* asub() const { return (bf16*)(p.ws + OW_ASUB); }
    __device__ __forceinline__ bf16* part() const { return (bf16*)(p.ws + OW_PART); }
    __device__ __forceinline__ bf16* sks() const { return (bf16*)(p.ws + OW_SKS); }
    __device__ __forceinline__ bf16* svts() const { return (bf16*)(p.ws + OW_SVTS); }
    __device__ __forceinline__ float* x() const { return p.out + O_YP; }
};
__device__ __forceinline__ const __attribute__((address_space(4))) OptP* kargs() { unsigned long long v = (unsigned long long)__builtin_amdgcn_kernarg_segment_ptr(); asm volatile("" : "+s"(v)); return (const __attribute__((address_space(4))) OptP*)v; }
__device__ __forceinline__ int row_pos(int r) { return r < NP ? (r % SEQ) : PAST_LEN + ((r - NP) % DEC_SEQ); }

constexpr int NWJOBS = 21;
__device__ __forceinline__ void make_wjob(const Ctx& c, int j, WJob& w) {
    const auto& p = c.p; w.gain = nullptr; w.mode = 0; w.head_rows = 0; w.head_c0 = 0; w.tail_c0 = 0; w.ntail = 0;
    if (j < 2) { w.W = p.ret_w_in + (size_t)j * D_MODEL * 6 * D_MODEL; w.gain = p.norm_mix + j * D_MODEL; w.dst = c.w_retin() + (size_t)j * 6 * D_MODEL * D_MODEL; w.K = D_MODEL; w.Ns = 6 * D_MODEL; w.Nd = 6 * D_MODEL; }
    else if (j < 4) { const int l = j - 2; w.W = p.ret_w_out + (size_t)l * 2 * D_MODEL * D_MODEL; w.dst = c.w_retout() + (size_t)l * 2 * D_MODEL * D_MODEL; w.K = 2 * D_MODEL; w.Ns = D_MODEL; w.Nd = D_MODEL; }
    else if (j < 8) { const int l = j - 4; w.W = p.ffn_w_in + (size_t)l * D_MODEL * 2 * D_FF; w.gain = p.norm_ffn + l * D_MODEL; w.dst = c.w_ffnin() + (size_t)l * 2 * D_FF * D_MODEL; w.K = D_MODEL; w.Ns = 2 * D_FF; w.Nd = 2 * D_FF; w.mode = 2; w.tail_c0 = D_FF; }
    else if (j < 12) { const int l = j - 8; w.W = p.ffn_w_out + (size_t)l * D_FF * D_MODEL; w.dst = c.w_ffnout() + (size_t)l * D_FF * D_MODEL; w.K = D_FF; w.Ns = D_MODEL; w.Nd = D_MODEL; }
    else if (j == 12) { w.W = p.kv_w; w.gain = p.kv_norm; w.dst = c.w_kvqg(); w.K = D_MODEL; w.Ns = D_KV; w.Nd = D_KV; w.mode = 1; w.head_rows = D_KV; }
    else if (j < 15) { const int q = j - 13; w.W = p.nsa_w_qg + (size_t)q * D_MODEL * D_QG; w.gain = p.norm_mix + (2 + q) * D_MODEL; w.dst = q == 0 ? c.w_kvqg() + (size_t)D_KV * D_MODEL : c.w_qg1(); w.K = D_MODEL; w.Ns = D_QG; w.Nd = N_QG1;
        w.mode = 1; w.head_rows = D_Q; w.tail_c0 = D_Q; w.ntail = 3 * N_HEADS; }
    else if (j < 17) { const int q = j - 15; w.W = p.nsa_w_o + (size_t)q * D_Q * D_MODEL; w.dst = c.w_wo() + (size_t)q * D_Q * D_MODEL; w.K = D_Q; w.Ns = D_MODEL; w.Nd = D_MODEL; }
    else { const int q = j - 17, cc = q >> 1, r = q & 1; w.W = p.cmp_w1 + ((size_t)cc * 2048 + (size_t)r * 1024) * CMP_HID; w.dst = c.w_cmp1() + ((size_t)cc * 256 + r * 128) * 1024; w.K = 1024; w.Ns = CMP_HID; w.Nd = CMP_HID; }
}
__device__ __forceinline__ void p0_prologue(const Ctx& c, Frame F) { F.tid = opq((int)threadIdx.x); F.lane = F.tid & 63;
    __attribute__((address_space(3))) float* scr = (__attribute__((address_space(3))) float*)(F.lds + F.wave * 16384);
    int base = 0;
    for (int j = 0; j < NWJOBS; ++j) { WJob w; make_wjob(c, j, w); const int n = wjob_items(w);
        int it = F.gw - (base % F.ngw); if (it < 0) it += F.ngw;
        for (; it < n; it += F.ngw) wjob_run(w, it, scr, F.lane);
        base += n; }
    for (long i = (long)opq_s(F.gw) * 64 + opq(F.lane); i < (long)ROPE_NPOS * 160; i += (long)F.ngw * 64) { const int pos = (int)(i / 160), k = (int)(i % 160);
        if (k < 128) { const float inv = expf(-9.210340371976184f * (float)k / 128.f); const float ang = (float)pos * inv; c.tabr()[(size_t)pos * 128 + k] = (f32x2){cosf(ang), sinf(ang)}; }
        else { const int kk = k - 128; const float inv = expf(-9.210340371976184f * (float)kk / 32.f); const float ang = (float)pos * inv; c.tabn()[(size_t)pos * 32 + kk] = (f32x2){cosf(ang), sinf(ang)}; } }
    for (int r = opq_s(F.gw); r < NT; r += F.ngw) { const float* src = r < NP ? c.p.x_prompt + (size_t)r * D_MODEL : c.p.x_sample + (size_t)(r - NP) * D_MODEL;
        float s = 0.f;
#pragma unroll
        for (int j = 0; j < 4; ++j) { const f32x4 v = ((const f32x4*)src)[F.lane + 64 * j]; s += (v.x * v.x + v.y * v.y) + (v.z * v.z + v.w * v.w);
            u32x2 w; w.x = pk2(v.x, v.y); w.y = pk2(v.z, v.w); ((u32x2*)(c.xb() + (size_t)r * D_MODEL))[F.lane + 64 * j] = w; }
        s = wave_sum(s); if (F.lane < 16) c.ssq()[(size_t)r * 16 + F.lane] = F.lane == 0 ? s : 0.f; if (F.lane == 0) c.rstd()[r] = 1.f / sqrtf(s * (1.f / D_MODEL) + EPS); }
    for (int i = opq_s(F.gw); i < 2 * 32; i += F.ngw) { const int cc = i >> 5, j = i & 31; float a0 = 0.f, a1 = 0.f; const float* pp = c.p.cmp_pos + (size_t)cc * CMP_LEN * HEAD_DIM + j * 64; const float* w = c.p.cmp_w1 + ((size_t)cc * CMP_LEN * HEAD_DIM + j * 64) * CMP_HID + F.lane;
#pragma unroll 8
        for (int ld = 0; ld < 64; ++ld) { const float pv = pp[ld]; a0 += pv * w[(size_t)ld * CMP_HID]; a1 += pv * w[(size_t)ld * CMP_HID + 64]; }
        c.posb()[(size_t)i * CMP_HID + F.lane] = a0; c.posb()[(size_t)i * CMP_HID + 64 + F.lane] = a1; }
}

__device__ __forceinline__ int xcd_slot(int c, int G) { return (G & 7) ? c : (c & 7) * (G >> 3) + (c >> 3); }
struct SchedDense {
    const char* A; const char* B; int lda, ldb, nM, nN, nt, G, c;
    __device__ __forceinline__ bool next(int i, pg8::Unit& u) const { const int q = xcd_slot(c, G); const long L = (long)i * G + q; if (L >= (long)nM * nN) return false;
        const int grp = 4 * nN, gid = (int)(L / grp), fm = gid * 4, gsz = (nM - fm) < 4 ? (nM - fm) : 4, w = (int)(L % grp);
        u.pm = fm + w % gsz; u.pn = w / gsz; u.nt = nt; u.aux = 0; u.A = A + (size_t)u.pm * 256 * lda * 2; u.B = B + (size_t)u.pn * 256 * ldb * 2; return true; }
};
typedef const f32x4 (&AccRef)[2][2][4][2];
#define EPI_ROWS(ai, m) _Pragma("unroll") for (int ai = 0; ai < 2; ++ai) _Pragma("unroll") for (int m = 0; m < 4; ++m)
#ifdef EPI_NT
#define ST16(p_, v_) __builtin_nontemporal_store((v_), (u32x4*)(p_))
#else
#define ST16(p_, v_) (*(u32x4*)(p_) = (v_))
#endif
__device__ __forceinline__ u32x4 pack8(const f32x4 a, const f32x4 b) { u32x4 w; w.x = pg8::cvt_pk_bf16(a.x, a.y); w.y = pg8::cvt_pk_bf16(a.z, a.w); w.z = pg8::cvt_pk_bf16(b.x, b.y); w.w = pg8::cvt_pk_bf16(b.z, b.w); return w; }
__device__ __forceinline__ void store_t4(bf16* base, size_t pitch, const f32x4 v) { base[0] = (bf16)f2bf(v.x); base[pitch] = (bf16)f2bf(v.y); base[2 * pitch] = (bf16)f2bf(v.z); base[3 * pitch] = (bf16)f2bf(v.w); }

typedef __attribute__((address_space(3))) unsigned char lds_b;
__device__ __forceinline__ void tr_store32(lds_b* scr, const f32x4 (&v)[2][2], bf16* dst, size_t pitch, int fr, int fq) {
#pragma unroll
    for (int mh = 0; mh < 2; ++mh)
#pragma unroll
        for (int n = 0; n < 2; ++n) { lds_b* p = scr + (8 * fq + 4 * n) * 72 + (16 * mh + fr) * 2;
            *(__attribute__((address_space(3))) unsigned short*)(p) = (unsigned short)f2bf(v[mh][n].x); *(__attribute__((address_space(3))) unsigned short*)(p + 72) = (unsigned short)f2bf(v[mh][n].y);
            *(__attribute__((address_space(3))) unsigned short*)(p + 144) = (unsigned short)f2bf(v[mh][n].z); *(__attribute__((address_space(3))) unsigned short*)(p + 216) = (unsigned short)f2bf(v[mh][n].w); }
    asm volatile("s_waitcnt lgkmcnt(0)" ::: "memory");
    const int lane = fr + 16 * fq;
#pragma unroll
    for (int t = 0; t < 2; ++t) { const int q = lane + 64 * t, col = q >> 2, tc = q & 3; const lds_b* p = scr + col * 72 + tc * 16;
        const u32x2 a = *(const __attribute__((address_space(3))) u32x2*)p, b = *(const __attribute__((address_space(3))) u32x2*)(p + 8);
        *(u32x4*)(dst + (size_t)col * pitch + tc * 8) = (u32x4){a.x, a.y, b.x, b.y}; }
    asm volatile("s_waitcnt lgkmcnt(0)" ::: "memory");
}
struct EpiRetIn { const Ctx* c; lds_b* scr0; bool dry;
    __device__ __forceinline__ void operator()(AccRef acc, const pg8::Unit& u, int wr, int wc, int fr, int fq) const { asm volatile("" : "+v"(fr), "+v"(fq));
        if (dry) return;
        const Ctx& C = *c; const int pn = u.pn; f32x4 kt1[2][2], kt2[2][2], vt[2][2][2];
        EPI_ROWS(ai, m) { const int row = u.pm * 256 + ai * 128 + wr * 64 + m * 16 + fr; const float rs = C.rstd()[row]; const bool prompt = row < NP;
            const int s = prompt ? row / SEQ : 0, t = prompt ? row % SEQ : (row - NP) % DEC_SEQ, pos = prompt ? t : PAST_LEN + t, j = t / SCH, il = t % SCH, srow = row - NP;
            if (pn < 8) {
                const int head = pn & 3; const bool isk = pn >= 4; const float sc = isk ? 0.0625f : 1.f; const float l2g = log2gamma(head);
                const float dec = prompt ? (isk ? exp2f((float)(SCH - 1 - il) * l2g) : exp2f((float)(il + 1) * l2g)) : 1.f;
                f32x4 o1[2], o2[2];
#pragma unroll
                for (int n = 0; n < 2; ++n) { const int i0 = 32 * wc + 8 * fq + 4 * n; const f32x4* tp = (const f32x4*)(C.tabr() + (size_t)pos * 128 + i0); const f32x4 t01 = tp[0], t23 = tp[1];
                    const f32x4 x1 = acc[ai][0][m][n] * (rs * sc), x2 = acc[ai][1][m][n] * (rs * sc);
                    o1[n] = (f32x4){x1.x * t01.x - x2.x * t01.y, x1.y * t01.z - x2.y * t01.w, x1.z * t23.x - x2.z * t23.y, x1.w * t23.z - x2.w * t23.w};
                    o2[n] = (f32x4){x2.x * t01.x + x1.x * t01.y, x2.y * t01.z + x1.y * t01.w, x2.z * t23.x + x1.z * t23.y, x2.w * t23.z + x1.w * t23.w}; }
                const int i8 = 32 * wc + 8 * fq;
                if (prompt) {
                    if (isk) { bf16* dst = C.kp() + (size_t)row * 1024 + head * 256 + i8; *(u32x4*)dst = pack8(o1[0], o1[1]); *(u32x4*)(dst + 128) = pack8(o2[0], o2[1]); }
                    if (!isk) { bf16* d2 = C.acat() + ((size_t)row * 4 + head) * CATK + i8; *(u32x4*)d2 = pack8(o1[0] * dec, o1[1] * dec); *(u32x4*)(d2 + 128) = pack8(o2[0] * dec, o2[1] * dec); }
                    else {
#pragma unroll
                        for (int n = 0; n < 2; ++n) { kt1[m & 1][n] = o1[n] * dec; kt2[m & 1][n] = o2[n] * dec; }
                        if (m & 1) { lds_b* scr = scr0 + (wr * 4 + wc) * 2304; const int t0 = (u.pm * 256 + ai * 128 + wr * 64 + (m - 1) * 16) % SEQ;
                            bf16* d2 = C.kdt() + ((size_t)(s * 4 + head) * 256 + 32 * wc) * SEQ + t0; tr_store32(scr, kt1, d2, SEQ, fr, fq); tr_store32(scr, kt2, d2 + (size_t)128 * SEQ, SEQ, fr, fq); } }
                } else { float* d = C.sqkv() + (size_t)srow * 4096 + (isk ? 1024 : 0) + head * 256 + i8; *(f32x4*)d = o1[0]; *(f32x4*)(d + 4) = o1[1]; *(f32x4*)(d + 128) = o2[0]; *(f32x4*)(d + 132) = o2[1]; }
            } else if (pn < 16) {
                const int head = (pn - 8) >> 1, e0 = ((pn - 8) & 1) * 256;
#pragma unroll
                for (int bj = 0; bj < 2; ++bj) { const int e = e0 + 128 * bj + 32 * wc + 8 * fq; const f32x4 v0 = acc[ai][bj][m][0] * rs, v1 = acc[ai][bj][m][1] * rs;
                    if (prompt) { vt[bj][m & 1][0] = v0; vt[bj][m & 1][1] = v1; }
                    else { float* d = C.sqkv() + (size_t)srow * 4096 + 2048 + head * 512 + e; *(f32x4*)d = v0; *(f32x4*)(d + 4) = v1; } }
                if (prompt && (m & 1)) { lds_b* scr = scr0 + (wr * 4 + wc) * 2304; const int t0 = (u.pm * 256 + ai * 128 + wr * 64 + (m - 1) * 16) % SEQ, j0 = t0 / SCH, il0 = t0 % SCH;
#pragma unroll
                    for (int bj = 0; bj < 2; ++bj) tr_store32(scr, vt[bj], C.bcat() + ((size_t)((s * 4 + head) * NSCH + j0) * 512 + e0 + 128 * bj + 32 * wc) * CATK + RET_DK + il0, CATK, fr, fq); }
            } else {
#pragma unroll
                for (int bj = 0; bj < 2; ++bj) { f32x4 v0 = acc[ai][bj][m][0] * rs, v1 = acc[ai][bj][m][1] * rs;
                    v0 = (f32x4){silu_f(v0.x), silu_f(v0.y), silu_f(v0.z), silu_f(v0.w)}; v1 = (f32x4){silu_f(v1.x), silu_f(v1.y), silu_f(v1.z), silu_f(v1.w)};
                    ST16(C.sg() + (size_t)row * 2048 + (pn - 16) * 256 + 128 * bj + 32 * wc + 8 * fq, pack8(v0, v1)); }
            } }
    }
};
struct EpiRes { const Ctx* c; bool dry, last;
    __device__ __forceinline__ void operator()(AccRef acc, const pg8::Unit& u, int wr, int wc, int fr, int fq) const { asm volatile("" : "+v"(fr), "+v"(fq));
        const Ctx& C = *c;
        if (u.aux >= 16) {
            if (!dry) { float* P = (float*)(C.p.ws + OW_SPLITK) + (size_t)(u.aux - 16) * 256 * D_MODEL;
                EPI_ROWS(ai, m) { const int rl = ai * 128 + wr * 64 + m * 16 + fr;
#pragma unroll
                    for (int bj = 0; bj < 2; ++bj) { float* d = P + (size_t)rl * D_MODEL + u.pn * 256 + 128 * bj + 32 * wc + 8 * fq; *(f32x4*)d = acc[ai][bj][m][0]; *(f32x4*)(d + 4) = acc[ai][bj][m][1]; } } }
            return; }
        EPI_ROWS(ai, m) { const int row = u.pm * 256 + ai * 128 + wr * 64 + m * 16 + fr; float ss = 0.f;
#pragma unroll
            for (int bj = 0; bj < 2; ++bj) { const size_t off = (size_t)row * D_MODEL + u.pn * 256 + 128 * bj + 32 * wc + 8 * fq; const u32x4 xo = *(const u32x4*)(C.xb() + off);
                const f32x4 a = (f32x4){bflo(xo.x), bfhi(xo.x), bflo(xo.y), bfhi(xo.y)} + acc[ai][bj][m][0], b = (f32x4){bflo(xo.z), bfhi(xo.z), bflo(xo.w), bfhi(xo.w)} + acc[ai][bj][m][1];
                if (!dry) { *(u32x4*)(C.xb() + off) = pack8(a, b); if (last) { f32x4* xp = (f32x4*)(C.x() + off); xp[0] = a; xp[1] = b; } }
                ss += ((a.x * a.x + a.y * a.y) + (a.z * a.z + a.w * a.w)) + ((b.x * b.x + b.y * b.y) + (b.z * b.z + b.w * b.w)); }
            ss += __shfl_xor(ss, 16); ss += __shfl_xor(ss, 32);
            if (fq == 0 && !dry) C.ssq()[(size_t)row * 16 + u.pn * 4 + wc] = ss; }
    }
};
#ifndef ROR_CTRL1
#define ROR_CTRL1 0x121
#define ROR_CTRL2 0x122
#endif
#ifdef ROR_BPERMUTE
__device__ __forceinline__ f32x4 dpp_ror1(const f32x4 v) { const int src = (__lane_id() & ~15) | ((__lane_id() - 1) & 15); return (f32x4){__shfl(v.x, src), __shfl(v.y, src), __shfl(v.z, src), __shfl(v.w, src)}; }
__device__ __forceinline__ f32x4 dpp_ror2(const f32x4 v) { const int src = (__lane_id() & ~15) | ((__lane_id() - 2) & 15); return (f32x4){__shfl(v.x, src), __shfl(v.y, src), __shfl(v.z, src), __shfl(v.w, src)}; }
#else
__device__ __forceinline__ f32x4 dpp_ror1(const f32x4 v) { f32x4 r; r.x = __builtin_bit_cast(float, __builtin_amdgcn_update_dpp(0, __builtin_bit_cast(int, v.x), ROR_CTRL1, 0xF, 0xF, false)); r.y = __builtin_bit_cast(float, __builtin_amdgcn_update_dpp(0, __builtin_bit_cast(int, v.y), ROR_CTRL1, 0xF, 0xF, false));
    r.z = __builtin_bit_cast(float, __builtin_amdgcn_update_dpp(0, __builtin_bit_cast(int, v.z), ROR_CTRL1, 0xF, 0xF, false)); r.w = __builtin_bit_cast(float, __builtin_amdgcn_update_dpp(0, __builtin_bit_cast(int, v.w), ROR_CTRL1, 0xF, 0xF, false)); return r; }
__device__ __forceinline__ f32x4 dpp_ror2(const f32x4 v) { f32x4 r; r.x = __builtin_bit_cast(float, __builtin_amdgcn_update_dpp(0, __builtin_bit_cast(int, v.x), ROR_CTRL2, 0xF, 0xF, false)); r.y = __builtin_bit_cast(float, __builtin_amdgcn_update_dpp(0, __builtin_bit_cast(int, v.y), ROR_CTRL2, 0xF, 0xF, false));
    r.z = __builtin_bit_cast(float, __builtin_amdgcn_update_dpp(0, __builtin_bit_cast(int, v.z), ROR_CTRL2, 0xF, 0xF, false)); r.w = __builtin_bit_cast(float, __builtin_amdgcn_update_dpp(0, __builtin_bit_cast(int, v.w), ROR_CTRL2, 0xF, 0xF, false)); return r; }
#endif
__device__ __forceinline__ f32x4 gelu4(const f32x4 v) { return (f32x4){gelu_tanh(v.x), gelu_tanh(v.y), gelu_tanh(v.z), gelu_tanh(v.w)}; }
struct EpiFfnIn { const Ctx* c; int layer; lds_b* scr0;
    __device__ __forceinline__ void operator()(AccRef acc, const pg8::Unit& u, int wr, int wc, int fr, int fq) const { asm volatile("" : "+v"(fr), "+v"(fq));
        const Ctx& C = *c; const bool sample = u.aux == 1; const int rbase = sample ? NP : 254 * u.pm - 2, fb = 128 * u.pn + 32 * wc + 8 * fq;
        __attribute__((address_space(3))) float* halo = (__attribute__((address_space(3))) float*)scr0;
        if (!sample && fr >= 14) {
#pragma unroll
            for (int ai = 0; ai < 2; ++ai) { const int rg = rbase + ai * 128 + wr * 64 + 48 + fr; const float rs = (rg >= 0) ? C.rstd()[rg] : 0.f;
#pragma unroll
                for (int n = 0; n < 2; ++n) *(__attribute__((address_space(3))) f32x4*)(halo + ((ai * 2 + wr) * 2 + (fr - 14)) * 128 + 32 * wc + 8 * fq + 4 * n) = acc[ai][0][3][n] * rs; } }
        asm volatile("s_waitcnt lgkmcnt(0)" ::: "memory"); __builtin_amdgcn_s_barrier();
        f32x4 w0[2], w1[2], w2[2], cb[2];
        { const float* cw = C.p.ffn_conv_w + (size_t)layer * 3 * D_FF + fb; const float* cbp = C.p.ffn_conv_b + (size_t)layer * D_FF + fb;
#pragma unroll
          for (int n = 0; n < 2; ++n) { w0[n] = *(const f32x4*)(cw + 4 * n); w1[n] = *(const f32x4*)(cw + D_FF + 4 * n); w2[n] = *(const f32x4*)(cw + 2 * D_FF + 4 * n); cb[n] = *(const f32x4*)(cbp + 4 * n); } }
#pragma unroll
        for (int ai = 0; ai < 2; ++ai) {
            f32x4 pr1[2], pr2[2];
            { const int ps = ai * 2 + wr - 1;
#pragma unroll
              for (int n = 0; n < 2; ++n) { const __attribute__((address_space(3))) float* hp = halo + (ps * 2) * 128 + 32 * wc + 8 * fq + 4 * n; const bool use = !sample && ps >= 0 && fr < 2;
                  const f32x4 h63 = use ? *(const __attribute__((address_space(3))) f32x4*)(hp + 128) : (f32x4){0.f, 0.f, 0.f, 0.f}, h62 = (use && fr == 0) ? *(const __attribute__((address_space(3))) f32x4*)hp : (f32x4){0.f, 0.f, 0.f, 0.f};
                  pr1[n] = h63; pr2[n] = fr == 0 ? h62 : h63; } }
#pragma unroll
            for (int m = 0; m < 4; ++m) { const int rl = ai * 128 + wr * 64 + m * 16 + fr, rg = rbase + rl; const bool inb = rg >= 0 && rg < NT; const float rs = inb ? C.rstd()[rg] : 0.f;
                const bool prompt = !sample; const int t = prompt ? (rg >= 0 ? rg % SEQ : 0) : (rg - NP) % DEC_SEQ, T = prompt ? SEQ : DEC_SEQ;
                const bool outrow = sample ? true : (rl >= 2 && rg < NP);
                const float* buf = sample ? C.p.state_conv + ((size_t)(layer * DEC_BATCH + (rg - NP) / DEC_SEQ) * 2) * D_FF + fb : nullptr;
                u32x4 wq = {0u, 0u, 0u, 0u};
#pragma unroll
                for (int n = 0; n < 2; ++n) { const f32x4 cur = acc[ai][0][m][n] * rs, gt = acc[ai][1][m][n] * rs;
                    const f32x4 c1r = dpp_ror1(cur), c2r = dpp_ror2(cur);
                    f32x4 um1 = fr >= 1 ? c1r : pr1[n], um2 = fr >= 2 ? c2r : pr2[n];
                    if (sample) { if (t == 0) { um1 = *(const f32x4*)(buf + D_FF + 4 * n); um2 = *(const f32x4*)(buf + 4 * n); } else if (t == 1) um2 = *(const f32x4*)(buf + D_FF + 4 * n); }
                    else { if (t == 0) { um1 = (f32x4){0.f, 0.f, 0.f, 0.f}; um2 = um1; } else if (t == 1) um2 = (f32x4){0.f, 0.f, 0.f, 0.f}; }
                    const f32x4 cc = cb[n] + w0[n] * um2 + w1[n] * um1 + w2[n] * cur; const f32x4 av = gelu4(cc) * gt;
                    pr1[n] = c1r; pr2[n] = c2r;
                    if (outrow) { if (n == 0) { wq.x = pg8::cvt_pk_bf16(av.x, av.y); wq.y = pg8::cvt_pk_bf16(av.z, av.w); } else { wq.z = pg8::cvt_pk_bf16(av.x, av.y); wq.w = pg8::cvt_pk_bf16(av.z, av.w); *(u32x4*)(C.act() + (size_t)rg * D_FF + fb) = wq; }
                        if (t >= T - 2) { const int jr = t - (T - 2);
                            float* d = C.p.out + (prompt ? O_CONVP + ((size_t)(layer * BATCH + rg / SEQ) * 2 + jr) * D_FF : O_CONVS + ((size_t)(layer * DEC_BATCH + (rg - NP) / DEC_SEQ) * 2 + jr) * D_FF) + fb + 4 * n;
                            *(f32x4*)d = cur; } } } } }
    }
};
struct SchedFfnIn {
    const char* A; const char* B; int G, c;
    __device__ __forceinline__ bool next(int i, pg8::Unit& u) const { const long L = (long)i * G + xcd_slot(c, G); constexpr int nM = 66, nN = 22; if (L >= (long)nM * nN) return false;
        const int grp = 4 * nN, gid = (int)(L / grp), fm = gid * 4, gsz = (nM - fm) < 4 ? (nM - fm) : 4, w = (int)(L % grp);
        u.pm = fm + w % gsz; u.pn = w / gsz; u.nt = 16; u.aux = u.pm == 65 ? 1 : 0;
        const long row0 = u.pm == 65 ? (long)NP : 254L * u.pm - 2; u.A = A + row0 * D_MODEL * 2; u.B = B + (size_t)u.pn * 256 * D_MODEL * 2; return true; }
};
constexpr float QSC = 0.125f * 1.4426950408889634f;
struct EpiKvqg { const Ctx* c; int tile0, jq;
    __device__ __forceinline__ void operator()(AccRef acc, const pg8::Unit& u, int wr, int wc, int fr, int fq) const { asm volatile("" : "+v"(fr), "+v"(fq));
        const Ctx& C = *c; const int T = u.pn + tile0;
        EPI_ROWS(ai, m) { const int row = u.pm * 256 + ai * 128 + wr * 64 + m * 16 + fr; const float rs0 = C.rstd()[row]; const bool prompt = row < NP;
            const int s = prompt ? row / SEQ : 0, t = prompt ? row % SEQ : (row - NP) % DEC_SEQ, pos = prompt ? t : PAST_LEN + t, b = prompt ? 0 : (row - NP) / DEC_SEQ, srow = row - NP;
            f32x4 x[2][2];
#pragma unroll
            for (int bj = 0; bj < 2; ++bj)
#pragma unroll
                for (int n = 0; n < 2; ++n) x[bj][n] = acc[ai][bj][m][n] * rs0;
            if (T == 10) {
                if (wc < 2) {
#pragma unroll
                    for (int n = 0; n < 2; ++n) { const int col = 32 * wc + 8 * fq + 4 * n; if (col < 3 * N_HEADS) { const f32x4 v = x[0][n]; *(f32x4*)(C.gates() + (size_t)row * 48 + col) = (f32x4){sigmoid_f(v.x), sigmoid_f(v.y), sigmoid_f(v.z), sigmoid_f(v.w)}; } } }
                continue; }
            const bool normed = (T == 2 || T == 4 || T >= 6);
            f32x4 y[2][2];
            if (normed) {
                float ss = 0.f;
#pragma unroll
                for (int bj = 0; bj < 2; ++bj)
#pragma unroll
                    for (int n = 0; n < 2; ++n) { const f32x4 v = x[bj][n]; ss += (v.x * v.x + v.y * v.y) + (v.z * v.z + v.w * v.w); }
                ss += __shfl_xor(ss, 16); ss += __shfl_xor(ss, 32);
                const float rs = 1.f / sqrtf(ss * (1.f / HEAD_DIM) + EPS);
                const float* gn = T == 2 ? C.p.kv_knorm + HEAD_DIM : T == 4 ? C.p.kv_knorm + 2 * HEAD_DIM : C.p.nsa_qnorm + jq * HEAD_DIM;
#pragma unroll
                for (int bj = 0; bj < 2; ++bj)
#pragma unroll
                    for (int n = 0; n < 2; ++n) { const f32x4 g = *(const f32x4*)(gn + 32 * bj + 8 * fq + 4 * n); x[bj][n] = x[bj][n] * rs * g; }
#pragma unroll
                for (int n = 0; n < 2; ++n) { const f32x4* tp = (const f32x4*)(C.tabn() + (size_t)pos * 32 + 8 * fq + 4 * n); const f32x4 t01 = tp[0], t23 = tp[1]; const f32x4 x1 = x[0][n], x2 = x[1][n];
                    y[0][n] = (f32x4){x1.x * t01.x - x2.x * t01.y, x1.y * t01.z - x2.y * t01.w, x1.z * t23.x - x2.z * t23.y, x1.w * t23.z - x2.w * t23.w};
                    y[1][n] = (f32x4){x2.x * t01.x + x1.x * t01.y, x2.y * t01.z + x1.y * t01.w, x2.z * t23.x + x1.z * t23.y, x2.w * t23.z + x1.w * t23.w}; }
            }
            if (T >= 6) {
                const int head = 4 * (T - 6) + wc;
#pragma unroll
                for (int bj = 0; bj < 2; ++bj) { const size_t off = ((size_t)row * N_HEADS + head) * HEAD_DIM + 32 * bj + 8 * fq; *(u32x4*)(C.qc() + off) = pack8(x[bj][0] * QSC, x[bj][1] * QSC); *(u32x4*)(C.qr() + off) = pack8(y[bj][0] * QSC, y[bj][1] * QSC); }
                continue; }
            const int kvh = wc, br = T >> 1, cc = T & 1;
            float* od = nullptr;
            if (br == 0) od = C.p.out + (prompt ? O_CMPP + (size_t)row * KVROW : O_CMPS + (size_t)srow * KVROW);
            else if (br == 1) od = C.p.out + (prompt ? O_SELP + (size_t)row * KVROW : O_SELS + (size_t)srow * KVROW);
            else { if (prompt) { if (t >= SEQ - WIN_P) od = C.p.out + O_WINP + ((size_t)s * WIN_P + (t - (SEQ - WIN_P))) * KVROW; } else od = C.p.out + O_WINS + ((size_t)b * WIN_S + (WIN_S - DEC_SEQ + t)) * KVROW; }
#pragma unroll
            for (int bj = 0; bj < 2; ++bj)
#pragma unroll
                for (int n = 0; n < 2; ++n) { const f32x4 v = (normed ? y[bj][n] : x[bj][n]); const int d = 32 * bj + 8 * fq + 4 * n;
                    if (od) *(f32x4*)(od + cc * KVH + kvh * HEAD_DIM + d) = v;
                    u32x2 w; w.x = pg8::cvt_pk_bf16(v.x, v.y); w.y = pg8::cvt_pk_bf16(v.z, v.w);
                    if (br == 0) { if (prompt) *(u32x2*)(C.asub() + ((size_t)((cc * N_KV + kvh) * NSEQ + s) * 512 + t / 16) * 1024 + (t % 16) * 64 + d) = w; }
                    else if (cc == 0) {
                        bf16* kd = br == 1 ? (prompt ? C.sk() + ((size_t)(s * N_KV + kvh) * SEQ + t) * 64 : C.sks() + ((size_t)(b * N_KV + kvh) * SELP + PAST_LEN + t) * 64)
                                           : (prompt ? C.wk() + ((size_t)(s * N_KV + kvh) * SEQ + t) * 64 : C.wks() + ((size_t)(b * N_KV + kvh) * WINS + WIN_BUF + t) * 64);
                        *(u32x2*)(kd + d) = w; }
                    else {
                        if (br == 1) { if (prompt) store_t4(C.svt() + (size_t)(s * N_KV + kvh) * 64 * SEQ + vtt_off(t, d), 32, v); else store_t4(C.svts() + (size_t)(b * N_KV + kvh) * 64 * SELP + vtt_off(PAST_LEN + t, d), 32, v); }
                        else { if (prompt) store_t4(C.wvt() + (size_t)(s * N_KV + kvh) * 64 * SEQ + vtt_off(t, d), 32, v); else store_t4(C.wvts() + (size_t)(b * N_KV + kvh) * 64 * WINS + vtt_off(WIN_BUF + t, d), 32, v); } } } }
    }
};
struct EpiP { const Ctx* c;
    __device__ __forceinline__ void operator()(AccRef acc, const pg8::Unit& u, int wr, int wc, int fr, int fq) const { asm volatile("" : "+v"(fr), "+v"(fq));
        const Ctx& C = *c; const int head = u.aux & 3, sj = u.aux >> 2;
        const float l2g = log2gamma(head);
        EPI_ROWS(ai, m) { const int iq = u.pm * 256 + ai * 128 + wr * 64 + m * 16 + fr; const size_t row = (size_t)sj * SCH + iq;
#pragma unroll
            for (int bj = 0; bj < 2; ++bj) { const int ik = u.pn * 256 + 128 * bj + 32 * wc + 8 * fq; f32x4 v0 = acc[ai][bj][m][0], v1 = acc[ai][bj][m][1]; const float dk = -(float)(ik + 1) * l2g;
                v0 = (f32x4){ik <= iq ? v0.x * exp2f(dk) : 0.f, ik + 1 <= iq ? v0.y * exp2f(dk - l2g) : 0.f, ik + 2 <= iq ? v0.z * exp2f(dk - 2.f * l2g) : 0.f, ik + 3 <= iq ? v0.w * exp2f(dk - 3.f * l2g) : 0.f};
                v1 = (f32x4){ik + 4 <= iq ? v1.x * exp2f(dk - 4.f * l2g) : 0.f, ik + 5 <= iq ? v1.y * exp2f(dk - 5.f * l2g) : 0.f, ik + 6 <= iq ? v1.z * exp2f(dk - 6.f * l2g) : 0.f, ik + 7 <= iq ? v1.w * exp2f(dk - 7.f * l2g) : 0.f};
                *(u32x4*)(C.acat() + (row * 4 + head) * CATK + RET_DK + ik) = pack8(v0, v1); } }
    }
};
struct EpiKV { const Ctx* c;
    __device__ __forceinline__ void operator()(AccRef acc, const pg8::Unit& u, int wr, int wc, int fr, int fq) const { asm volatile("" : "+v"(fr), "+v"(fq));
        const Ctx& C = *c;
        EPI_ROWS(ai, m) { const int e = u.pm * 256 + ai * 128 + wr * 64 + m * 16 + fr;
#pragma unroll
            for (int bj = 0; bj < 2; ++bj) *(u32x4*)((bf16*)C.kvs() + ((size_t)u.aux * 512 + e) * 256 + 128 * bj + 32 * wc + 8 * fq) = pack8(acc[ai][bj][m][0], acc[ai][bj][m][1]); }
    }
};
struct EpiOut { const Ctx* c;
    __device__ __forceinline__ void operator()(AccRef acc, const pg8::Unit& u, int wr, int wc, int fr, int fq) const { asm volatile("" : "+v"(fr), "+v"(fq));
        const Ctx& C = *c; const int head = u.aux & 3, sj = u.aux >> 2;
        EPI_ROWS(ai, m) { const size_t row = (size_t)sj * SCH + u.pm * 256 + ai * 128 + wr * 64 + m * 16 + fr;
#pragma unroll
            for (int bj = 0; bj < 2; ++bj) ST16(C.o() + row * 2048 + head * 512 + u.pn * 256 + 128 * bj + 32 * wc + 8 * fq, pack8(acc[ai][bj][m][0], acc[ai][bj][m][1])); }
    }
};
struct EpiCmp1 { const Ctx* c;
    __device__ __forceinline__ void operator()(AccRef acc, const pg8::Unit& u, int wr, int wc, int fr, int fq) const { asm volatile("" : "+v"(fr), "+v"(fq));
        const Ctx& C = *c;
        EPI_ROWS(ai, m) { const size_t row = (size_t)u.pm * 256 + ai * 128 + wr * 64 + m * 16 + fr;
#pragma unroll
            for (int bj = 0; bj < 2; ++bj) ST16(C.part() + row * 256 + 128 * bj + 32 * wc + 8 * fq, pack8(acc[ai][bj][m][0], acc[ai][bj][m][1])); }
    }
};
struct SchedPKV {
    const Ctx* c; int G, cu, which;
    __device__ __forceinline__ bool next(int i, pg8::Unit& u) const { const Ctx& C = *c; const long L = (long)i * G + xcd_slot(cu, G);
        if (which == 0) { if (L >= (long)BATCH * 4 * NSCH * 3) return false; const int k = (int)(L % 3), shj = (int)(L / 3), head = shj % 4, sj = shj / 4;
            u.pm = k == 0 ? 0 : 1; u.pn = k == 2 ? 1 : 0; u.nt = 4; u.aux = sj * 4 + head;
            u.A = (const char*)(C.acat() + (((size_t)sj * SCH + u.pm * 256) * 4 + head) * CATK); u.B = (const char*)(C.kp() + ((size_t)sj * SCH + u.pn * 256) * 1024 + head * 256); return true; }
        else { if (L >= (long)BATCH * 4 * NSCH * 2) return false; const int eh = (int)(L % 2), q = (int)(L / 2), j = q % NSCH, sh = q / NSCH;
            u.pm = eh; u.pn = 0; u.nt = 8; u.aux = sh * NSCH + j;
            u.A = (const char*)(C.bcat() + ((size_t)(sh * NSCH + j) * 512 + eh * 256) * CATK + RET_DK); u.B = (const char*)(C.kdt() + (size_t)sh * 256 * SEQ + j * SCH); return true; } }
};
struct SchedOut { const Ctx* c; int G, cu;
    __device__ __forceinline__ bool next(int i, pg8::Unit& u) const { const Ctx& C = *c; const long pr = (long)(i >> 1) * G + xcd_slot(cu, G); if (pr >= (long)BATCH * 4 * NSCH * 2) return false;
        const int shj = (int)(pr >> 1), head = shj % 4, sj = shj / 4, s = sj / NSCH, j = sj % NSCH;
        u.pm = (int)(pr & 1); u.pn = i & 1; u.nt = u.pm == 0 ? 8 : 12; u.aux = sj * 4 + head;
        u.A = (const char*)(C.acat() + (((size_t)sj * SCH + u.pm * 256) * 4 + head) * CATK); u.B = (const char*)(C.bcat() + ((size_t)((s * 4 + head) * NSCH + j) * 512 + u.pn * 256) * CATK); return true; }
};
typedef __attribute__((address_space(3))) float lds_f32;
__device__ __forceinline__ void bf8_to_f32(const u32x4 w, float (&v)[8]) { v[0] = bflo(w.x); v[1] = bfhi(w.x); v[2] = bflo(w.y); v[3] = bfhi(w.y); v[4] = bflo(w.z); v[5] = bfhi(w.z); v[6] = bflo(w.w); v[7] = bfhi(w.w); }
__device__ __forceinline__ void ph_ret_scan(const Ctx& c, Frame F, int layer) { F.tid = opq((int)threadIdx.x); F.lane = F.tid & 63;
    for (long idx = (long)opq_s(blockIdx.x) * MK_THREADS + opq(F.tid); idx < (long)BATCH * 4 * 512 * 32; idx += (long)gridDim.x * MK_THREADS) {
        const int dch = (int)(idx % 32), e = (int)((idx / 32) % 512), sh = (int)(idx / (32 * 512)), head = sh % 4, s = sh / 4; const float dec = exp2f((float)SCH * log2gamma(head));
        float S[8];
#pragma unroll
        for (int k = 0; k < 8; ++k) S[k] = 0.f;
        for (int j = 0; j < NSCH; ++j) { const size_t rowi = (size_t)(sh * NSCH + j) * 512 + e;
            u32x4 w; w.x = pk2(S[0], S[1]); w.y = pk2(S[2], S[3]); w.z = pk2(S[4], S[5]); w.w = pk2(S[6], S[7]); *(u32x4*)(c.bcat() + rowi * CATK + dch * 8) = w;
            const u32x4 kw = *(const u32x4*)((const bf16*)c.kvs() + rowi * 256 + dch * 8); const f32x4 a = (f32x4){bflo(kw.x), bfhi(kw.x), bflo(kw.y), bfhi(kw.y)}, b = (f32x4){bflo(kw.z), bfhi(kw.z), bflo(kw.w), bfhi(kw.w)};
            S[0] = S[0] * dec + a.x; S[1] = S[1] * dec + a.y; S[2] = S[2] * dec + a.z; S[3] = S[3] * dec + a.w; S[4] = S[4] * dec + b.x; S[5] = S[5] * dec + b.y; S[6] = S[6] * dec + b.z; S[7] = S[7] * dec + b.w; }
        float* o = c.p.out + O_RETP + ((size_t)(layer * BATCH + s) * RET_HEADS + head) * RET_DK * RET_DV + (size_t)(dch * 8) * RET_DV + e;
#pragma unroll
        for (int k = 0; k < 8; ++k) o[(size_t)k * RET_DV] = S[k]; }
}
__device__ __forceinline__ void ph_ret_sample(const Ctx& c, Frame F, int layer) { F.tid = opq((int)threadIdx.x); F.lane = F.tid & 63;
    lds_f32* qd = (lds_f32*)(F.lds); lds_f32* kd = qd + 8 * 256; lds_f32* vv = kd + 8 * 256; lds_f32* sc = vv + 8 * 256; lds_f32* part = sc + 64;
    for (int item = blockIdx.x; item < DEC_BATCH * 4 * 2; item += gridDim.x) { const int eh = item & 1, head = (item >> 1) & 3, b = item >> 3; const float l2g = log2gamma(head);
        __syncthreads();
        for (int i = F.tid; i < 8 * 256; i += MK_THREADS) { const int t = i >> 8, d = i & 255; const float* r = c.sqkv() + (size_t)(b * 8 + t) * 4096;
            qd[i] = r[head * 256 + d]; kd[i] = r[1024 + head * 256 + d]; vv[i] = r[2048 + head * 512 + eh * 256 + d]; }
        __syncthreads();
        if (F.tid < 64) { const int t = F.tid >> 3, m = F.tid & 7; float a = 0.f; if (m <= t) { for (int d = 0; d < 256; ++d) a += qd[t * 256 + d] * kd[m * 256 + d]; a *= exp2f((float)(t - m) * l2g); } sc[F.tid] = a; }
        __syncthreads();
        const int el = F.tid & 255, dh = F.tid >> 8, e = eh * 256 + el; const size_t sbase = ((size_t)(layer * DEC_BATCH + b) * RET_HEADS + head) * RET_DK * RET_DV;
        float o[8], vloc[8], qdec[8], kdec[8];
#pragma unroll
        for (int t = 0; t < 8; ++t) { o[t] = 0.f; vloc[t] = vv[t * 256 + el]; qdec[t] = exp2f((float)(t + 1) * l2g); kdec[t] = exp2f((float)(7 - t) * l2g); }
        const float dec8 = exp2f(8.f * l2g);
        float kv8[8];
#pragma unroll
        for (int t = 0; t < 8; ++t) kv8[t] = kdec[t] * vloc[t];
#pragma unroll 1
        for (int d0 = dh * 128; d0 < dh * 128 + 128; d0 += 8) { float s0[8];
#pragma unroll
            for (int k = 0; k < 8; ++k) s0[k] = c.p.state_ret[sbase + (size_t)(d0 + k) * RET_DV + e];
#pragma unroll
            for (int k = 0; k < 8; ++k) { const int d = d0 + k; float sn = s0[k] * dec8;
#pragma unroll
                for (int t = 0; t < 8; ++t) { o[t] += qd[t * 256 + d] * s0[k]; sn += kd[t * 256 + d] * kv8[t]; }
                c.p.out[O_RETS + sbase + (size_t)d * RET_DV + e] = sn; } }
        if (dh == 1) {
#pragma unroll
            for (int t = 0; t < 8; ++t) part[t * 256 + el] = o[t]; }
        __syncthreads();
        if (dh == 0) {
#pragma unroll
            for (int t = 0; t < 8; ++t) { float a = (o[t] + part[t * 256 + el]) * qdec[t];
#pragma unroll
                for (int m = 0; m < 8; ++m) if (m <= t) a += sc[t * 8 + m] * vloc[m];
                c.o()[(size_t)(NP + b * 8 + t) * 2048 + head * 512 + e] = (bf16)f2bf(a); } }
    }
    __syncthreads();
}
__device__ __forceinline__ void gate_rows4(const Ctx& c, const size_t (&off)[4], int lane) { u32x4 ow[4], gw[4];
#pragma unroll
    for (int k = 0; k < 4; ++k) { ow[k] = *(const u32x4*)(c.o() + off[k] + lane * 8); gw[k] = *(const u32x4*)(c.sg() + off[k] + lane * 8); }
#pragma unroll
    for (int k = 0; k < 4; ++k) { float o[8], g[8]; bf8_to_f32(ow[k], o); bf8_to_f32(gw[k], g); float ss = 0.f;
#pragma unroll
        for (int q = 0; q < 8; ++q) ss += o[q] * o[q];
        ss = wave_sum(ss); const float rs = 1.f / sqrtf(ss * (1.f / RET_DV) + EPS);
        u32x4 w; w.x = pk2(o[0] * rs * g[0], o[1] * rs * g[1]); w.y = pk2(o[2] * rs * g[2], o[3] * rs * g[3]); w.z = pk2(o[4] * rs * g[4], o[5] * rs * g[5]); w.w = pk2(o[6] * rs * g[6], o[7] * rs * g[7]);
        *(u32x4*)(c.g() + off[k] + lane * 8) = w; } }
__device__ __forceinline__ void ph_gate_own(const Ctx& c, Frame F) { F.tid = opq((int)threadIdx.x); F.lane = F.tid & 63;
    for (long pr = opq_s(xcd_slot((int)blockIdx.x, (int)gridDim.x)); pr < (long)BATCH * 4 * NSCH * 2; pr += gridDim.x) { const int shj = (int)(pr >> 1), head = shj % 4, sj = shj / 4, pm = (int)(pr & 1); const size_t row0 = (size_t)sj * SCH + pm * 256;
        for (int r4 = F.wave * 4; r4 < 256; r4 += NWAVES * 4) { size_t off[4];
#pragma unroll
            for (int k = 0; k < 4; ++k) off[k] = (row0 + r4 + k) * 2048 + head * 512;
            gate_rows4(c, off, F.lane); } }
}
__device__ __forceinline__ void ph_gate_sample(const Ctx& c, Frame F) { F.tid = opq((int)threadIdx.x); F.lane = F.tid & 63;
    for (long i4 = (long)opq_s(F.gw) * 4; i4 < (long)NS * RET_HEADS; i4 += (long)F.ngw * 4) { size_t off[4];
#pragma unroll
        for (int k = 0; k < 4; ++k) off[k] = ((size_t)NP * RET_HEADS + i4 + k) * RET_DV;
        gate_rows4(c, off, F.lane); }
}
__device__ __forceinline__ void ph_conv(const Ctx& c, Frame F, int layer) { F.tid = opq((int)threadIdx.x); F.lane = F.tid & 63;
    constexpr int NCHK = D_FF / 8, NSEG = NT / 64; const float* cw = c.p.ffn_conv_w + (size_t)layer * 3 * D_FF; const float* cb = c.p.ffn_conv_b + (size_t)layer * D_FF;
    for (long it = (long)opq_s(blockIdx.x) * MK_THREADS + opq(F.tid); it < (long)NSEG * NCHK; it += (long)gridDim.x * MK_THREADS) { const int ch = (int)(it % NCHK), seg = (int)(it / NCHK), f = ch * 8, row0 = seg * 64; const bool prompt = row0 < NP;
        float w0[8], w1[8], w2[8], bb[8];
#pragma unroll
        for (int k = 0; k < 2; ++k) { const f32x4 a = *(const f32x4*)(cw + f + 4 * k), b = *(const f32x4*)(cw + D_FF + f + 4 * k), d = *(const f32x4*)(cw + 2 * D_FF + f + 4 * k), e = *(const f32x4*)(cb + f + 4 * k);
            w0[4 * k] = a.x; w0[4 * k + 1] = a.y; w0[4 * k + 2] = a.z; w0[4 * k + 3] = a.w; w1[4 * k] = b.x; w1[4 * k + 1] = b.y; w1[4 * k + 2] = b.z; w1[4 * k + 3] = b.w;
            w2[4 * k] = d.x; w2[4 * k + 1] = d.y; w2[4 * k + 2] = d.z; w2[4 * k + 3] = d.w; bb[4 * k] = e.x; bb[4 * k + 1] = e.y; bb[4 * k + 2] = e.z; bb[4 * k + 3] = e.w; }
        float u1[8], u2[8];
#pragma unroll
        for (int k = 0; k < 8; ++k) { u1[k] = 0.f; u2[k] = 0.f; }
        if (prompt && (row0 % SEQ) != 0) { bf8_to_f32(*(const u32x4*)(c.u() + (size_t)(row0 - 1) * D_FF + f), u1); bf8_to_f32(*(const u32x4*)(c.u() + (size_t)(row0 - 2) * D_FF + f), u2); }
#pragma unroll 1
        for (int r4 = 0; r4 < 64; r4 += 4) { u32x4 uu[4], gg[4];
#pragma unroll
            for (int j = 0; j < 4; ++j) { const size_t off = (size_t)(row0 + r4 + j) * D_FF + f; uu[j] = *(const u32x4*)(c.u() + off); gg[j] = *(const u32x4*)(c.gt() + off); }
#pragma unroll
            for (int j = 0; j < 4; ++j) { const int row = row0 + r4 + j;
                if (!prompt && ((row - NP) % DEC_SEQ) == 0) { const float* buf = c.p.state_conv + ((size_t)(layer * DEC_BATCH + (row - NP) / DEC_SEQ) * 2) * D_FF + f;
#pragma unroll
                    for (int k = 0; k < 8; ++k) { u2[k] = buf[k]; u1[k] = buf[D_FF + k]; } }
                float u0[8], gt[8], rr[8]; bf8_to_f32(uu[j], u0); bf8_to_f32(gg[j], gt);
#pragma unroll
                for (int k = 0; k < 8; ++k) { const float cc = bb[k] + w0[k] * u2[k] + w1[k] * u1[k] + w2[k] * u0[k]; rr[k] = gelu_tanh(cc) * gt[k]; u2[k] = u1[k]; u1[k] = u0[k]; }
                u32x4 w; w.x = pk2(rr[0], rr[1]); w.y = pk2(rr[2], rr[3]); w.z = pk2(rr[4], rr[5]); w.w = pk2(rr[6], rr[7]); *(u32x4*)(c.act() + (size_t)row * D_FF + f) = w; } } }
}

struct SchedResSplit { const char* A; const char* B; int ld, nt, G, c;
    __device__ __forceinline__ bool next(int i, pg8::Unit& u) const { const long L = (long)i * G + c;
        if (L < 256) { const int w = (int)(L % 32), gid = (int)(L / 32); u.pm = gid * 8 + w % 8; u.pn = w / 8; u.nt = nt; u.aux = 0; u.A = A + (size_t)u.pm * 256 * ld * 2; u.B = B + (size_t)u.pn * 256 * ld * 2; return true; }
        const int j = (int)(L - 256); if (j >= 32) return false;
        const int pn = j >> 3, sl = j & 7, pairs = nt / 2, q = pairs / 8, rm = pairs % 8, t0 = 2 * (sl * q + (sl < rm ? sl : rm)), np = q + (sl < rm ? 1 : 0);
        u.pm = 64; u.pn = pn; u.nt = 2 * np; u.aux = 16 + sl; u.A = A + (size_t)64 * 256 * ld * 2 + (size_t)t0 * 128; u.B = B + (size_t)pn * 256 * ld * 2 + (size_t)t0 * 128; return true; }
};
__device__ __forceinline__ void ph_fix_sample(const Ctx& c, Frame F, bool dry, bool last) { F.tid = opq((int)threadIdx.x); F.lane = F.tid & 63;
    const float* P = (const float*)(c.p.ws + OW_SPLITK);
    for (int rl = opq_s(F.gw); rl < NS; rl += F.ngw) { const int r = NP + rl; float s = 0.f;
#pragma unroll
        for (int j = 0; j < 4; ++j) { const u32x2 xo = ((const u32x2*)(c.xb() + (size_t)r * D_MODEL))[F.lane + 64 * j]; f32x4 v = (f32x4){bflo(xo.x), bfhi(xo.x), bflo(xo.y), bfhi(xo.y)};
#pragma unroll
            for (int sl = 0; sl < 8; ++sl) v = v + ((const f32x4*)(P + ((size_t)sl * 256 + rl) * D_MODEL))[F.lane + 64 * j];
            s += (v.x * v.x + v.y * v.y) + (v.z * v.z + v.w * v.w);
            if (!dry) { if (last) ((f32x4*)(c.x() + (size_t)r * D_MODEL))[F.lane + 64 * j] = v; u32x2 w; w.x = pk2(v.x, v.y); w.y = pk2(v.z, v.w); ((u32x2*)(c.xb() + (size_t)r * D_MODEL))[F.lane + 64 * j] = w; } }
        s = wave_sum(s); if (F.lane < 16 && !dry) c.ssq()[(size_t)r * 16 + F.lane] = F.lane == 0 ? s : 0.f; if (F.lane == 0 && !dry) c.rstd()[r] = 1.f / sqrtf(s * (1.f / D_MODEL) + EPS); }
    if (!dry) for (int r = opq_s((int)blockIdx.x) * MK_THREADS + F.tid; r < NP; r += gridDim.x * MK_THREADS) c.rstd()[r] = row_rstd(c.ssq(), r);
}
__device__ __forceinline__ const float* paged_row_f(const float* cache, const int* pt, int b, int p) { const int page = pt[b * N_PAGES + p / PAGE_SIZE]; return cache + ((size_t)page * PAGE_SIZE + p % PAGE_SIZE) * KVROW; }
__device__ __forceinline__ void ph_cmp_convert(const Ctx& c, Frame F) { F.tid = opq((int)threadIdx.x); F.lane = F.tid & 63;
    const int cc = F.lane >> 5, kvh = (F.lane >> 3) & 3, d = (F.lane & 7) * 8;
    for (long i0 = (long)opq_s(F.gw) * 8; i0 < (long)DEC_BATCH * PAST_LEN; i0 += (long)F.ngw * 8) { const int b = (int)(i0 / PAST_LEN), p = (int)(i0 % PAST_LEN);
        const float* src = paged_row_f(c.p.cache_cmp, c.p.page_table, b, p) + F.lane * 8; f32x4 a[8], bb[8];
#pragma unroll
        for (int k = 0; k < 8; ++k) { a[k] = __builtin_nontemporal_load((const f32x4*)(src + (size_t)k * KVROW)); bb[k] = __builtin_nontemporal_load((const f32x4*)(src + (size_t)k * KVROW) + 1); }
        bf16* dst = c.asub() + ((size_t)((cc * N_KV + kvh) * NSEQ + BATCH + b) * 512 + p / 16) * 1024 + (p % 16) * 64 + d;
#pragma unroll
        for (int k = 0; k < 8; ++k) *(u32x4*)(dst + k * 64) = pack8(a[k], bb[k]); }
}
struct SchedCmp { const Ctx* c; int G, cu;
    __device__ __forceinline__ bool next(int i, pg8::Unit& u) const { const long L = (long)i * G + cu; constexpr int NU = 8 * NSEQ * 512 / 256; if (L >= NU) return false;
        u.pm = (int)L; u.pn = 0; u.nt = 16; u.aux = 0; u.A = (const char*)(c->asub() + (size_t)L * 256 * 1024); u.B = (const char*)(c->w_cmp1() + (size_t)(L / (NU / 2)) * 256 * 1024); return true; }
};
__device__ __forceinline__ void ph_cmp_stage2(const Ctx& c, Frame F) { F.tid = opq((int)threadIdx.x); F.lane = F.tid & 63;
    lds_f32* hid = (lds_f32*)(F.lds + F.wave * 1024);
    constexpr long PER_C = (long)4 * NSEQ * 512;
#pragma unroll 1
    for (int cc = 0; cc < 2; ++cc) {
        float w2r[CMP_HID];
#pragma unroll
        for (int hh = 0; hh < CMP_HID; ++hh) w2r[hh] = c.p.cmp_w2[((size_t)cc * CMP_HID + hh) * HEAD_DIM + F.lane];
        float pb0 = 0.f, pb1 = 0.f;
#pragma unroll 8
        for (int j = 0; j < 32; ++j) { pb0 += c.posb()[(size_t)(cc * 32 + j) * CMP_HID + F.lane]; pb1 += c.posb()[(size_t)(cc * 32 + j) * CMP_HID + 64 + F.lane]; }
        const float kg = c.p.kv_knorm[F.lane];
        for (long ii0 = (long)opq_s(F.gw) * 4; ii0 < PER_C; ii0 += (long)F.ngw * 4) { float a0[4], a1[4];
#pragma unroll
            for (int k = 0; k < 4; ++k) { const bf16* p0 = c.part() + (size_t)(cc * PER_C + ii0 + k) * 256; const bf16* p1 = p0 + 256 + 128; const bool real = ((ii0 + k) % 512) < NCMP;
                a0[k] = real ? bf2f(p0[F.lane]) + bf2f(p1[F.lane]) : 0.f; a1[k] = real ? bf2f(p0[F.lane + 64]) + bf2f(p1[F.lane + 64]) : 0.f; }
#pragma unroll
            for (int k = 0; k < 4; ++k) { const long ii = ii0 + k; const int n = (int)(ii % 512), s = (int)((ii / 512) % NSEQ), kvh = (int)(ii / (512 * NSEQ));
                if (n >= NCMP) {
                    if (cc == 0) c.cmpk()[((size_t)(s * N_KV + kvh) * 512 + n) * 64 + F.lane] = 0; else c.cmpvt()[(size_t)(s * N_KV + kvh) * 64 * 512 + vtt_off(n, F.lane)] = 0; continue; }
                hid[F.lane] = gelu_tanh(a0[k] + pb0); hid[F.lane + 64] = gelu_tanh(a1[k] + pb1);
                asm volatile("s_waitcnt lgkmcnt(0)" ::: "memory");
                float o0 = 0.f, o1 = 0.f;
#pragma unroll
                for (int h4 = 0; h4 < CMP_HID / 4; ++h4) { const f32x4 hv = *(const __attribute__((address_space(3))) f32x4*)(hid + 4 * h4); o0 += hv.x * w2r[4 * h4] + hv.z * w2r[4 * h4 + 2]; o1 += hv.y * w2r[4 * h4 + 1] + hv.w * w2r[4 * h4 + 3]; }
                const float o = o0 + o1;
                asm volatile("s_waitcnt lgkmcnt(0)" ::: "memory");
                if (cc == 0) { const float ss = wave_sum(o * o); const float rs = 1.f / sqrtf(ss * (1.f / HEAD_DIM) + EPS); c.cmpk()[((size_t)(s * N_KV + kvh) * 512 + n) * 64 + F.lane] = (bf16)f2bf(o * rs * kg); }
                else c.cmpvt()[(size_t)(s * N_KV + kvh) * 64 * 512 + vtt_off(n, F.lane)] = (bf16)f2bf(o); } } }
}
__device__ __forceinline__ void kvt_item(const float* srck, const float* srcv, int pitch, bf16* dstk, bf16* dstv, int ldt, lds_f32* scr, int lane) {
#pragma unroll
    for (int i = 0; i < 8; ++i) { const int tok = i * 8 + (lane >> 3), d8 = (lane & 7) * 8; const f32x4* sp = (const f32x4*)(srck + (size_t)tok * pitch + d8); *(u32x4*)(dstk + (size_t)tok * 64 + d8) = pack8(__builtin_nontemporal_load(sp), __builtin_nontemporal_load(sp + 1)); }
#pragma unroll
    for (int half = 0; half < 2; ++half) {
        { const int col4 = (lane & 7) * 4; f32x4 v[8];
#pragma unroll
          for (int i = 0; i < 8; ++i) { const int tok = i * 8 + (lane >> 3); v[i] = __builtin_nontemporal_load((const f32x4*)(srcv + (size_t)tok * pitch + half * 32 + col4)); }
#pragma unroll
          for (int i = 0; i < 8; ++i) { const int tok = i * 8 + (lane >> 3); scr[tok * 33 + col4] = v[i].x; scr[tok * 33 + col4 + 1] = v[i].y; scr[tok * 33 + col4 + 2] = v[i].z; scr[tok * 33 + col4 + 3] = v[i].w; } }
        asm volatile("s_waitcnt lgkmcnt(0)" ::: "memory");
        const int cch = lane & 7;
#pragma unroll
        for (int j = 0; j < 4; ++j) { const int n = (lane >> 3) + 8 * j; const lds_f32* s = scr + (8 * cch) * 33 + n;
            u32x4 o; o.x = pk2(s[0 * 33], s[1 * 33]); o.y = pk2(s[2 * 33], s[3 * 33]); o.z = pk2(s[4 * 33], s[5 * 33]); o.w = pk2(s[6 * 33], s[7 * 33]);
            *(u32x4*)(dstv + (size_t)(cch >> 2) * 2048 + (size_t)(half * 32 + n) * 32 + ((8 * cch) & 31)) = o; }
        asm volatile("s_waitcnt lgkmcnt(0)" ::: "memory"); }
}
#ifndef SEL_EARLY
#define SEL_EARLY 2400
#endif
constexpr int SEL_ITEMS = DEC_BATCH * N_KV * (PAST_LEN / 64 + WIN_BUF / 64);
__device__ __forceinline__ void sel_convert_items(const Ctx& c, Frame F, int lo, int hi, int widx, int nw) { F.tid = opq((int)threadIdx.x); F.lane = F.tid & 63;
    lds_f32* scr = (lds_f32*)(F.lds + 8192 + F.wave * 16384);
    constexpr int NB_SEL = PAST_LEN / 64, NB_WIN = WIN_BUF / 64;
    for (long i = (long)lo + opq_s(widx); i < (long)hi; i += nw) { const int blk = (int)(i % (NB_SEL + NB_WIN)), bk = (int)(i / (NB_SEL + NB_WIN)), kvh = bk % N_KV, b = bk / N_KV;
        if (blk < NB_SEL) { const float* src = paged_row_f(c.p.cache_sel, c.p.page_table, b, blk * 64) + kvh * 64;
            kvt_item(src, src + KVH, KVROW, c.sks() + ((size_t)bk * SELP + blk * 64) * 64, c.svts() + (size_t)bk * 64 * SELP + (size_t)blk * 4096, SELP, scr, F.lane); }
        else { const int wb = blk - NB_SEL; const float* src = c.p.cache_win + ((size_t)b * WIN_BUF + wb * 64) * KVROW + kvh * 64;
            kvt_item(src, src + KVH, KVROW, c.wks() + ((size_t)bk * WINS + wb * 64) * 64, c.wvts() + (size_t)bk * 64 * WINS + (size_t)wb * 4096, WINS, scr, F.lane); } }
}
__device__ __forceinline__ void ph_sel_convert(const Ctx& c, Frame F) { F.tid = opq((int)threadIdx.x); F.lane = F.tid & 63;
    sel_convert_items(c, F, 2 * SEL_EARLY, SEL_ITEMS, F.gw, F.ngw);
    for (long i = (long)opq_s(blockIdx.x) * MK_THREADS + opq(F.tid); i < (long)DEC_BATCH * N_KV * 64 * (SELP - PAST_LEN - DEC_SEQ); i += (long)gridDim.x * MK_THREADS) { const int pt = (int)(i % (SELP - PAST_LEN - DEC_SEQ)) + PAST_LEN + DEC_SEQ, d = (int)((i / (SELP - PAST_LEN - DEC_SEQ)) % 64); const long bk = i / ((SELP - PAST_LEN - DEC_SEQ) * 64);
        c.sks()[((size_t)bk * SELP + pt) * 64 + d] = 0; c.svts()[(size_t)bk * 64 * SELP + vtt_off(pt, d)] = 0; }
    for (long i = (long)opq_s(blockIdx.x) * MK_THREADS + opq(F.tid); i < (long)DEC_BATCH * N_KV * 64 * (WINS - WIN_BUF - DEC_SEQ); i += (long)gridDim.x * MK_THREADS) { const int pt = (int)(i % (WINS - WIN_BUF - DEC_SEQ)) + WIN_BUF + DEC_SEQ, d = (int)((i / (WINS - WIN_BUF - DEC_SEQ)) % 64); const long bk = i / ((WINS - WIN_BUF - DEC_SEQ) * 64);
        c.wks()[((size_t)bk * WINS + pt) * 64 + d] = 0; c.wvts()[(size_t)bk * 64 * WINS + vtt_off(pt, d)] = 0; }
    for (long i = (long)opq_s(blockIdx.x) * MK_THREADS + opq(F.tid); i < (long)DEC_BATCH * (WIN_S - DEC_SEQ) * (KVROW / 4); i += (long)gridDim.x * MK_THREADS) { const int q4 = (int)(i % (KVROW / 4)), j = (int)((i / (KVROW / 4)) % (WIN_S - DEC_SEQ)), b = (int)(i / ((long)(KVROW / 4) * (WIN_S - DEC_SEQ)));
        ((f32x4*)(c.p.out + O_WINS + ((size_t)b * WIN_S + j) * KVROW))[q4] = ((const f32x4*)(c.p.cache_win + ((size_t)b * WIN_BUF + (WIN_BUF - (WIN_S - DEC_SEQ) + j)) * KVROW))[q4]; }
}
typedef float f32x16 __attribute__((ext_vector_type(16)));
typedef short s16x8 __attribute__((ext_vector_type(8)));
typedef short s16x4 __attribute__((ext_vector_type(4)));
typedef __bf16 bf16x2_t __attribute__((ext_vector_type(2)));
typedef __attribute__((address_space(3))) unsigned lds_u32;
#define MFMA32(a, b, c) __builtin_amdgcn_mfma_f32_32x32x16_bf16((a), (b), (c), 0, 0, 0)
__device__ __forceinline__ unsigned cvtpk(float lo, float hi) { const f32x2 v = {lo, hi}; const bf16x2_t b = __builtin_convertvector(v, bf16x2_t); return __builtin_bit_cast(unsigned, b); }
__device__ __forceinline__ int crow16(int i, int h) { return (i & 3) + 8 * (i >> 2) + 4 * h; }
#define CROWK(k_) (((k_) & 3) + 4 * (((k_) >> 2) & 1) + 16 * ((k_) >> 3))
constexpr float LOG2E = 1.4426950408889634f;
template <int O> __device__ __forceinline__ int xshf_i(int v) {
    if constexpr (O == 1) return __builtin_amdgcn_update_dpp(0, v, 0xB1, 0xF, 0xF, false);
    else if constexpr (O == 2) return __builtin_amdgcn_update_dpp(0, v, 0x4E, 0xF, 0xF, false);
    else if constexpr (O == 32) return __shfl_xor(v, 32);
    else return __builtin_amdgcn_ds_swizzle(v, (O << 10) | 0x1f); }
template <int O> __device__ __forceinline__ float xshf(float v) { return __builtin_bit_cast(float, xshf_i<O>(__builtin_bit_cast(int, v))); }
typedef __attribute__((address_space(3))) unsigned char lds_u8;
__device__ __forceinline__ void att_dma_offsets(int (&ko)[4], int (&vo)[4], int lane) {
#pragma unroll
    for (int j = 0; j < 4; ++j) { const int p = 64 * j + lane; { const int row = p >> 3, ch = (p & 7) ^ ((row >> 1) & 7), key = (row & ~12) | ((row & 4) << 1) | ((row & 8) >> 1); ko[j] = key * 64 + ch * 8; }
        { const int row = p >> 2, ch = (p & 3) ^ ((row >> 2) & 3); vo[j] = row * 32 + ch * 8; } } }
__device__ __forceinline__ void att_dma(const bf16* src, const int (&off)[4], lds_u8* dst) {
#pragma unroll
    for (int j = 0; j < 4; ++j) __builtin_amdgcn_global_load_lds((const unsigned*)(src + off[j]), (__attribute__((address_space(3))) unsigned*)(dst + j * 1024), 16, 0, 0); }
__device__ __forceinline__ f32x16 att_qk_lds(const lds_u8* kb, const s16x8 (&q)[4], int r, int h, float init) { f32x16 s;
#pragma unroll
    for (int i = 0; i < 16; ++i) s[i] = init;
    const lds_u8* rowp = kb + r * 128; const int kx = (r >> 1) & 7;
#pragma unroll
    for (int ks = 0; ks < 4; ++ks) { const s16x8 kf = *(const __attribute__((address_space(3))) s16x8*)(rowp + (((2 * ks + h) ^ kx) << 4)); s = MFMA32(kf, q[ks], s); }
    return s; }
__device__ __forceinline__ void att_pv_lds(const lds_u8* vb, const float (&e)[16], f32x16 (&o)[2], int r, int h) { const int vx = (r >> 2) & 3;
#pragma unroll
    for (int s2 = 0; s2 < 2; ++s2) { u32x4 pw; pw.x = cvtpk(e[8 * s2], e[8 * s2 + 1]); pw.y = cvtpk(e[8 * s2 + 2], e[8 * s2 + 3]); pw.z = cvtpk(e[8 * s2 + 4], e[8 * s2 + 5]); pw.w = cvtpk(e[8 * s2 + 6], e[8 * s2 + 7]);
        const s16x8 pb = __builtin_bit_cast(s16x8, pw);
#pragma unroll
        for (int dt = 0; dt < 2; ++dt) { const s16x8 vf = *(const __attribute__((address_space(3))) s16x8*)(vb + (32 * dt + r) * 64 + (((2 * s2 + h) ^ vx) << 4)); o[dt] = MFMA32(vf, pb, o[dt]); } } }
#define ATT_WALK(NT_, ...) do { const int nt_ = (NT_); \
    asm volatile("s_waitcnt vmcnt(0) lgkmcnt(0)" ::: "memory"); \
    if (nt_ > 0) { att_dma(KT__(0), ko, kbuf0); if (PV__) att_dma(VT__(0), vo, vbuf0); } \
    _Pragma("unroll 1") for (int i = 0; i < nt_; ++i) { lds_u8* const kb_ = (i & 1) ? kbuf1 : kbuf0; lds_u8* const vbuf = (i & 1) ? vbuf1 : vbuf0; (void)vbuf; \
        if (i + 1 < nt_) { if (abl != 9) { att_dma(KT__(i + 1), ko, (i & 1) ? kbuf0 : kbuf1); if (PV__) att_dma(VT__(i + 1), vo, (i & 1) ? vbuf0 : vbuf1); } \
            if (abl == 9) asm volatile("s_waitcnt vmcnt(0)" ::: "memory"); else if (PV__) asm volatile("s_waitcnt vmcnt(8)" ::: "memory"); else asm volatile("s_waitcnt vmcnt(4)" ::: "memory"); } \
        else asm volatile("s_waitcnt vmcnt(0)" ::: "memory"); \
        const f32x16 sc = att_qk_lds(kb_, q, r, h, (INIT__)); __VA_ARGS__ \
        asm volatile("s_waitcnt lgkmcnt(0)" ::: "memory"); } } while (0)
__device__ __forceinline__ void ph_attention(const Ctx& c, Frame F, int jq, int rep) { F.tid = opq((int)threadIdx.x); F.lane = F.tid & 63;
#ifndef ABL_MODE
#define ABL_MODE 0
#endif
    const int abl = rep ? ABL_MODE : 0;
    const int lane = F.lane, r = lane & 31, h = lane >> 5, qi = r >> 2, g = r & 3;
    lds_u8* const wl = (lds_u8*)(F.lds + F.wave * 17920);
    lds_u32* selm = (lds_u32*)wl; __attribute__((address_space(3))) int* tl = (__attribute__((address_space(3))) int*)(wl + 256);
    lds_u8* const kbuf0 = wl + 1536; lds_u8* const kbuf1 = wl + 5632; lds_u8* const vbuf0 = wl + 9728; lds_u8* const vbuf1 = wl + 13824; lds_f32* imp = (lds_f32*)vbuf1; lds_f32* impv = (lds_f32*)vbuf0;
    int ko[4], vo[4]; att_dma_offsets(ko, vo, lane);
    unsigned* ctr0 = (unsigned*)(c.p.ws + OW_CTL) + 8192 + (jq * 2 + rep) * 512;
    const unsigned x0 = xb_xcc_id() & 7u;
    float gq = fabsf(c.p.nsa_qnorm[jq * HEAD_DIM + lane]), gk0 = fabsf(c.p.kv_knorm[lane]), gk1 = fabsf(c.p.kv_knorm[HEAD_DIM + lane]), gk2 = fabsf(c.p.kv_knorm[2 * HEAD_DIM + lane]);
#define GMAX_(O_) do { gq = fmaxf(gq, xshf<O_>(gq)); gk0 = fmaxf(gk0, xshf<O_>(gk0)); gk1 = fmaxf(gk1, xshf<O_>(gk1)); gk2 = fmaxf(gk2, xshf<O_>(gk2)); } while (0)
    GMAX_(1); GMAX_(2); GMAX_(4); GMAX_(8); GMAX_(16); GMAX_(32);
#undef GMAX_
    const float c1 = 0.125f * LOG2E, c2c = 8.1f * gq * gk0 * LOG2E, c2s = 8.1f * gq * gk1 * LOG2E, c2w = 8.1f * gq * gk2 * LOG2E;
    constexpr int NQ_S = DEC_BATCH * N_KV / 8, NQ_P = SEQ / 8;
    for (int kx = 0; kx < 8; ++kx) { const int xq = (int)((x0 + kx) & 7u); unsigned* ctr = ctr0 + 64 * xq;
    for (;;) {
        unsigned ui = 0; if (lane == 0) ui = __hip_atomic_fetch_add(ctr, 1u, __ATOMIC_RELAXED, __HIP_MEMORY_SCOPE_AGENT); ui = __builtin_amdgcn_readfirstlane(ui);
        if (ui >= (unsigned)(NQ_S + NQ_P)) break;
        int s, kvh, row0, pos0; bool prompt;
        if (ui < (unsigned)NQ_S) { prompt = false; const int v = xq * NQ_S + (int)ui, b = v / N_KV; kvh = v % N_KV; s = BATCH + b; row0 = NP + b * DEC_SEQ; pos0 = PAST_LEN; }
        else { prompt = true; const int tg = (SEQ / 8 - 1) - ((int)ui - NQ_S); s = xq / N_KV; kvh = xq % N_KV; row0 = s * SEQ + tg * 8; pos0 = tg * 8; }
        const int pos = pos0 + qi, posmax = pos0 + 7, cur = pos0 >> 6; const int head = kvh * GROUP + g, row = row0 + qi;
        const bf16* ck = c.cmpk() + (size_t)(s * N_KV + kvh) * 512 * 64; const bf16* cvt = c.cmpvt() + (size_t)(s * N_KV + kvh) * 64 * 512;
        const bf16 *sk, *svt, *wk, *wvt; size_t svp, wvp; int wbase;
        if (prompt) { sk = c.sk() + (size_t)(s * N_KV + kvh) * SEQ * 64; svt = c.svt() + (size_t)(s * N_KV + kvh) * 64 * SEQ; svp = SEQ; wk = c.wk() + (size_t)(s * N_KV + kvh) * SEQ * 64; wvt = c.wvt() + (size_t)(s * N_KV + kvh) * 64 * SEQ; wvp = SEQ; wbase = 0; }
        else { const int bk = (s - BATCH) * N_KV + kvh; sk = c.sks() + (size_t)bk * SELP * 64; svt = c.svts() + (size_t)bk * 64 * SELP; svp = SELP; wk = c.wks() + (size_t)bk * WINS * 64; wvt = c.wvts() + (size_t)bk * 64 * WINS; wvp = WINS; wbase = PAST_LEN - WIN_BUF; }
        f32x16 ob[2];
#pragma unroll
        for (int i = 0; i < 16; ++i) { ob[0][i] = 0.f; ob[1][i] = 0.f; }
        const float gate0 = c.gates()[(size_t)row * 48 + head * 3 + 0], gate1 = c.gates()[(size_t)row * 48 + head * 3 + 1], gate2 = c.gates()[(size_t)row * 48 + head * 3 + 2];
        bf16* const od = c.ao() + (size_t)row * D_Q + head * 64;
#define ATT_OSTORE() do { _Pragma("unroll") for (int dt = 0; dt < 2; ++dt) _Pragma("unroll") for (int a = 0; a < 4; ++a) { u32x2 w; w.x = cvtpk(ob[dt][4 * a], ob[dt][4 * a + 1]); w.y = cvtpk(ob[dt][4 * a + 2], ob[dt][4 * a + 3]); *(u32x2*)(od + 32 * dt + 8 * a + 4 * h) = w; } } while (0)
#define ATT_OADD() do { _Pragma("unroll") for (int dt = 0; dt < 2; ++dt) _Pragma("unroll") for (int a = 0; a < 4; ++a) { const u32x2 w = *(const u32x2*)(od + 32 * dt + 8 * a + 4 * h); ob[dt][4 * a] += bflo(w.x); ob[dt][4 * a + 1] += bfhi(w.x); ob[dt][4 * a + 2] += bflo(w.y); ob[dt][4 * a + 3] += bfhi(w.y); } } while (0)
        s16x8 q[4];
        {   const bf16* qb = c.qc() + ((size_t)row * N_HEADS + head) * 64 + 8 * h;
#pragma unroll
            for (int ks = 0; ks < 4; ++ks) q[ks] = *(const s16x8*)(qb + 16 * ks);
            int nc = pos - (CMP_LEN - 1); nc = nc < 0 ? 0 : nc / CMP_STRIDE + 1; nc = nc < NCMP ? nc : NCMP;
            int ncmin = pos0 - (CMP_LEN - 1); ncmin = ncmin < 0 ? 0 : ncmin / CMP_STRIDE + 1; ncmin = ncmin < NCMP ? ncmin : NCMP;
            int ncmax = posmax - (CMP_LEN - 1); ncmax = ncmax < 0 ? 0 : ncmax / CMP_STRIDE + 1; ncmax = ncmax < NCMP ? ncmax : NCMP;
            float l = 0.f; f32x2 l2 = {0.f, 0.f};
#define KP_(i_) (ck + (size_t)(i_) * 32 * 64)
#define VP_(i_) (cvt + (size_t)(i_) * 2048)

#define KT__(i_) KP_(i_)
#define VT__(i_) VP_(i_)
#define PV__ 1
#define INIT__ -c2c
            ATT_WALK((ncmax + 31) >> 5, { const int lim = nc - i * 32 - 8 * h; float e[16];
                if (i * 32 + 32 <= ncmin) { _Pragma("unroll") for (int k = 0; k < 16; ++k) e[k] = __builtin_amdgcn_exp2f(sc[k]); }
                else { _Pragma("unroll") for (int k = 0; k < 16; ++k) e[k] = (CROWK(k) < lim) ? __builtin_amdgcn_exp2f(sc[k]) : 0.f; }
                _Pragma("unroll") for (int k = 0; k < 16; k += 2) l2 += (f32x2){e[k], e[k + 1]};
                att_pv_lds(vbuf, e, ob, r, h); });
#undef KT__
#undef VT__
#undef PV__
#undef INIT__

            l = l2.x + l2.y; l += __shfl_xor(l, 32);
            const float invl = 1.f / (l > TINY ? l : TINY), f0 = gate0 * invl;
#pragma unroll
            for (int i = 0; i < 16; ++i) { ob[0][i] *= f0; ob[1][i] *= f0; }
            ATT_OSTORE();
#pragma unroll
            for (int i = 0; i < 16; ++i) { ob[0][i] = 0.f; ob[1][i] = 0.f; }
            for (int i = lane; i < 8 * 128; i += 64) { imp[i] = 0.f; impv[i] = 0.f; }
            if (lane < 64) selm[lane] = 0u;

#define KT__(i_) KP_(i_)
#define VT__(i_) VP_(i_)
#define PV__ 0
#define INIT__ -c2c
            ATT_WALK((ncmax + 31) >> 5, { const int n0 = i * 32, lim = nc - n0 - 8 * h;
                _Pragma("unroll") for (int a = 0; a < 4; ++a) { float e4[4];
                    _Pragma("unroll") for (int k = 0; k < 4; ++k) { const int ii = 4 * a + k; e4[k] = (CROWK(ii) < lim) ? __builtin_amdgcn_exp2f(sc[ii]) * invl : 0.f; }
                    float u = (e4[0] + e4[1]) + (e4[2] + 0.5f * e4[3]), v = 0.5f * e4[3];
                    u += xshf<1>(u); u += xshf<2>(u); v += xshf<1>(v); v += xshf<2>(v);
                    const int sb = (n0 >> 2) + 4 * (a >> 1) + (a & 1) + 2 * h;
                    if (g == 0 && sb < 127) { imp[qi * 128 + sb] = u; impv[qi * 128 + sb + 1] = v; } } });
#undef KT__
#undef VT__
#undef PV__
#undef INIT__

#undef KP_
#undef VP_
        }
        {   const int tq = lane >> 3, sub = lane & 7; const int nforced = cur == 0 ? 1 : (cur == 1 ? 2 : 3), kx = SEL_TOPK - nforced, ncand = cur - 2 > 0 ? cur - 2 : 0;
            if (c.p.dbg_topi) {
                if (sub == 0) { const int* ti = c.p.dbg_topi + ((size_t)(row0 + tq) * N_KV + kvh) * SEL_TOPK; for (int k = 0; k < SEL_TOPK; ++k) { const int sb = ti[k]; if (sb >= 0) selm[tq * 8 + (sb >> 5)] |= 1u << (sb & 31); } }
            } else {
            if (sub == 0) { selm[tq * 8 + 0] |= 1u; selm[tq * 8 + (cur >> 5)] |= 1u << (cur & 31); if (cur >= 1) selm[tq * 8 + ((cur - 1) >> 5)] |= 1u << ((cur - 1) & 31); }
            if (ncand <= kx) { if (sub == 0) for (int sb = 1; sb <= cur - 2; ++sb) selm[tq * 8 + (sb >> 5)] |= 1u << (sb & 31); }
            else for (int it = 0; it < kx; ++it) { float best = -3e38f; int bi = 0x7fffffff;
                for (int sb = 1 + sub; sb <= cur - 2; sb += 8) { const float v = imp[tq * 128 + sb] + impv[tq * 128 + sb]; if (v > best) { best = v; bi = sb; } }
#define TK_(O_) do { const float ob2 = xshf<O_>(best); const int oi = xshf_i<O_>(bi); if (ob2 > best || (ob2 == best && oi < bi)) { best = ob2; bi = oi; } } while (0)
                TK_(1); TK_(2); TK_(4);
#undef TK_
                if (bi != 0x7fffffff) { if (sub == ((bi - 1) & 7)) imp[tq * 128 + bi] = -3.4e38f; if (sub == 0) selm[tq * 8 + (bi >> 5)] |= 1u << (bi & 31); } }
            }
        }
        {   const bf16* qb = c.qr() + ((size_t)row * N_HEADS + head) * 64 + 8 * h;
#pragma unroll
            for (int ks = 0; ks < 4; ++ks) q[ks] = *(const s16x8*)(qb + 16 * ks);
            float l = 0.f; f32x2 l2 = {0.f, 0.f};
            int ntl = 0;
            for (int sb = 0; sb <= cur; ++sb) { const unsigned mw = selm[qi * 8 + (sb >> 5)]; const bool bit = (mw >> (sb & 31)) & 1u; if (!__any(bit)) continue;
                const bool two = sb * 64 + 32 <= posmax; if (lane == 0) { tl[ntl] = sb * 64; if (two) tl[ntl + 1] = sb * 64 + 32; } ntl += two ? 2 : 1; }
#define KP_(i_) (sk + (size_t)tl[(i_)] * 64)
#define VP_(i_) (svt + (size_t)(tl[(i_)] >> 5) * 2048)

#define KT__(i_) KP_(i_)
#define VT__(i_) VP_(i_)
#define PV__ 1
#define INIT__ (((selm[qi * 8 + (tl[i] >> 11)] >> ((tl[i] >> 6) & 31)) & 1u) ? -c2s : -1e30f)
            ATT_WALK(ntl, { const int tok0 = tl[i], sb = tok0 >> 6; const bool bit = (selm[qi * 8 + (sb >> 5)] >> (sb & 31)) & 1u; const int lim = bit ? pos - tok0 - 8 * h : -1; float e[16];
                if (tok0 + 31 <= pos0) { _Pragma("unroll") for (int k = 0; k < 16; ++k) e[k] = __builtin_amdgcn_exp2f(sc[k]); }
                else { _Pragma("unroll") for (int k = 0; k < 16; ++k) e[k] = (CROWK(k) <= lim) ? __builtin_amdgcn_exp2f(sc[k]) : 0.f; }
                _Pragma("unroll") for (int k = 0; k < 16; k += 2) l2 += (f32x2){e[k], e[k + 1]};
                att_pv_lds(vbuf, e, ob, r, h); });
#undef KT__
#undef VT__
#undef PV__
#undef INIT__

#undef KP_
#undef VP_
            l = l2.x + l2.y; l += __shfl_xor(l, 32);
            { const float f1 = gate1 / (l > TINY ? l : TINY);
#pragma unroll
              for (int i = 0; i < 16; ++i) { ob[0][i] *= f1; ob[1][i] *= f1; }
              ATT_OADD(); ATT_OSTORE();
#pragma unroll
              for (int i = 0; i < 16; ++i) { ob[0][i] = 0.f; ob[1][i] = 0.f; } }
            l = 0.f; l2 = (f32x2){0.f, 0.f};
            int lo = pos0 - (WINDOW - 1); if (lo < wbase) lo = wbase; if (lo < 0) lo = 0; const int i0 = (lo - wbase) & ~31;
#define KP_(i_) (wk + (size_t)(i0 + 32 * (i_)) * 64)
#define VP_(i_) (wvt + (size_t)((i0 >> 5) + (i_)) * 2048)

#define KT__(i_) KP_(i_)
#define VT__(i_) VP_(i_)
#define PV__ 1
#define INIT__ -c2w
            ATT_WALK(((posmax - wbase - i0) >> 5) + 1, { const int tok0 = i0 + 32 * i + wbase; const int hi_ = pos - tok0 - 8 * h, lo_ = hi_ - WINDOW; float e[16];
                if (tok0 + 31 <= pos0 && tok0 > posmax - WINDOW) { _Pragma("unroll") for (int k = 0; k < 16; ++k) e[k] = __builtin_amdgcn_exp2f(sc[k]); }
                else { _Pragma("unroll") for (int k = 0; k < 16; ++k) e[k] = (CROWK(k) <= hi_ && CROWK(k) > lo_) ? __builtin_amdgcn_exp2f(sc[k]) : 0.f; }
                _Pragma("unroll") for (int k = 0; k < 16; k += 2) l2 += (f32x2){e[k], e[k + 1]};
                att_pv_lds(vbuf, e, ob, r, h); });
#undef KT__
#undef VT__
#undef PV__
#undef INIT__

#undef KP_
#undef VP_
            l = l2.x + l2.y; l += __shfl_xor(l, 32);
            { const float f2 = gate2 / (l > TINY ? l : TINY);
#pragma unroll
              for (int i = 0; i < 16; ++i) { ob[0][i] *= f2; ob[1][i] *= f2; }
              ATT_OADD(); }
        }
        ATT_OSTORE();
#undef ATT_OSTORE
#undef ATT_OADD
    }
    }
}
#ifndef GEMM_ALIGN
#define GEMM_ALIGN true
#endif
constexpr int PH_KVQG = 19, PH_CMPG = 20, PH_CMP2 = 21, PH_ATT0 = 22, PH_QG1 = 27, PH_ATT1 = 28, NPH = 33;
__device__ __forceinline__ void gemm_dense(const Ctx& c, const Frame& F, const bf16* A, int lda, const bf16* B, int ldb, int nM, int nN, int K) { (void)c; (void)F; (void)A; (void)lda; (void)B; (void)ldb; (void)nM; (void)nN; (void)K; }
#ifndef OPT_ATTN
__device__ __forceinline__ void ph_attention(const Ctx& c, const Frame& F, int jq, int rep) { (void)c; (void)F; (void)jq; (void)rep; }
#endif
__global__ void __launch_bounds__(MK_THREADS, 2) fwd(OptP p) {
    extern __shared__ __attribute__((aligned(16))) unsigned char lds_raw[];
    Frame F; F.lds = (__attribute__((address_space(3))) unsigned char*)lds_raw; F.tid = threadIdx.x; F.lane = F.tid & 63; F.wave = __builtin_amdgcn_readfirstlane(F.tid >> 6);
    F.gw = blockIdx.x * NWAVES + F.wave; F.ngw = gridDim.x * NWAVES;
    volatile LAS unsigned* misc = (volatile LAS unsigned*)(F.lds + MK_LDS - 64);
    if (F.tid < 4) misc[F.tid] = 0u;
    __syncthreads();
    XcdBarrier bar = xcd_barrier_post((unsigned*)(p.ws + OW_CTL) + 4096, misc);
    unsigned long long bar_ticks = 0; (void)bar_ticks;
    const int lo = (int)p.ph_lo, hi = (int)p.ph_hi, G = gridDim.x, cu = blockIdx.x; const unsigned long long dupm = (unsigned long long)p.dup;
#ifdef ONLY_PHASE
#define IN(k) ((k) == ONLY_PHASE)
#else
#define IN(k) (lo <= (k) && (k) < hi)
#endif
#ifdef BAR_PROBE
#define SEAM(k) do { if (IN(k) && IN((k) + 1)) { const unsigned long long t0_ = __builtin_amdgcn_s_memrealtime(); xcd_barrier(bar); bar_ticks += __builtin_amdgcn_s_memrealtime() - t0_; } } while (0)
#elif defined(DOUBLE_BARRIER)
#define SEAM(k) do { if (IN(k) && IN((k) + 1)) { xcd_barrier(bar); xcd_barrier(bar); } } while (0)
#else
#define SEAM(k) do { if (IN(k) && IN((k) + 1)) xcd_barrier(bar); } while (0)
#endif
    PG8_LAS unsigned char* gl = (PG8_LAS unsigned char*)F.lds;
    if (IN(0)) for (int rep = (int)((dupm >> (0)) & 1ull); rep >= 0; --rep) { const Ctx c{*kargs()}; p0_prologue(c, F); } SEAM(0);
    { constexpr int l = 0; constexpr int b0 = 1 + 9 * l;
        if (IN(b0)) for (int rep = (int)((dupm >> (b0)) & 1ull); rep >= 0; --rep) { const Ctx c{*kargs()}; SchedDense S{(const char*)c.xb(), (const char*)(c.w_retin() + (size_t)l * 6 * D_MODEL * D_MODEL), D_MODEL, D_MODEL, NPAN, 24, 16, opq_s(G), opq_s(cu)}; EpiRetIn E{&c, (lds_b*)(F.lds + 131072), rep != 0 && (p.dup >> 40) != 0}; pg8::gemm_phase<EpiRetIn, SchedDense, GEMM_ALIGN>(gl, D_MODEL, D_MODEL, S, E); { const int tl = (NPAN * 24) % G, q = xcd_slot(cu, G); if (q >= tl) sel_convert_items(c, F, l * SEL_EARLY, (l + 1) * SEL_EARLY, (q - tl) * NWAVES + F.wave, (G - tl) * NWAVES); } } SEAM(b0);
        if (IN(b0 + 1)) for (int rep = (int)((dupm >> (b0 + 1)) & 1ull); rep >= 0; --rep) { const Ctx c{*kargs()}; { SchedPKV S{&c, opq_s(G), opq_s(cu), 0}; EpiP E{&c}; pg8::gemm_phase(gl, 4 * CATK, 1024, S, E); }
                          { SchedPKV S{&c, opq_s(G), opq_s(cu), 1}; EpiKV E{&c}; pg8::gemm_phase(gl, CATK, SEQ, S, E); }
                          ph_ret_sample(c, F, l); } SEAM(b0 + 1);
        if (IN(b0 + 2)) for (int rep = (int)((dupm >> (b0 + 2)) & 1ull); rep >= 0; --rep) { const Ctx c{*kargs()}; ph_ret_scan(c, F, l); ph_gate_sample(c, F); } SEAM(b0 + 2);
        if (IN(b0 + 3)) for (int rep = (int)((dupm >> (b0 + 3)) & 1ull); rep >= 0; --rep) { const Ctx c{*kargs()}; SchedOut S{&c, opq_s(G), opq_s(cu)}; EpiOut E{&c}; pg8::gemm_phase(gl, 4 * CATK, CATK, S, E); ph_gate_own(c, F); } SEAM(b0 + 3);
        if (IN(b0 + 5)) for (int rep = (int)((dupm >> (b0 + 5)) & 1ull); rep >= 0; --rep) { const Ctx c{*kargs()}; SchedResSplit S{(const char*)c.g(), (const char*)(c.w_retout() + (size_t)l * 2 * D_MODEL * D_MODEL), 2 * D_MODEL, 32, opq_s(G), opq_s(cu)}; EpiRes E{&c, rep != 0, false}; pg8::gemm_phase(gl, 2 * D_MODEL, 2 * D_MODEL, S, E); xcd_barrier(bar); ph_fix_sample(c, F, rep != 0, false); } SEAM(b0 + 5);
        if (IN(b0 + 6)) for (int rep = (int)((dupm >> (b0 + 6)) & 1ull); rep >= 0; --rep) { const Ctx c{*kargs()}; SchedFfnIn S{(const char*)c.xb(), (const char*)(c.w_ffnin() + (size_t)l * 2 * D_FF * D_MODEL), opq_s(G), opq_s(cu)}; EpiFfnIn E{&c, l, (lds_b*)(F.lds + 131072)}; pg8::gemm_phase<EpiFfnIn, SchedFfnIn, true>(gl, D_MODEL, D_MODEL, S, E); } SEAM(b0 + 6);
        if (IN(b0 + 8)) for (int rep = (int)((dupm >> (b0 + 8)) & 1ull); rep >= 0; --rep) { const Ctx c{*kargs()}; SchedResSplit S{(const char*)c.act(), (const char*)(c.w_ffnout() + (size_t)l * D_FF * D_MODEL), D_FF, D_FF / 64, opq_s(G), opq_s(cu)}; EpiRes E{&c, rep != 0, l == DEPTH - 1}; pg8::gemm_phase(gl, D_FF, D_FF, S, E); xcd_barrier(bar); ph_fix_sample(c, F, rep != 0, l == DEPTH - 1); } SEAM(b0 + 8);
        }
    { constexpr int l = 1; constexpr int b0 = 1 + 9 * l;
        if (IN(b0)) for (int rep = (int)((dupm >> (b0)) & 1ull); rep >= 0; --rep) { const Ctx c{*kargs()}; SchedDense S{(const char*)c.xb(), (const char*)(c.w_retin() + (size_t)l * 6 * D_MODEL * D_MODEL), D_MODEL, D_MODEL, NPAN, 24, 16, opq_s(G), opq_s(cu)}; EpiRetIn E{&c, (lds_b*)(F.lds + 131072), rep != 0 && (p.dup >> 40) != 0}; pg8::gemm_phase<EpiRetIn, SchedDense, GEMM_ALIGN>(gl, D_MODEL, D_MODEL, S, E); { const int tl = (NPAN * 24) % G, q = xcd_slot(cu, G); if (q >= tl) sel_convert_items(c, F, l * SEL_EARLY, (l + 1) * SEL_EARLY, (q - tl) * NWAVES + F.wave, (G - tl) * NWAVES); } } SEAM(b0);
        if (IN(b0 + 1)) for (int rep = (int)((dupm >> (b0 + 1)) & 1ull); rep >= 0; --rep) { const Ctx c{*kargs()}; { SchedPKV S{&c, opq_s(G), opq_s(cu), 0}; EpiP E{&c}; pg8::gemm_phase(gl, 4 * CATK, 1024, S, E); }
                          { SchedPKV S{&c, opq_s(G), opq_s(cu), 1}; EpiKV E{&c}; pg8::gemm_phase(gl, CATK, SEQ, S, E); }
                          ph_ret_sample(c, F, l); } SEAM(b0 + 1);
        if (IN(b0 + 2)) for (int rep = (int)((dupm >> (b0 + 2)) & 1ull); rep >= 0; --rep) { const Ctx c{*kargs()}; ph_ret_scan(c, F, l); ph_gate_sample(c, F); } SEAM(b0 + 2);
        if (IN(b0 + 3)) for (int rep = (int)((dupm >> (b0 + 3)) & 1ull); rep >= 0; --rep) { const Ctx c{*kargs()}; SchedOut S{&c, opq_s(G), opq_s(cu)}; EpiOut E{&c}; pg8::gemm_phase(gl, 4 * CATK, CATK, S, E); ph_gate_own(c, F); } SEAM(b0 + 3);
        if (IN(b0 + 5)) for (int rep = (int)((dupm >> (b0 + 5)) & 1ull); rep >= 0; --rep) { const Ctx c{*kargs()}; SchedResSplit S{(const char*)c.g(), (const char*)(c.w_retout() + (size_t)l * 2 * D_MODEL * D_MODEL), 2 * D_MODEL, 32, opq_s(G), opq_s(cu)}; EpiRes E{&c, rep != 0, false}; pg8::gemm_phase(gl, 2 * D_MODEL, 2 * D_MODEL, S, E); xcd_barrier(bar); ph_fix_sample(c, F, rep != 0, false); } SEAM(b0 + 5);
        if (IN(b0 + 6)) for (int rep = (int)((dupm >> (b0 + 6)) & 1ull); rep >= 0; --rep) { const Ctx c{*kargs()}; SchedFfnIn S{(const char*)c.xb(), (const char*)(c.w_ffnin() + (size_t)l * 2 * D_FF * D_MODEL), opq_s(G), opq_s(cu)}; EpiFfnIn E{&c, l, (lds_b*)(F.lds + 131072)}; pg8::gemm_phase<EpiFfnIn, SchedFfnIn, true>(gl, D_MODEL, D_MODEL, S, E); } SEAM(b0 + 6);
        if (IN(b0 + 8)) for (int rep = (int)((dupm >> (b0 + 8)) & 1ull); rep >= 0; --rep) { const Ctx c{*kargs()}; SchedResSplit S{(const char*)c.act(), (const char*)(c.w_ffnout() + (size_t)l * D_FF * D_MODEL), D_FF, D_FF / 64, opq_s(G), opq_s(cu)}; EpiRes E{&c, rep != 0, l == DEPTH - 1}; pg8::gemm_phase(gl, D_FF, D_FF, S, E); xcd_barrier(bar); ph_fix_sample(c, F, rep != 0, l == DEPTH - 1); } SEAM(b0 + 8);
        }
    if (IN(PH_KVQG)) for (int rep = (int)((dupm >> (PH_KVQG)) & 1ull); rep >= 0; --rep) { const Ctx c{*kargs()}; { SchedDense S{(const char*)c.xb(), (const char*)c.w_kvqg(), D_MODEL, D_MODEL, NPAN, N_KVQG / 256, 16, opq_s(G), opq_s(cu)}; EpiKvqg E{&c, 0, 0}; pg8::gemm_phase(gl, D_MODEL, D_MODEL, S, E); }
                       ph_cmp_convert(c, F); } SEAM(PH_KVQG);
    if (IN(PH_CMPG)) for (int rep = (int)((dupm >> (PH_CMPG)) & 1ull); rep >= 0; --rep) { const Ctx c{*kargs()}; SchedCmp S{&c, opq_s(G), opq_s(cu)}; EpiCmp1 E{&c}; pg8::gemm_phase(gl, 1024, 1024, S, E); } SEAM(PH_CMPG);
    if (IN(PH_CMP2)) for (int rep = (int)((dupm >> (PH_CMP2)) & 1ull); rep >= 0; --rep) { const Ctx c{*kargs()};
#ifdef ABL21
        if (!(rep && ABL21 == 1)) ph_cmp_stage2(c, F); if (!(rep && ABL21 == 2)) ph_sel_convert(c, F);
#else
        ph_cmp_stage2(c, F); ph_sel_convert(c, F);
#endif
    } SEAM(PH_CMP2);
    { constexpr int jq = 0; constexpr int l = N_A + jq, a0 = jq == 0 ? PH_ATT0 : PH_ATT1;
        if (jq == 1) { if (IN(PH_QG1)) for (int rep = (int)((dupm >> (PH_QG1)) & 1ull); rep >= 0; --rep) { const Ctx c{*kargs()}; SchedDense S{(const char*)c.xb(), (const char*)c.w_qg1(), D_MODEL, D_MODEL, NPAN, N_QG1 / 256, 16, opq_s(G), opq_s(cu)}; EpiKvqg E{&c, 6, 1}; pg8::gemm_phase(gl, D_MODEL, D_MODEL, S, E); } SEAM(PH_QG1); }
        if (IN(a0)) for (int rep = (int)((dupm >> (a0)) & 1ull); rep >= 0; --rep) { const Ctx c{*kargs()}; ph_attention(c, F, jq, rep); } SEAM(a0);
        if (IN(a0 + 1)) for (int rep = (int)((dupm >> (a0 + 1)) & 1ull); rep >= 0; --rep) { const Ctx c{*kargs()}; SchedResSplit S{(const char*)c.ao(), (const char*)(c.w_wo() + (size_t)jq * D_Q * D_MODEL), D_Q, 16, opq_s(G), opq_s(cu)}; EpiRes E{&c, rep != 0, false}; pg8::gemm_phase(gl, D_Q, D_Q, S, E); xcd_barrier(bar); ph_fix_sample(c, F, rep != 0, false); } SEAM(a0 + 1);
        if (IN(a0 + 2)) for (int rep = (int)((dupm >> (a0 + 2)) & 1ull); rep >= 0; --rep) { const Ctx c{*kargs()}; SchedFfnIn S{(const char*)c.xb(), (const char*)(c.w_ffnin() + (size_t)l * 2 * D_FF * D_MODEL), opq_s(G), opq_s(cu)}; EpiFfnIn E{&c, l, (lds_b*)(F.lds + 131072)}; pg8::gemm_phase<EpiFfnIn, SchedFfnIn, true>(gl, D_MODEL, D_MODEL, S, E); } SEAM(a0 + 2);
        if (IN(a0 + 4)) for (int rep = (int)((dupm >> (a0 + 4)) & 1ull); rep >= 0; --rep) { const Ctx c{*kargs()}; SchedResSplit S{(const char*)c.act(), (const char*)(c.w_ffnout() + (size_t)l * D_FF * D_MODEL), D_FF, D_FF / 64, opq_s(G), opq_s(cu)}; EpiRes E{&c, rep != 0, l == DEPTH - 1}; pg8::gemm_phase(gl, D_FF, D_FF, S, E); xcd_barrier(bar); ph_fix_sample(c, F, rep != 0, l == DEPTH - 1); } SEAM(a0 + 4);
        }
    { constexpr int jq = 1; constexpr int l = N_A + jq, a0 = jq == 0 ? PH_ATT0 : PH_ATT1;
        if (jq == 1) { if (IN(PH_QG1)) for (int rep = (int)((dupm >> (PH_QG1)) & 1ull); rep >= 0; --rep) { const Ctx c{*kargs()}; SchedDense S{(const char*)c.xb(), (const char*)c.w_qg1(), D_MODEL, D_MODEL, NPAN, N_QG1 / 256, 16, opq_s(G), opq_s(cu)}; EpiKvqg E{&c, 6, 1}; pg8::gemm_phase(gl, D_MODEL, D_MODEL, S, E); } SEAM(PH_QG1); }
        if (IN(a0)) for (int rep = (int)((dupm >> (a0)) & 1ull); rep >= 0; --rep) { const Ctx c{*kargs()}; ph_attention(c, F, jq, rep); } SEAM(a0);
        if (IN(a0 + 1)) for (int rep = (int)((dupm >> (a0 + 1)) & 1ull); rep >= 0; --rep) { const Ctx c{*kargs()}; SchedResSplit S{(const char*)c.ao(), (const char*)(c.w_wo() + (size_t)jq * D_Q * D_MODEL), D_Q, 16, opq_s(G), opq_s(cu)}; EpiRes E{&c, rep != 0, false}; pg8::gemm_phase(gl, D_Q, D_Q, S, E); xcd_barrier(bar); ph_fix_sample(c, F, rep != 0, false); } SEAM(a0 + 1);
        if (IN(a0 + 2)) for (int rep = (int)((dupm >> (a0 + 2)) & 1ull); rep >= 0; --rep) { const Ctx c{*kargs()}; SchedFfnIn S{(const char*)c.xb(), (const char*)(c.w_ffnin() + (size_t)l * 2 * D_FF * D_MODEL), opq_s(G), opq_s(cu)}; EpiFfnIn E{&c, l, (lds_b*)(F.lds + 131072)}; pg8::gemm_phase<EpiFfnIn, SchedFfnIn, true>(gl, D_MODEL, D_MODEL, S, E); } SEAM(a0 + 2);
        if (IN(a0 + 4)) for (int rep = (int)((dupm >> (a0 + 4)) & 1ull); rep >= 0; --rep) { const Ctx c{*kargs()}; SchedResSplit S{(const char*)c.act(), (const char*)(c.w_ffnout() + (size_t)l * D_FF * D_MODEL), D_FF, D_FF / 64, opq_s(G), opq_s(cu)}; EpiRes E{&c, rep != 0, l == DEPTH - 1}; pg8::gemm_phase(gl, D_FF, D_FF, S, E); xcd_barrier(bar); ph_fix_sample(c, F, rep != 0, l == DEPTH - 1); } SEAM(a0 + 4);
        }
#ifdef BAR_PROBE
    xcd_barrier(bar); if (blockIdx.x == BAR_PROBE && threadIdx.x == 0) p.out[O_YP] += 100.f * (float)(int)((float)bar_ticks * 0.0001f + 0.5f);
#endif
#undef IN
#undef SEAM
}
static_assert(PH_ATT0 + 5 == PH_QG1 && PH_ATT1 + 5 == NPH && 1 + 9 * N_A == PH_KVQG, "phase numbering");
static void opt_fill(OptP& p, void* const* d_in, float* out, unsigned char* ws) {
    p.x_prompt = (const float*)d_in[0]; p.x_sample = (const float*)d_in[1]; p.cache_cmp = (const float*)d_in[2]; p.cache_sel = (const float*)d_in[3]; p.cache_win = (const float*)d_in[4];
    p.state_ret = (const float*)d_in[5]; p.state_conv = (const float*)d_in[6]; p.page_table = (const int*)d_in[7]; p.norm_mix = (const float*)d_in[8]; p.norm_ffn = (const float*)d_in[9];
    p.ret_w_in = (const float*)d_in[10]; p.ret_w_out = (const float*)d_in[11]; p.ffn_w_in = (const float*)d_in[12]; p.ffn_conv_w = (const float*)d_in[13]; p.ffn_conv_b = (const float*)d_in[14];
    p.ffn_w_out = (const float*)d_in[15]; p.kv_norm = (const float*)d_in[16]; p.kv_w = (const float*)d_in[17]; p.kv_knorm = (const float*)d_in[18]; p.cmp_pos = (const float*)d_in[19];
    p.cmp_w1 = (const float*)d_in[20]; p.cmp_w2 = (const float*)d_in[21]; p.nsa_w_qg = (const float*)d_in[22]; p.nsa_qnorm = (const float*)d_in[23]; p.nsa_w_o = (const float*)d_in[24];
    p.out = out; p.ws = ws; p.ph_lo = 0; p.ph_hi = NPH;
}
static int opt_grid() {
    static int grid = 0;
    if (grid == 0) { int dev = 0, cus = 0, per_cu = 0;
        if (hipGetDevice(&dev) != hipSuccess || hipDeviceGetAttribute(&cus, hipDeviceAttributeMultiprocessorCount, dev) != hipSuccess) { grid = -1; return grid; }
        if (hipFuncSetAttribute((const void*)fwd, hipFuncAttributeMaxDynamicSharedMemorySize, MK_LDS) != hipSuccess) { fprintf(stderr, "hipFuncSetAttribute failed\n"); grid = -1; return grid; }
        if (hipOccupancyMaxActiveBlocksPerMultiprocessor(&per_cu, (const void*)fwd, MK_THREADS, MK_LDS) != hipSuccess || per_cu < 1) { fprintf(stderr, "occupancy query says %d\n", per_cu); grid = -1; return grid; }
        (void)hipGetLastError(); grid = cus; }
    return grid;
}
extern "C" void kernel_launch(void* const* d_in, const int* in_sizes, int n_in, void* d_out, int out_size, void* d_ws, size_t ws_size, hipStream_t stream) {
    const int grid = opt_grid();
    if (n_in != 25 || out_size != (int)O_END || ws_size < OW_END || grid < 0) { fprintf(stderr, "kernel_launch: sizes n_in %d out %d ws %zu need %zu grid %d\n", n_in, out_size, ws_size, (size_t)OW_END, grid); return; }
    OptP op; memset(&op, 0, sizeof(op)); opt_fill(op, d_in, (float*)d_out, (unsigned char*)d_ws);
#ifdef DUP_MASK
    op.dup = (long)(DUP_MASK);
#endif
    hipMemsetAsync((unsigned char*)d_ws + OW_CTL, 0, OW_CTL_BYTES, stream);
    hipLaunchKernelGGL(fwd, dim3(grid), dim3(MK_THREADS), MK_LDS, stream, op);
}
```
